# Optimizing an MI355X kernel written in HIP

```python
import math
import jax, jax.numpy as jnp
from jax import lax
import numpy as np

D_MODEL = 1024
BATCH = 32
SEQ = 2048
DEPTH = 1

N_HEADS = 8
QK_NOPE_DIM = 64
QK_ROPE_DIM = 32
QK_DIM = QK_NOPE_DIM + QK_ROPE_DIM
V_HEAD_DIM = 64
Q_LORA_RANK = 256
KV_LORA_RANK = 128
ROPE_THETA = 10000.0
Q_BLOCK = 128
ATTN_WIDTH = N_HEADS * V_HEAD_DIM

LRU_WIDTH = 512
LRU_BLOCKS = 4
LRU_BLOCK_DIM = LRU_WIDTH // LRU_BLOCKS
CONV_WIDTH = 4
CONV_LEFT = 2
LRU_C = 8.0
N_DIRS = 2

N_BRANCHES = 2
D_FF = -(-8 * D_MODEL // (3 * 256)) * 256
NORM_EPS = 1e-6

C_QA = Q_LORA_RANK
C_KVA = C_QA + KV_LORA_RANK
C_KR = C_KVA + QK_ROPE_DIM
C_LX = C_KR + LRU_WIDTH
C_LY = C_LX + LRU_WIDTH
D_IN = C_LY + N_BRANCHES * D_MODEL

kernel_name = 'hybrid_mla_rglru_encoder'


def rmsnorm(x, g):
    xf = x.astype(jnp.float32)
    y = xf * lax.rsqrt(jnp.mean(xf * xf, axis=-1, keepdims=True) + NORM_EPS)
    return (y * g.astype(jnp.float32)).astype(x.dtype)


def rope_tables(seq):
    pos = jnp.arange(seq, dtype=jnp.float32)
    inv_freq = 1.0 / (ROPE_THETA ** (jnp.arange(0, QK_ROPE_DIM, 2, dtype=jnp.float32) / QK_ROPE_DIM))
    ang = pos[:, None] * inv_freq[None, :]
    return jnp.cos(ang), jnp.sin(ang)


def apply_rope(x, cos, sin):
    x1, x2 = jnp.split(x, 2, axis=-1)
    cos = cos.astype(x.dtype)
    sin = sin.astype(x.dtype)
    return jnp.concatenate([x1 * cos - x2 * sin, x2 * cos + x1 * sin], axis=-1)


def mla_mixer(q_a, kv_a, k_rope_raw, q_a_norm_g, w_q_b, kv_a_norm_g, w_kv_b):
    b, s, _ = q_a.shape
    cos, sin = rope_tables(s)
    q = (rmsnorm(q_a, q_a_norm_g) @ w_q_b).reshape(b, s, N_HEADS, QK_DIM)
    q_nope, q_rope = q[..., :QK_NOPE_DIM], q[..., QK_NOPE_DIM:]
    q_rope = apply_rope(q_rope, cos[:, None, :], sin[:, None, :])
    kv = (rmsnorm(kv_a, kv_a_norm_g) @ w_kv_b).reshape(b, s, N_HEADS, QK_NOPE_DIM + V_HEAD_DIM)
    k_nope, v = kv[..., :QK_NOPE_DIM], kv[..., QK_NOPE_DIM:]
    k_rope = apply_rope(k_rope_raw, cos, sin)
    q = jnp.concatenate([q_nope, q_rope], axis=-1)
    k = jnp.concatenate([k_nope, jnp.broadcast_to(k_rope[:, :, None, :], (b, s, N_HEADS, QK_ROPE_DIM))], axis=-1)
    scale = QK_DIM ** -0.5
    n_blk = s // Q_BLOCK
    q_blocks = q.reshape(b, n_blk, Q_BLOCK, N_HEADS, QK_DIM).transpose(1, 0, 2, 3, 4)

    def attend(qb):
        sc = jnp.einsum('bqhd,bkhd->bhqk', qb, k).astype(jnp.float32) * scale
        p = jax.nn.softmax(sc, axis=-1).astype(v.dtype)
        return jnp.einsum('bhqk,bkhd->bqhd', p, v)

    o = lax.map(attend, q_blocks)
    return o.transpose(1, 0, 2, 3, 4).reshape(b, s, ATTN_WIDTH)


def _lin_combine(left, right):
    a1, b1 = left
    a2, b2 = right
    return a1 * a2, a2 * b1 + b2


def rglru_bidir(xl, conv_w, conv_b, w_r, b_r, w_i, b_i, lam):
    b, s, w = xl.shape
    xp = jnp.pad(xl, ((0, 0), (CONV_LEFT, CONV_WIDTH - 1 - CONV_LEFT), (0, 0)))
    xc = sum(xp[:, j:j + s, :] * conv_w[j] for j in range(CONV_WIDTH)) + conv_b
    xb = xc.reshape(b, s, LRU_BLOCKS, LRU_BLOCK_DIM)
    r = jax.nn.sigmoid((jnp.einsum('bsnc,rncd->rbsnd', xb, w_r) + b_r[:, None, None]).astype(jnp.float32))
    i = jax.nn.sigmoid((jnp.einsum('bsnc,rncd->rbsnd', xb, w_i) + b_i[:, None, None]).astype(jnp.float32))
    r = r.reshape(N_DIRS, b, s, w)
    i = i.reshape(N_DIRS, b, s, w)
    log_a = -LRU_C * r * jax.nn.softplus(-lam.astype(jnp.float32))[:, None, None, :]
    a = jnp.exp(log_a)
    mult = jnp.sqrt(-jnp.expm1(2.0 * log_a))
    u = i * xc.astype(jnp.float32)[None] * mult
    _, h_fwd = lax.associative_scan(_lin_combine, (a[0], u[0]), axis=1)
    _, h_bwd = lax.associative_scan(_lin_combine, (a[1], u[1]), axis=1, reverse=True)
    return (h_fwd + h_bwd).astype(xl.dtype)


def setup_inputs(seed: int = 0) -> dict:
    key = jax.random.key(seed)
    ks = jax.random.split(key, 24)
    f32 = jnp.float32
    L = DEPTH

    def nrm(k, shape, fan_in):
        return jax.random.normal(k, shape, f32) * (fan_in ** -0.5)

    def gain(k, shape):
        return jnp.ones(shape, f32) + 0.01 * jax.random.normal(k, shape, f32)

    u = jax.random.uniform(ks[14], (L, N_DIRS, LRU_WIDTH), f32, 0.9, 0.999)
    a0 = u ** (1.0 / LRU_C)
    lru_lambda = jnp.log(a0) - jnp.log1p(-a0)
    return {
        'x': jax.random.normal(ks[0], (BATCH, SEQ, D_MODEL), f32),
        'norm1_g': gain(ks[1], (L, D_MODEL)),
        'w_in': nrm(ks[2], (L, D_MODEL, D_IN), D_MODEL),
        'q_a_norm_g': gain(ks[3], (L, Q_LORA_RANK)),
        'w_q_b': nrm(ks[4], (L, Q_LORA_RANK, N_HEADS * QK_DIM), Q_LORA_RANK),
        'kv_a_norm_g': gain(ks[5], (L, KV_LORA_RANK)),
        'w_kv_b': nrm(ks[6], (L, KV_LORA_RANK, N_HEADS * (QK_NOPE_DIM + V_HEAD_DIM)), KV_LORA_RANK),
        'w_o_attn': nrm(ks[7], (L, ATTN_WIDTH, D_MODEL), ATTN_WIDTH),
        'conv_w': nrm(ks[8], (L, CONV_WIDTH, LRU_WIDTH), CONV_WIDTH),
        'conv_b': 0.1 * jax.random.normal(ks[9], (L, LRU_WIDTH), f32),
        'w_rgate': nrm(ks[10], (L, N_DIRS, LRU_BLOCKS, LRU_BLOCK_DIM, LRU_BLOCK_DIM), LRU_BLOCK_DIM),
        'b_rgate': 0.1 * jax.random.normal(ks[11], (L, N_DIRS, LRU_BLOCKS, LRU_BLOCK_DIM), f32),
        'w_igate': nrm(ks[12], (L, N_DIRS, LRU_BLOCKS, LRU_BLOCK_DIM, LRU_BLOCK_DIM), LRU_BLOCK_DIM),
        'b_igate': 0.1 * jax.random.normal(ks[13], (L, N_DIRS, LRU_BLOCKS, LRU_BLOCK_DIM), f32),
        'lru_lambda': lru_lambda,
        'w_o_lru': nrm(ks[15], (L, LRU_WIDTH, D_MODEL), LRU_WIDTH),
        'w_out': nrm(ks[16], (L, D_MODEL, D_MODEL), D_MODEL),
        'norm2_g': gain(ks[17], (L, D_MODEL)),
        'w_ffn_gate': nrm(ks[18], (L, D_MODEL, D_FF), D_MODEL),
        'w_ffn_up': nrm(ks[19], (L, D_MODEL, D_FF), D_MODEL),
        'w_ffn_down': nrm(ks[20], (L, D_FF, D_MODEL), D_FF),
        'final_g': gain(ks[21], (D_MODEL,)),
    }


def reference(x, norm1_g, w_in, q_a_norm_g, w_q_b, kv_a_norm_g, w_kv_b, w_o_attn,
              conv_w, conv_b, w_rgate, b_rgate, w_igate, b_igate, lru_lambda, w_o_lru,
              w_out, norm2_g, w_ffn_gate, w_ffn_up, w_ffn_down, final_g):
    for l in range(DEPTH):
        h = rmsnorm(x, norm1_g[l])
        proj = h @ w_in[l]
        q_a = proj[..., :C_QA]
        kv_a = proj[..., C_QA:C_KVA]
        k_rope_raw = proj[..., C_KVA:C_KR]
        lru_x = proj[..., C_KR:C_LX]
        lru_y = proj[..., C_LX:C_LY]
        gate_logits = proj[..., C_LY:]

        attn = mla_mixer(q_a, kv_a, k_rope_raw, q_a_norm_g[l], w_q_b[l], kv_a_norm_g[l], w_kv_b[l]) @ w_o_attn[l]
        rec = rglru_bidir(lru_x, conv_w[l], conv_b[l], w_rgate[l], b_rgate[l], w_igate[l], b_igate[l], lru_lambda[l])
        rec = (jax.nn.gelu(lru_y) * rec) @ w_o_lru[l]

        gates = jax.nn.sigmoid(gate_logits.astype(jnp.float32)).astype(x.dtype)
        g_attn = gates[..., :D_MODEL]
        g_rec = gates[..., D_MODEL:]
        merged = g_attn * attn + g_rec * rec
        x = x + merged @ w_out[l]

        h2 = rmsnorm(x, norm2_g[l])
        x = x + (jax.nn.silu(h2 @ w_ffn_gate[l]) * (h2 @ w_ffn_up[l])) @ w_ffn_down[l]
    return rmsnorm(x, final_g)
```

```cpp
#include <hip/hip_runtime.h>
#include <hip/hip_cooperative_groups.h>
#include <hip/hip_bf16.h>
#include <hip/hip_fp16.h>
#include <cstdio>
#include <cstdint>
namespace cg = cooperative_groups;

#ifndef PHASE_MASK
#define PHASE_MASK 0x3ff
#endif
#ifndef P2SUB
#define P2SUB 7
#endif
#ifndef MK_SINGLE
#define MK_SINGLE 1
#endif

constexpr int T = 65536, DM = 1024, SEQ = 2048, NBATCH = 32;
constexpr int DIN_SRC = 3488, DIN_PAD = 3584, DFF = 2816;
constexpr float EPS = 1e-6f;
constexpr float LOG2E = 1.4426950408889634f;

typedef unsigned short bf16_t;
typedef short bf16x8 __attribute__((ext_vector_type(8)));
typedef short s16x4 __attribute__((ext_vector_type(4)));
typedef float f32x4 __attribute__((ext_vector_type(4)));
typedef float f32x2 __attribute__((ext_vector_type(2)));
typedef float f32x16 __attribute__((ext_vector_type(16)));
typedef unsigned u32x4 __attribute__((ext_vector_type(4)));
typedef unsigned u32x2 __attribute__((ext_vector_type(2)));
#define LAS __attribute__((address_space(3)))

__device__ __forceinline__ unsigned cvt_pk_bf16(float lo, float hi) { unsigned r; asm volatile("v_cvt_pk_bf16_f32 %0, %1, %2" : "=v"(r) : "v"(lo), "v"(hi)); return r; }
__device__ __forceinline__ float bf_lo(unsigned w) { return __uint_as_float(w << 16); }
__device__ __forceinline__ float bf_hi(unsigned w) { return __uint_as_float(w & 0xffff0000u); }
__device__ __forceinline__ float fsigmoid(float x) { return __builtin_amdgcn_rcpf(1.0f + __builtin_amdgcn_exp2f(-x * LOG2E)); }
__device__ __forceinline__ u32x4 pack8(f32x4 a, f32x4 b) { u32x4 w; w.x = cvt_pk_bf16(a[0], a[1]); w.y = cvt_pk_bf16(a[2], a[3]); w.z = cvt_pk_bf16(b[0], b[1]); w.w = cvt_pk_bf16(b[2], b[3]); return w; }
__device__ __forceinline__ void unpack8(u32x4 w, f32x4& a, f32x4& b) { a = (f32x4){bf_lo(w.x), bf_hi(w.x), bf_lo(w.y), bf_hi(w.y)}; b = (f32x4){bf_lo(w.z), bf_hi(w.z), bf_lo(w.w), bf_hi(w.w)}; }
__device__ __forceinline__ float wave_sum(float v) {
#pragma unroll
    for (int o = 1; o < 64; o <<= 1) v += __shfl_xor(v, o);
    return v;
}

namespace pg8 {
constexpr int BM = 256, BK = 64, HALF = 128, HTB = HALF * BK * 2, STAGE_BYTES = 8 * HTB, NXCD = 8, WGM = 8;
__host__ __device__ __forceinline__ int lds_byte(int r, int c) { const int st = (r >> 4) * 2 + (c >> 5), rr = r & 15, cc = c & 31, ob = rr * 64 + cc * 2; return st * 1024 + (ob ^ (((ob >> 9) & 1) << 5)); }
__host__ __device__ __forceinline__ void stage_rc(int b, int& R, int& C) { const int st = b / 1024, sb = b % 1024, swz = sb ^ (((sb >> 9) & 1) << 5); R = (st >> 1) * 16 + swz / 64; C = (st & 1) * 32 + (swz % 64) / 2; }
__host__ __device__ __forceinline__ int perm32(int rho) { const int n = rho >> 4, i = rho & 15; return 8 * (i >> 2) + 4 * n + (i & 3); }

struct Unit { int pm, pn, sel; };
struct Gemm {
    const bf16_t *A0, *A1, *B0, *B1; int lda, ldb, K; int a_grp_shift, a_grp_cols;
    __device__ __forceinline__ const char* a_ptr(const Unit& u) const { return (const char*)(u.sel ? A1 : A0) + ((size_t)u.pm * BM * lda + (size_t)(u.pn >> a_grp_shift) * a_grp_cols) * 2; }
    __device__ __forceinline__ const char* b_ptr(const Unit& u) const { return (const char*)(u.sel ? B1 : B0) + (size_t)u.pn * BM * ldb * 2; }
};

struct StaticOrder {
    int nM, nN, nwg, G, c;
    __device__ void init(int M, int N, int G_, int c_) { nM = M / BM; nN = N / BM; nwg = nM * nN; G = G_; c = c_; }
    __device__ bool next(int i, Unit& u) const {
        const long L = (long)i * G + c; if (L >= nwg) return false;
        int wgid = (int)L; { const int q = nwg / NXCD, r = nwg % NXCD, xcd = wgid % NXCD, off = wgid / NXCD; wgid = (xcd < r ? xcd * (q + 1) : r * (q + 1) + (xcd - r) * q) + off; }
        const int nig = WGM * nN, gid = wgid / nig, fm = gid * WGM, gsz = (nM - fm) < WGM ? (nM - fm) : WGM;
        u.pm = fm + ((wgid % nig) % gsz); u.pn = (wgid % nig) / gsz; u.sel = 0; return true;
    }
};
struct DualOrder {
    StaticOrder S;
    __device__ bool next(int i, Unit& u) const { if (!S.next(i >> 1, u)) return false; u.sel = i & 1; return true; }
};

template <class Epi, class Sched, bool ALIGN_EPI>
__device__ __forceinline__ void gemm_phase(LAS unsigned char* lds, const Gemm g, const Sched& S, const Epi& E) {
    const int tid = threadIdx.x, wid = __builtin_amdgcn_readfirstlane(tid >> 6), lane = tid & 63, wr = wid >> 2, wc = wid & 3, fr = lane & 15, fq = lane >> 4;
    int lda_ = g.lda, ldb_ = g.ldb, K = g.K; asm volatile("" : "+s"(lda_), "+s"(ldb_), "+s"(K) :: "memory");
    const int nt = K / BK;
    unsigned voffA[2], voffB[2];
#pragma unroll
    for (int i = 0; i < 2; ++i) { int R, C; stage_rc(tid * 16 + i * 8192, R, C); const int Rb = Epi::PERM ? ((R & ~31) + perm32(R & 31)) : R;
        voffA[i] = (unsigned)(R * lda_ + C) * 2u; voffB[i] = (unsigned)(Rb * ldb_ + C) * 2u; }
    const size_t kstep = (size_t)(BK * 2);
    const size_t hstepA = (size_t)HALF * lda_ * 2, hstepB = (size_t)HALF * ldb_ * 2;
    const unsigned ldsw = (unsigned)wid * 1024u;
    const int aoff = lds_byte(wr * 64 + fr, fq * 8), boff = lds_byte(wc * 32 + fr, fq * 8);
#define PG8_SA(b, h) (((b) * 2 + (h)) * HTB)
#define PG8_SB(b, h) ((4 + (b) * 2 + (h)) * HTB)
#define PG8_STAGE(bufoff, gbase, voff) do { _Pragma("unroll") for (int _i = 0; _i < 2; ++_i) \
        __builtin_amdgcn_global_load_lds((const unsigned*)((const char*)(gbase) + (voff)[_i]), (LAS unsigned*)(lds + (bufoff) + ldsw + _i * 8192), 16, 0, 0); } while (0)
#define PG8_LDA(dst, b, h) do { _Pragma("unroll") for (int m = 0; m < 4; ++m) _Pragma("unroll") for (int k = 0; k < 2; ++k) dst[m][k] = *(const LAS bf16x8*)(lds + PG8_SA(b, h) + aoff + m * 2048 + k * 1024); } while (0)
#define PG8_LDB(dst, b, h) do { _Pragma("unroll") for (int n = 0; n < 2; ++n) _Pragma("unroll") for (int k = 0; k < 2; ++k) dst[n][k] = *(const LAS bf16x8*)(lds + PG8_SB(b, h) + boff + n * 2048 + k * 1024); } while (0)
#define PG8_MMA(ai, bj, At, Bt) do { __builtin_amdgcn_s_setprio(1); _Pragma("unroll") for (int m = 0; m < 4; ++m) _Pragma("unroll") for (int n = 0; n < 2; ++n) _Pragma("unroll") for (int k = 0; k < 2; ++k) \
        acc[ai][bj][m][n] = __builtin_amdgcn_mfma_f32_16x16x32_bf16(Bt[n][k], At[m][k], acc[ai][bj][m][n], 0, 0, 0); __builtin_amdgcn_s_setprio(0); } while (0)
#define PG8_WAIT_V(n) asm volatile("s_waitcnt vmcnt(" #n ")" ::: "memory")
#define PG8_WAIT_L(n) asm volatile("s_waitcnt lgkmcnt(" #n ")" ::: "memory")
#define PG8_BAR __builtin_amdgcn_s_barrier()
#define PG8_SCHED __builtin_amdgcn_sched_barrier(0)
    Unit cur, nxt; int ui = 0;
    if (!S.next(0, cur)) return;
    f32x4 acc[2][2][4][2];
#pragma unroll
    for (int a = 0; a < 2; ++a)
#pragma unroll
        for (int b = 0; b < 2; ++b)
#pragma unroll
            for (int m = 0; m < 4; ++m)
#pragma unroll
                for (int n = 0; n < 2; ++n) acc[a][b][m][n] = (f32x4){0.f, 0.f, 0.f, 0.f};
    bf16x8 At[4][2], B0[2][2], B1[2][2];
    const char* cA = g.a_ptr(cur); const char* cB = g.b_ptr(cur);
    PG8_STAGE(PG8_SB(0, 0), cB, voffB); PG8_STAGE(PG8_SB(0, 1), cB + hstepB, voffB); PG8_STAGE(PG8_SA(0, 0), cA, voffA); PG8_STAGE(PG8_SA(0, 1), cA + hstepA, voffA);
    if (wr == 1) PG8_BAR;
    PG8_WAIT_V(2); PG8_BAR;
    PG8_STAGE(PG8_SB(1, 0), cB + kstep, voffB); PG8_STAGE(PG8_SA(1, 0), cA + kstep, voffA); PG8_STAGE(PG8_SB(1, 1), cB + hstepB + kstep, voffB);
    PG8_WAIT_V(6); PG8_BAR;
    for (;;) {
        const bool has_next = S.next(ui + 1, nxt);
        const char* nA = has_next ? g.a_ptr(nxt) : cA; const char* nB = has_next ? g.b_ptr(nxt) : cB;
        for (int t = 0; t < nt; t += 2) {
            const bool last = (t == nt - 2);
            const char* a1 = cA + (size_t)(t + 1) * kstep;
            const char* a2 = last ? nA : cA + (size_t)(t + 2) * kstep; const char* b2 = last ? nB : cB + (size_t)(t + 2) * kstep;
            const char* a3 = a2 + kstep; const char* b3 = b2 + kstep;
            PG8_LDB(B0, 0, 0); PG8_LDB(B1, 0, 1); PG8_SCHED; PG8_LDA(At, 0, 0); PG8_STAGE(PG8_SA(1, 1), a1 + hstepA, voffA);
            PG8_WAIT_V(8); PG8_WAIT_L(0); PG8_BAR; PG8_MMA(0, 0, At, B0); PG8_MMA(0, 1, At, B1); PG8_BAR; PG8_SCHED;
            PG8_LDA(At, 0, 1); PG8_STAGE(PG8_SB(0, 0), b2, voffB); PG8_STAGE(PG8_SB(0, 1), b2 + hstepB, voffB); PG8_STAGE(PG8_SA(0, 0), a2, voffA);
            PG8_WAIT_V(8); PG8_WAIT_L(0); PG8_BAR; PG8_MMA(1, 0, At, B0); PG8_MMA(1, 1, At, B1); PG8_BAR; PG8_SCHED;
            PG8_LDB(B0, 1, 0); PG8_LDB(B1, 1, 1); PG8_SCHED; PG8_LDA(At, 1, 0); PG8_STAGE(PG8_SA(0, 1), a2 + hstepA, voffA);
            PG8_WAIT_V(8); PG8_WAIT_L(0); PG8_BAR; PG8_MMA(0, 0, At, B0); PG8_MMA(0, 1, At, B1); PG8_BAR; PG8_SCHED;
            PG8_LDA(At, 1, 1); PG8_STAGE(PG8_SB(1, 0), b3, voffB); PG8_STAGE(PG8_SB(1, 1), b3 + hstepB, voffB); PG8_STAGE(PG8_SA(1, 0), a3, voffA);
            PG8_WAIT_V(8); PG8_WAIT_L(0); PG8_BAR; PG8_MMA(1, 0, At, B0); PG8_MMA(1, 1, At, B1); PG8_BAR; PG8_SCHED;
        }
        if constexpr (ALIGN_EPI) { if (wr == 0) PG8_BAR; }
        PG8_SCHED; E(acc, cur, wr, wc, fr, fq); PG8_SCHED;
        if (!has_next) break;
#pragma unroll
        for (int a = 0; a < 2; ++a)
#pragma unroll
            for (int b = 0; b < 2; ++b)
#pragma unroll
                for (int m = 0; m < 4; ++m)
#pragma unroll
                    for (int n = 0; n < 2; ++n) acc[a][b][m][n] = (f32x4){0.f, 0.f, 0.f, 0.f};
        cur = nxt; cA = nA; cB = nB; ++ui;
        if constexpr (ALIGN_EPI) { if (wr == 1) PG8_BAR; }
    }
    PG8_WAIT_V(0);
    if constexpr (!ALIGN_EPI) { if (wr == 0) PG8_BAR; }
    PG8_BAR;
#undef PG8_SA
#undef PG8_SB
#undef PG8_STAGE
#undef PG8_LDA
#undef PG8_LDB
#undef PG8_MMA
#undef PG8_WAIT_V
#undef PG8_WAIT_L
#undef PG8_BAR
#undef PG8_SCHED
}
}
using pg8::Unit;
typedef f32x4 Acc[2][2][4][2];

__device__ __forceinline__ void rope4(f32x4& v0, f32x4& v1, const float* rp, int i0) {
    const f32x4 c = *(const f32x4*)(rp + i0), s = *(const f32x4*)(rp + 16 + i0);
    const f32x4 a = v0, b = v1;
    v0[0] = a[0] * c[0] - a[1] * s[0]; v0[1] = a[1] * c[0] + a[0] * s[0];
    v0[2] = a[2] * c[1] - a[3] * s[1]; v0[3] = a[3] * c[1] + a[2] * s[1];
    v1[0] = b[0] * c[2] - b[1] * s[2]; v1[1] = b[1] * c[2] + b[0] * s[2];
    v1[2] = b[2] * c[3] - b[3] * s[3]; v1[3] = b[3] * c[3] + b[2] * s[3];
}
__device__ __forceinline__ float gelu_tanh(float y) { const float z = 0.7978845608028654f * (y + 0.044715f * y * y * y); return y * fsigmoid(2.0f * z); }

struct EpiProj {
    static constexpr bool PERM = true;
    bf16_t *QA, *KVA, *KR, *LX, *LY, *GATES; float *SSQ, *SSKV; const float* rope;
    __device__ __forceinline__ void operator()(const Acc& acc, const Unit& u, int wr, int wc, int fr, int fq) const {
        const int pn = u.pn, rowt = u.pm * 256 + wr * 64 + fr, cw = wc * 32 + 8 * fq;
        if (pn >= 2) {
            bf16_t* base; int ld, mode;
            if (pn >= 6) { base = GATES + (pn - 6) * 256; ld = 2048; mode = 2; } else if (pn >= 4) { base = LY + (pn - 4) * 256; ld = 512; mode = 1; } else { base = LX + (pn - 2) * 256; ld = 512; mode = 0; }
#pragma unroll
            for (int ai = 0; ai < 2; ++ai)
#pragma unroll
                for (int m = 0; m < 4; ++m) { const unsigned row = rowt + ai * 128 + m * 16;
#pragma unroll
                    for (int bj = 0; bj < 2; ++bj) { f32x4 v0 = acc[ai][bj][m][0], v1 = acc[ai][bj][m][1];
                        if (mode == 2) {
#pragma unroll
                            for (int e = 0; e < 4; ++e) { v0[e] = fsigmoid(v0[e]); v1[e] = fsigmoid(v1[e]); } }
                        else if (mode == 1) {
#pragma unroll
                            for (int e = 0; e < 4; ++e) { v0[e] = gelu_tanh(v0[e]); v1[e] = gelu_tanh(v1[e]); } }
                        *(u32x4*)(base + row * ld + bj * 128 + cw) = pack8(v0, v1); } }
        } else if (pn == 0) {
#pragma unroll
            for (int ai = 0; ai < 2; ++ai)
#pragma unroll
                for (int m = 0; m < 4; ++m) { const unsigned row = rowt + ai * 128 + m * 16; float ss = 0.f;
#pragma unroll
                    for (int bj = 0; bj < 2; ++bj) { const f32x4 v0 = acc[ai][bj][m][0], v1 = acc[ai][bj][m][1];
                        ss += (v0[0] * v0[0] + v0[1] * v0[1]) + (v0[2] * v0[2] + v0[3] * v0[3]) + (v1[0] * v1[0] + v1[1] * v1[1]) + (v1[2] * v1[2] + v1[3] * v1[3]);
                        *(u32x4*)(QA + row * 256 + bj * 128 + cw) = pack8(v0, v1); }
                    ss += __shfl_xor(ss, 16); ss += __shfl_xor(ss, 32);
                    if (fq == 0) atomicAdd(SSQ + row, ss); }
        } else {
#pragma unroll
            for (int ai = 0; ai < 2; ++ai)
#pragma unroll
                for (int m = 0; m < 4; ++m) { const unsigned row = rowt + ai * 128 + m * 16;
                    { const f32x4 v0 = acc[ai][0][m][0], v1 = acc[ai][0][m][1];
                      float ss = (v0[0] * v0[0] + v0[1] * v0[1]) + (v0[2] * v0[2] + v0[3] * v0[3]) + (v1[0] * v1[0] + v1[1] * v1[1]) + (v1[2] * v1[2] + v1[3] * v1[3]);
                      *(u32x4*)(KVA + row * 128 + cw) = pack8(v0, v1);
                      ss += __shfl_xor(ss, 16); ss += __shfl_xor(ss, 32);
                      if (fq == 0) atomicAdd(SSKV + row, ss); }
                    if (wc == 0) { f32x4 v0 = acc[ai][1][m][0], v1 = acc[ai][1][m][1];
                      rope4(v0, v1, rope + (row & (SEQ - 1)) * 32, 4 * fq);
                      *(u32x4*)(KR + row * 32 + 8 * fq) = pack8(v0, v1); } }
        }
    }
};

struct EpiQ {
    static constexpr bool PERM = true;
    bf16_t* Q; const float* SSQ; const float* rope;
    __device__ __forceinline__ void operator()(const Acc& acc, const Unit& u, int wr, int wc, int fr, int fq) const {
        const int rowt = u.pm * 256 + wr * 64 + fr;
#pragma unroll
        for (int ai = 0; ai < 2; ++ai)
#pragma unroll
            for (int m = 0; m < 4; ++m) { const unsigned row = rowt + ai * 128 + m * 16; const float rstd = rsqrtf(SSQ[row] * (1.0f / 256.0f) + EPS); const float* rp = rope + (unsigned)((row & (SEQ - 1)) * 32);
#pragma unroll
                for (int bj = 0; bj < 2; ++bj) { const int c0 = u.pn * 256 + bj * 128 + wc * 32 + 8 * fq, d = c0 % 96;
                    f32x4 v0 = acc[ai][bj][m][0] * rstd, v1 = acc[ai][bj][m][1] * rstd;
                    if (d >= 64) rope4(v0, v1, rp, (d - 64) >> 1);
                    *(u32x4*)(Q + row * 768 + c0) = pack8(v0, v1); } asm volatile("" ::: "memory"); }
    }
};

struct EpiKV {
    static constexpr bool PERM = true;
    bf16_t *KN, *V; const float* SSKV;
    __device__ __forceinline__ void operator()(const Acc& acc, const Unit& u, int wr, int wc, int fr, int fq) const {
        const int rowt = u.pm * 256 + wr * 64 + fr; bf16_t* base = (u.pn < 2 ? KN : V) + (u.pn & 1) * 256; const unsigned cw = wc * 32 + 8 * fq;
#pragma unroll
        for (int ai = 0; ai < 2; ++ai)
#pragma unroll
            for (int m = 0; m < 4; ++m) { const unsigned row = rowt + ai * 128 + m * 16; const float rstd = rsqrtf(SSKV[row] * (1.0f / 128.0f) + EPS);
#pragma unroll
                for (int bj = 0; bj < 2; ++bj) *(u32x4*)(base + (row * 512 + bj * 128 + cw)) = pack8(acc[ai][bj][m][0] * rstd, acc[ai][bj][m][1] * rstd); asm volatile("" ::: "memory"); }
    }
};

__device__ __forceinline__ unsigned pack_h2(float lo, float hi) { const __half2 h = __floats2half2_rn(lo, hi); return *(const unsigned*)&h; }
struct EpiGates {
    static constexpr bool PERM = true;
    const bf16_t* XC; unsigned* AU; const float *br, *bi, *sp8;
    __device__ __forceinline__ void operator()(const Acc& acc, const Unit& u, int wr, int wc, int fr, int fq) const {
        const int blk = u.pn >> 1, dir = u.pn & 1, rowt = u.pm * 256 + wr * 64 + fr, j0 = wc * 32 + 8 * fq, ch = blk * 128 + j0;
        const float* pbr = br + (dir * 4 + blk) * 128; const float* pbi = bi + (dir * 4 + blk) * 128; const float* psp = sp8 + dir * 512 + blk * 128;
        unsigned* dst = AU + (size_t)dir * T * 512;
#pragma unroll
        for (int ai = 0; ai < 2; ++ai)
#pragma unroll
            for (int m = 0; m < 4; ++m) { const unsigned row = rowt + ai * 128 + m * 16;
                const u32x4 xw = *(const u32x4*)(XC + row * 512 + ch); f32x4 x0, x1; unpack8(xw, x0, x1);
                u32x4 o0, o1;
#pragma unroll
                for (int h = 0; h < 2; ++h) { const f32x4 ar = acc[ai][0][m][h] + *(const f32x4*)(pbr + (unsigned)(j0 + 4 * h)), aiq = acc[ai][1][m][h] + *(const f32x4*)(pbi + (unsigned)(j0 + 4 * h)), sp = *(const f32x4*)(psp + (unsigned)(j0 + 4 * h)), xx = h ? x1 : x0; u32x4 o;
#pragma unroll
                    for (int e = 0; e < 4; ++e) { const float rr = fsigmoid(ar[e]), ii = fsigmoid(aiq[e]); const float la = -rr * sp[e], y = 2.0f * la;
                        const float m2 = (y > -0.03f) ? -y * (1.0f + y * (0.5f + y * (0.16666667f + y * 0.041666668f))) : 1.0f - __builtin_amdgcn_exp2f(y * LOG2E);
                        const float uu = ii * xx[e] * sqrtf(m2); o[e] = pack_h2(la * LOG2E, uu); }
                    if (h) o1 = o; else o0 = o; }
                *(u32x4*)(dst + (row * 512 + ch)) = o0; *(u32x4*)(dst + (row * 512 + ch + 4)) = o1; asm volatile("" ::: "memory"); }
    }
};

struct EpiMerge {
    static constexpr bool PERM = true;
    const bf16_t* GATES; bf16_t* MERGED;
    __device__ __forceinline__ void operator()(const Acc& acc, const Unit& u, int wr, int wc, int fr, int fq) const {
        const int rowt = u.pm * 256 + wr * 64 + fr, c0 = u.pn * 256 + wc * 32 + 8 * fq;
#pragma unroll
        for (int ai = 0; ai < 2; ++ai)
#pragma unroll
            for (int m = 0; m < 4; ++m) { const unsigned row = rowt + ai * 128 + m * 16;
#pragma unroll
                for (int bj = 0; bj < 2; ++bj) { const int c = c0 + bj * 128; f32x4 g0, g1; unpack8(*(const u32x4*)(GATES + row * 2048 + u.sel * 1024 + c), g0, g1);
                    f32x4 v0 = acc[ai][bj][m][0] * g0, v1 = acc[ai][bj][m][1] * g1;
                    if (u.sel) { f32x4 p0, p1; unpack8(*(const u32x4*)(MERGED + row * 1024 + c), p0, p1); v0 += p0; v1 += p1; }
                    *(u32x4*)(MERGED + row * 1024 + c) = pack8(v0, v1); } asm volatile("" ::: "memory"); }
    }
};

struct EpiOut {
    static constexpr bool PERM = true;
    const float* X; float* X1; bf16_t* X1B; float* SS2;
    __device__ __forceinline__ void operator()(const Acc& acc, const Unit& u, int wr, int wc, int fr, int fq) const {
        const int rowt = u.pm * 256 + wr * 64 + fr, c0 = u.pn * 256 + wc * 32 + 8 * fq;
#pragma unroll
        for (int ai = 0; ai < 2; ++ai)
#pragma unroll
            for (int m = 0; m < 4; ++m) { const unsigned row = rowt + ai * 128 + m * 16; float ss = 0.f;
#pragma unroll
                for (int bj = 0; bj < 2; ++bj) { const unsigned o = row * 1024 + c0 + bj * 128;
                    const f32x4 v0 = acc[ai][bj][m][0] + *(const f32x4*)(X + o), v1 = acc[ai][bj][m][1] + *(const f32x4*)(X + o + 4);
                    ss += (v0[0] * v0[0] + v0[1] * v0[1]) + (v0[2] * v0[2] + v0[3] * v0[3]) + (v1[0] * v1[0] + v1[1] * v1[1]) + (v1[2] * v1[2] + v1[3] * v1[3]);
                    *(f32x4*)(X1 + o) = v0; *(f32x4*)(X1 + o + 4) = v1; *(u32x4*)(X1B + o) = pack8(v0, v1); }
                ss += __shfl_xor(ss, 16); ss += __shfl_xor(ss, 32);
                if (fq == 0) atomicAdd(SS2 + row, ss); asm volatile("" ::: "memory"); }
    }
};

struct EpiFfn {
    static constexpr bool PERM = true;
    bf16_t* HID; const float* SS2;
    __device__ __forceinline__ void operator()(const Acc& acc, const Unit& u, int wr, int wc, int fr, int fq) const {
        const int rowt = u.pm * 256 + wr * 64 + fr, c0 = u.pn * 128 + wc * 32 + 8 * fq;
#pragma unroll
        for (int ai = 0; ai < 2; ++ai)
#pragma unroll
            for (int m = 0; m < 4; ++m) { const unsigned row = rowt + ai * 128 + m * 16; const float rstd = rsqrtf(SS2[row] * (1.0f / 1024.0f) + EPS);
                f32x4 h0, h1;
#pragma unroll
                for (int e = 0; e < 4; ++e) { const float g0 = acc[ai][0][m][0][e] * rstd, g1 = acc[ai][0][m][1][e] * rstd;
                    h0[e] = g0 * fsigmoid(g0) * (acc[ai][1][m][0][e] * rstd); h1[e] = g1 * fsigmoid(g1) * (acc[ai][1][m][1][e] * rstd); }
                *(u32x4*)(HID + row * DFF + c0) = pack8(h0, h1); asm volatile("" ::: "memory"); }
    }
};

struct EpiDown {
    static constexpr bool PERM = true;
    float* X1; float* SS3;
    __device__ __forceinline__ void operator()(const Acc& acc, const Unit& u, int wr, int wc, int fr, int fq) const {
        const int rowt = u.pm * 256 + wr * 64 + fr, c0 = u.pn * 256 + wc * 32 + 8 * fq;
#pragma unroll
        for (int ai = 0; ai < 2; ++ai)
#pragma unroll
            for (int m = 0; m < 4; ++m) { const unsigned row = rowt + ai * 128 + m * 16; float ss = 0.f;
#pragma unroll
                for (int bj = 0; bj < 2; ++bj) { const unsigned o = row * 1024 + c0 + bj * 128;
                    const f32x4 v0 = acc[ai][bj][m][0] + *(const f32x4*)(X1 + o), v1 = acc[ai][bj][m][1] + *(const f32x4*)(X1 + o + 4);
                    ss += (v0[0] * v0[0] + v0[1] * v0[1]) + (v0[2] * v0[2] + v0[3] * v0[3]) + (v1[0] * v1[0] + v1[1] * v1[1]) + (v1[2] * v1[2] + v1[3] * v1[3]);
                    *(f32x4*)(X1 + o) = v0; *(f32x4*)(X1 + o + 4) = v1; }
                ss += __shfl_xor(ss, 16); ss += __shfl_xor(ss, 32);
                if (fq == 0) atomicAdd(SS3 + row, ss); asm volatile("" ::: "memory"); }
    }
};

namespace att {
constexpr int NW = 8, QBLK = 32, KVBLK = 64;
constexpr float SCALE = 0.10206207261596577f;
constexpr float THR = 8.f;
constexpr int SHM_V = 16384, SHM_K = 16384;
#define KSWZ(row, colB) ((row) * 256 + ((colB) ^ (((row) & 7) << 4)))
#define SBAR() __builtin_amdgcn_sched_barrier(0)
__device__ __forceinline__ int crow(int r, int hi) { return (r & 3) + 8 * (r >> 2) + 4 * hi; }
__device__ __forceinline__ void partialSM(f32x16& p0, f32x16& p1, float& m_reg, float& mn, float& alpha) {
  constexpr float C = SCALE * 1.4426950408889634f;
  float pmax = p0[0];
#pragma unroll
  for (int r = 1; r < 16; ++r) pmax = fmaxf(pmax, p0[r]);
#pragma unroll
  for (int r = 0; r < 16; ++r) pmax = fmaxf(pmax, p1[r]);
  { auto rr = __builtin_amdgcn_permlane32_swap(__float_as_uint(pmax), __float_as_uint(pmax), false, false);
    pmax = fmaxf(__uint_as_float(rr[0]), __uint_as_float(rr[1])); }
  if (__builtin_expect(__all(pmax - m_reg <= THR / SCALE), 1)) { mn = m_reg; alpha = 1.f; }
  else { mn = fmaxf(m_reg, pmax); alpha = __builtin_amdgcn_exp2f((m_reg - mn) * C); m_reg = mn; }
  float mnC = -mn * C;
#pragma unroll
  for (int r = 0; r < 16; ++r) p0[r] = fmaf(p0[r], C, mnC);
#pragma unroll
  for (int r = 0; r < 16; ++r) p1[r] = fmaf(p1[r], C, mnC);
#pragma unroll
  for (int r = 0; r < 16; ++r) p0[r] = __builtin_amdgcn_exp2f(p0[r]);
}
__device__ __forceinline__ void finishSM(f32x16& p0, f32x16& p1, float alpha, float& l_reg, bf16x8& pa0, bf16x8& pa1, bf16x8& pa2, bf16x8& pa3) {
#pragma unroll
  for (int r = 0; r < 16; ++r) p1[r] = __builtin_amdgcn_exp2f(p1[r]);
  float ps = 0;
#pragma unroll
  for (int r = 0; r < 16; ++r) ps += p0[r];
#pragma unroll
  for (int r = 0; r < 16; ++r) ps += p1[r];
  { auto rr = __builtin_amdgcn_permlane32_swap(__float_as_uint(ps), __float_as_uint(ps), false, false);
    ps = __uint_as_float(rr[0]) + __uint_as_float(rr[1]); }
  l_reg = l_reg * alpha + ps;
#define PK4(P, BASE, OUT) do { unsigned a0 = cvt_pk_bf16(P[BASE + 0], P[BASE + 1]), a1 = cvt_pk_bf16(P[BASE + 2], P[BASE + 3]);   \
    unsigned b0 = cvt_pk_bf16(P[BASE + 4], P[BASE + 5]), b1 = cvt_pk_bf16(P[BASE + 6], P[BASE + 7]);                              \
    auto r0 = __builtin_amdgcn_permlane32_swap(a0, b0, false, false); auto r1 = __builtin_amdgcn_permlane32_swap(a1, b1, false, false); \
    u32x4 w = {r0[0], r1[0], r0[1], r1[1]}; OUT = *reinterpret_cast<bf16x8*>(&w); } while (0)
  PK4(p0, 0, pa0); PK4(p0, 8, pa1); PK4(p1, 0, pa2); PK4(p1, 8, pa3);
#undef PK4
}
__device__ __forceinline__ void qkt(f32x16& p0, f32x16& p1, const char* Ks, const bf16x8* qr, int r32, int hi) {
  p0 = f32x16{}; p1 = f32x16{};
#pragma unroll
  for (int d0 = 0; d0 < 6; ++d0) { int cb = (d0 * 16 + hi * 8) * 2;
    bf16x8 b0 = *reinterpret_cast<const bf16x8*>(Ks + KSWZ(r32, cb));
    bf16x8 b1 = *reinterpret_cast<const bf16x8*>(Ks + KSWZ(32 + r32, cb));
    p0 = __builtin_amdgcn_mfma_f32_32x32x16_bf16(b0, qr[d0], p0, 0, 0, 0);
    p1 = __builtin_amdgcn_mfma_f32_32x32x16_bf16(b1, qr[d0], p1, 0, 0, 0); }
}
__device__ __forceinline__ int v_st(int k, int c) { const int kk = (k & ~0xC) | ((k & 4) << 1) | ((k & 8) >> 1); return ((kk >> 3) * 4 + (c >> 5)) * 512 + ((kk & 7) * 32 + (c & 31)) * 2; }
__device__ __forceinline__ int v_rd_base(int lane) { return ((lane & 3) << 3) | (((lane >> 2) & 3) << 6) | (((lane >> 4) & 1) << 5) | (((lane >> 5) & 1) << 8); }
constexpr int v_rd_off(int d0, int ks, int half) { return d0 * 512 + ks * 4096 + half * 2048; }
template <int OFF> __device__ __forceinline__ s16x4 tr_read(int vb) {
  s16x4 r; asm volatile("ds_read_b64_tr_b16 %0, %1 offset:%2" : "=&v"(r) : "v"(vb), "i"(OFF) : "memory"); return r;
}
template <int D0> __device__ __forceinline__ void pv_one(f32x16& od, int vb, bf16x8 pa0, bf16x8 pa1, bf16x8 pa2, bf16x8 pa3) {
  const s16x4 l0 = tr_read<v_rd_off(D0, 0, 0)>(vb), h0 = tr_read<v_rd_off(D0, 0, 1)>(vb), l1 = tr_read<v_rd_off(D0, 1, 0)>(vb), h1 = tr_read<v_rd_off(D0, 1, 1)>(vb);
  const s16x4 l2 = tr_read<v_rd_off(D0, 2, 0)>(vb), h2 = tr_read<v_rd_off(D0, 2, 1)>(vb), l3 = tr_read<v_rd_off(D0, 3, 0)>(vb), h3 = tr_read<v_rd_off(D0, 3, 1)>(vb);
  asm volatile("s_waitcnt lgkmcnt(0)" ::: "memory"); SBAR();
#define PK(L, H) (bf16x8){L[0], L[1], L[2], L[3], H[0], H[1], H[2], H[3]}
  od = __builtin_amdgcn_mfma_f32_32x32x16_bf16(pa0, PK(l0, h0), od, 0, 0, 0);
  od = __builtin_amdgcn_mfma_f32_32x32x16_bf16(pa1, PK(l1, h1), od, 0, 0, 0);
  od = __builtin_amdgcn_mfma_f32_32x32x16_bf16(pa2, PK(l2, h2), od, 0, 0, 0);
  od = __builtin_amdgcn_mfma_f32_32x32x16_bf16(pa3, PK(l3, h3), od, 0, 0, 0);
#undef PK
}
__device__ __forceinline__ void pv_d0(f32x16* o, int vb, bf16x8 pa0, bf16x8 pa1, bf16x8 pa2, bf16x8 pa3) {
  pv_one<0>(o[0], vb, pa0, pa1, pa2, pa3); pv_one<1>(o[1], vb, pa0, pa1, pa2, pa3);
}
__device__ __forceinline__ void attn_unit(const bf16_t* __restrict__ Qb, const bf16_t* __restrict__ KNh, const bf16_t* __restrict__ KRb, const bf16_t* __restrict__ Vh, bf16_t* __restrict__ Ob, char* lds) {
  const int tid = threadIdx.x, wid = tid >> 6, lane = tid & 63, r32 = lane & 31, hi = lane >> 5;
  char* V_lds = lds; char* K_lds = lds + 2 * SHM_V;
  float* ws = (float*)(lds + 2 * SHM_V + 2 * SHM_K) + wid * 64; float* li_l = ws; float* al_l = ws + 32;
  float m_reg = -1e30f, l_reg = 0; f32x16 o[2] = {}; bf16x8 qr[6];
  const bf16_t* Qw = Qb + (long)(wid * QBLK + r32) * 768 + hi * 8;
#pragma unroll
  for (int d0 = 0; d0 < 6; ++d0) qr[d0] = *reinterpret_cast<const bf16x8*>(Qw + d0 * 16);
  const int sr = tid >> 3, sc = (tid & 7) * 8, vst = v_st(sr, sc), kst = KSWZ(sr, sc * 2), krst = KSWZ(sr, 128 + (tid & 7) * 8);
  const int vb0 = (int)(uintptr_t)V_lds + v_rd_base(lane);
  struct { bf16x8 vs, ks; s16x4 kr; } sr_[2];
#define SLOAD(i, k0) do { sr_[i].vs = *reinterpret_cast<const bf16x8*>(&Vh[(long)((k0) + sr) * 512 + sc]); sr_[i].ks = *reinterpret_cast<const bf16x8*>(&KNh[(long)((k0) + sr) * 512 + sc]); \
    sr_[i].kr = *reinterpret_cast<const s16x4*>(&KRb[(long)((k0) + sr) * 32 + (tid & 7) * 4]); } while (0)
#define SWRITE(b, i) do { *(bf16x8*)(V_lds + (b) * SHM_V + vst) = sr_[i].vs; *(bf16x8*)(K_lds + (b) * SHM_K + kst) = sr_[i].ks; *(s16x4*)(K_lds + (b) * SHM_K + krst) = sr_[i].kr; } while (0)
#define SWAIT() asm volatile("s_waitcnt vmcnt(3)" ::: "memory")
#define RESC(a) do { if (__any((a) < 1.f)) { if (hi == 0) al_l[r32] = (a); asm volatile("s_waitcnt lgkmcnt(0)" ::: "memory"); \
    _Pragma("unroll") for (int d = 0; d < 2; ++d) _Pragma("unroll") for (int r = 0; r < 16; ++r) o[d][r] *= al_l[crow(r, hi)]; } } while (0)
  f32x16 pA0, pA1, pB0, pB1; float mnA, mnB, alA, alB; bf16x8 pa0, pa1, pa2, pa3; constexpr int NT = SEQ / KVBLK;
  constexpr int SE = 0, SO = 1;
  SLOAD(SE, 0); asm volatile("s_waitcnt vmcnt(0)" ::: "memory"); SWRITE(0, SE); __syncthreads();
  qkt(pA0, pA1, K_lds, qr, r32, hi); partialSM(pA0, pA1, m_reg, mnA, alA);
  SLOAD(SO, KVBLK); SLOAD(SE, 2 * KVBLK);
  SWAIT(); SWRITE(1, SO); __syncthreads();
  for (int j = 1; j + 1 < NT; j += 2) {
    SBAR(); qkt(pB0, pB1, K_lds + SHM_K, qr, r32, hi);
    finishSM(pA0, pA1, alA, l_reg, pa0, pa1, pa2, pa3); SBAR();
    SLOAD(SO, (j + 2) * KVBLK); SBAR();
    pv_d0(o, vb0, pa0, pa1, pa2, pa3); partialSM(pB0, pB1, m_reg, mnB, alB);
    __syncthreads(); SWAIT(); SWRITE(0, SE);
    RESC(alB); __syncthreads();
    SBAR(); qkt(pA0, pA1, K_lds, qr, r32, hi);
    finishSM(pB0, pB1, alB, l_reg, pa0, pa1, pa2, pa3); SBAR();
    if (j + 3 < NT) SLOAD(SE, (j + 3) * KVBLK); SBAR();
    pv_d0(o, vb0 + SHM_V, pa0, pa1, pa2, pa3); partialSM(pA0, pA1, m_reg, mnA, alA);
    __syncthreads(); SWAIT(); SWRITE(1, SO);
    RESC(alA); __syncthreads();
  }
  SBAR(); qkt(pB0, pB1, K_lds + SHM_K, qr, r32, hi);
  finishSM(pA0, pA1, alA, l_reg, pa0, pa1, pa2, pa3); SBAR();
  pv_d0(o, vb0, pa0, pa1, pa2, pa3); partialSM(pB0, pB1, m_reg, mnB, alB);
  __syncthreads(); RESC(alB);
  finishSM(pB0, pB1, alB, l_reg, pa0, pa1, pa2, pa3); SBAR();
  pv_d0(o, vb0 + SHM_V, pa0, pa1, pa2, pa3);
  if (hi == 0) li_l[r32] = l_reg; asm volatile("s_waitcnt lgkmcnt(0)" ::: "memory");
  float rli[16];
#pragma unroll
  for (int r = 0; r < 16; ++r) rli[r] = __builtin_amdgcn_rcpf(li_l[crow(r, hi)]);
  bf16_t* Ow = Ob + (long)(wid * QBLK) * 512;
#pragma unroll
  for (int r = 0; r < 16; ++r) { int orow = crow(r, hi);
#pragma unroll
    for (int d0 = 0; d0 < 2; ++d0) Ow[(long)orow * 512 + d0 * 32 + r32] = (bf16_t)(cvt_pk_bf16(o[d0][r] * rli[r], 0.f) & 0xffffu); }
  __syncthreads();
#undef SLOAD
#undef SWRITE
#undef SWAIT
#undef RESC
}
#undef KSWZ
#undef SBAR
}

__device__ __forceinline__ void h2f(unsigned w, float& lo, float& hi) { const __half2 h = *(const __half2*)&w; const float2 f = __half22float2(h); lo = f.x; hi = f.y; }
__device__ __forceinline__ void scan_item(int b, int cgp, unsigned* AU, const bf16_t* LY, bf16_t* REC, float* sc) {
    const int tid = threadIdx.x, wid = tid >> 6, lane = tid & 63, c = cgp * 64 + lane;
    const size_t r0 = (size_t)b * SEQ + wid * 256;
    unsigned* au0 = AU + c; unsigned* au1 = AU + (size_t)T * 512 + c;
#pragma unroll 1
    for (int dir = 0; dir < 2; ++dir) {
        const unsigned* au = dir ? au1 : au0; float h = 0.f, sl = 0.f;
#pragma unroll 1
        for (int blk = 0; blk < 16; ++blk) { unsigned w[16];
#pragma unroll
            for (int k = 0; k < 16; ++k) { const int rr = blk * 16 + k; w[k] = au[(r0 + (dir ? 255 - rr : rr)) * 512]; }
#pragma unroll
            for (int k = 0; k < 16; ++k) { float la, u; h2f(w[k], la, u); h = __builtin_amdgcn_exp2f(la) * h + u; sl += la; } }
        sc[(dir * 8 + wid) * 64 + lane] = __builtin_amdgcn_exp2f(sl); sc[1024 + (dir * 8 + wid) * 64 + lane] = h;
    }
    __syncthreads();
    float cin0 = 0.f, cin1 = 0.f;
    for (int k = 0; k < wid; ++k) cin0 = sc[k * 64 + lane] * cin0 + sc[1024 + k * 64 + lane];
    for (int k = 7; k > wid; --k) cin1 = sc[(8 + k) * 64 + lane] * cin1 + sc[1024 + (8 + k) * 64 + lane];
    { float h = cin0;
#pragma unroll 1
      for (int blk = 0; blk < 16; ++blk) { unsigned w[16];
#pragma unroll
        for (int k = 0; k < 16; ++k) w[k] = au0[(r0 + blk * 16 + k) * 512];
#pragma unroll
        for (int k = 0; k < 16; ++k) { float la, u; h2f(w[k], la, u); h = __builtin_amdgcn_exp2f(la) * h + u; au0[(r0 + blk * 16 + k) * 512] = __float_as_uint(h); } } }
    { float h = cin1;
#pragma unroll 1
      for (int blk = 0; blk < 16; ++blk) { unsigned w[16], f[16]; bf16_t y[16];
#pragma unroll
        for (int k = 0; k < 16; ++k) { const size_t row = r0 + 255 - (blk * 16 + k); w[k] = au1[row * 512]; f[k] = au0[row * 512]; y[k] = LY[row * 512 + c]; }
#pragma unroll
        for (int k = 0; k < 16; ++k) { const size_t row = r0 + 255 - (blk * 16 + k); float la, u; h2f(w[k], la, u); h = __builtin_amdgcn_exp2f(la) * h + u;
            const float tot = (h + __uint_as_float(f[k])) * __uint_as_float((unsigned)y[k] << 16);
            REC[row * 512 + c] = (bf16_t)(cvt_pk_bf16(tot, 0.f) & 0xffffu); } } }
    __syncthreads();
}

template <class F> __device__ __forceinline__ void xpose(bf16_t* Bt, int N, int K, F f, int gw, int NGW, int lane) {
    const int nN = N / 64, total = nN * (K / 8);
    for (int item = gw; item < total; item += NGW) { const int ng = item % nN, kc = item / nN, n = ng * 64 + lane, k0 = kc * 8;
        float v[8];
#pragma unroll
        for (int e = 0; e < 8; ++e) v[e] = f(n, k0 + e);
        u32x4 w; w.x = cvt_pk_bf16(v[0], v[1]); w.y = cvt_pk_bf16(v[2], v[3]); w.z = cvt_pk_bf16(v[4], v[5]); w.w = cvt_pk_bf16(v[6], v[7]);
        *(u32x4*)(Bt + (size_t)n * K + k0) = w; }
}

constexpr size_t MiB = 1u << 20;
constexpr size_t WS_SS = 0;
constexpr size_t WS_ROPE = 1 * MiB;
constexpr size_t WS_SP8 = WS_ROPE + 256 * 1024;
constexpr size_t WS_WIN = 2 * MiB;
constexpr size_t WS_WQB = 9 * MiB;
constexpr size_t WS_WKVB = WS_WQB + 512 * 1024;
constexpr size_t WS_WG = 10 * MiB;
constexpr size_t WS_WOA = 11 * MiB;
constexpr size_t WS_WOL = 12 * MiB;
constexpr size_t WS_WOUT = 13 * MiB;
constexpr size_t WS_WGU = 15 * MiB;
constexpr size_t WS_WD = 26 * MiB;
constexpr size_t WS_A = 40 * MiB;
constexpr size_t WS_GATES = 168 * MiB;
constexpr size_t WS_LY = 424 * MiB;
constexpr size_t WS_LX = 488 * MiB;
constexpr size_t WS_QA = 552 * MiB;
constexpr size_t WS_KVA = 584 * MiB;
constexpr size_t WS_KN = 616 * MiB;
constexpr size_t WS_V = 680 * MiB;
constexpr size_t WS_KR = 744 * MiB;
constexpr size_t WS_XC = 748 * MiB;
constexpr size_t WS_X1B = 616 * MiB;
constexpr size_t WS_HID = 168 * MiB;
constexpr size_t WS_END = 812 * MiB;

struct Args { const float* in[22]; float* out; unsigned char* ws; int ph_lo, ph_hi; };

__global__ void __launch_bounds__(512, 2) mega_fwd(Args args) {
    extern __shared__ __attribute__((aligned(16))) unsigned char lds_raw[];
    LAS unsigned char* lds = (LAS unsigned char*)lds_raw;
    const int tid = threadIdx.x, lane = tid & 63, wave = __builtin_amdgcn_readfirstlane(tid >> 6);
    const int G = gridDim.x, bid = blockIdx.x;
    const int gw = bid * 8 + wave, NGW = G * 8, gtid = bid * 512 + tid, NTH = G * 512;
    unsigned char* ws = args.ws;
    float* SSQ = (float*)(ws + WS_SS); float* SSKV = SSQ + T; float* SS2 = SSKV + T; float* SS3 = SS2 + T;
    float* ROPE = (float*)(ws + WS_ROPE); float* SP8 = (float*)(ws + WS_SP8);
    bf16_t* WIN = (bf16_t*)(ws + WS_WIN); bf16_t* WQB = (bf16_t*)(ws + WS_WQB); bf16_t* WKVB = (bf16_t*)(ws + WS_WKVB); bf16_t* WG = (bf16_t*)(ws + WS_WG);
    bf16_t* WOA = (bf16_t*)(ws + WS_WOA); bf16_t* WOL = (bf16_t*)(ws + WS_WOL); bf16_t* WOUT = (bf16_t*)(ws + WS_WOUT); bf16_t* WGU = (bf16_t*)(ws + WS_WGU); bf16_t* WD = (bf16_t*)(ws + WS_WD);
    bf16_t* XN = (bf16_t*)(ws + WS_A); bf16_t* Qb = (bf16_t*)(ws + WS_A); bf16_t* MERGED = (bf16_t*)(ws + WS_A);
    bf16_t* GATES = (bf16_t*)(ws + WS_GATES); bf16_t* LY = (bf16_t*)(ws + WS_LY); bf16_t* LX = (bf16_t*)(ws + WS_LX); bf16_t* ATT = (bf16_t*)(ws + WS_LX);
    bf16_t* QA = (bf16_t*)(ws + WS_QA); bf16_t* KVA = (bf16_t*)(ws + WS_KVA); bf16_t* REC = (bf16_t*)(ws + WS_QA);
    bf16_t* KN = (bf16_t*)(ws + WS_KN); bf16_t* Vb = (bf16_t*)(ws + WS_V); bf16_t* KR = (bf16_t*)(ws + WS_KR); bf16_t* XC = (bf16_t*)(ws + WS_XC);
    bf16_t* X1B = (bf16_t*)(ws + WS_X1B); bf16_t* HID = (bf16_t*)(ws + WS_HID);
    unsigned* AU = (unsigned*)args.out; float* X1 = args.out;
    const int lo = args.ph_lo, hi = args.ph_hi;
#define IN(k) (((PHASE_MASK >> (k)) & 1) && lo <= (k) && (k) < hi)
#define SEAM(k) do { if (IN(k) && IN((k) + 1)) { cg::this_grid().sync(); } } while (0)

    if (IN(0)) {
        for (int i = gtid; i < 4 * T; i += NTH) SSQ[i] = 0.f;
        for (int i = gtid; i < SEQ * 16; i += NTH) { const int pos = i >> 4, fi = i & 15; const float inv = 1.0f / powf(10000.0f, (float)fi * (1.0f / 16.0f)); const float ang = (float)pos * inv;
            float s, c; sincosf(ang, &s, &c); ROPE[pos * 32 + fi] = c; ROPE[pos * 32 + 16 + fi] = s; }
        for (int i = gtid; i < 1024; i += NTH) { const float lam = args.in[14][i]; SP8[i] = 8.0f * log1pf(expf(-lam)); }
        { const float* w = args.in[2];
          xpose(WIN, DIN_PAD, 1024, [=](int n, int k) -> float { int src;
              if (n < 384) src = n; else if (n < 416) { const int j = n - 384; src = 384 + (j & 1) * 16 + (j >> 1); } else if (n < 512) src = -1;
              else if (n < 1024) src = 416 + (n - 512); else if (n < 1536) src = 928 + (n - 1024); else src = 1440 + (n - 1536);
              return src < 0 ? 0.f : w[(size_t)k * DIN_SRC + src]; }, gw, NGW, lane); }
        { const float* w = args.in[4]; const float* g = args.in[3];
          xpose(WQB, 768, 256, [=](int n, int k) -> float { const int h = n / 96, dp = n % 96; int d = dp; if (dp >= 64) { const int j = dp - 64; d = 64 + (j & 1) * 16 + (j >> 1); }
              return w[(size_t)k * 768 + h * 96 + d] * g[k]; }, gw, NGW, lane); }
        { const float* w = args.in[6]; const float* g = args.in[5];
          xpose(WKVB, 1024, 128, [=](int n, int k) -> float { const int nn = n & 511, h = nn >> 6, d = nn & 63; return w[(size_t)k * 1024 + h * 128 + (n >> 9) * 64 + d] * g[k]; }, gw, NGW, lane); }
        { const float* wr_ = args.in[10]; const float* wi_ = args.in[12];
          xpose(WG, 2048, 128, [=](int n, int k) -> float { const int g = n >> 8, bj = (n >> 7) & 1, j = n & 127, blk = g >> 1, dir = g & 1;
              return (bj ? wi_ : wr_)[((size_t)(dir * 4 + blk) * 128 + k) * 128 + j]; }, gw, NGW, lane); }
        { const float* w = args.in[7]; xpose(WOA, 1024, 512, [=](int n, int k) -> float { return w[(size_t)k * 1024 + n]; }, gw, NGW, lane); }
        { const float* w = args.in[15]; xpose(WOL, 1024, 512, [=](int n, int k) -> float { return w[(size_t)k * 1024 + n]; }, gw, NGW, lane); }
        { const float* w = args.in[16]; xpose(WOUT, 1024, 1024, [=](int n, int k) -> float { return w[(size_t)k * 1024 + n]; }, gw, NGW, lane); }
        { const float* wg_ = args.in[18]; const float* wu_ = args.in[19]; const float* g = args.in[17];
          xpose(WGU, 2 * DFF, 1024, [=](int n, int k) -> float { const int pn = n >> 8, bj = (n >> 7) & 1, j = n & 127; return (bj ? wu_ : wg_)[(size_t)k * DFF + pn * 128 + j] * g[k]; }, gw, NGW, lane); }
        { const float* w = args.in[20]; xpose(WD, 1024, DFF, [=](int n, int k) -> float { return w[(size_t)k * 1024 + n]; }, gw, NGW, lane); }
        { const float* x = args.in[0]; const float* g1 = args.in[1];
          f32x4 gv[4];
#pragma unroll
          for (int j = 0; j < 4; ++j) gv[j] = *((const f32x4*)g1 + lane + 64 * j);
          for (int m = gw; m < T; m += NGW) { const f32x4* xr = (const f32x4*)(x + (size_t)m * DM) + lane; f32x4 v[4]; float s = 0.f;
#pragma unroll
              for (int j = 0; j < 4; ++j) { v[j] = xr[64 * j]; s += (v[j].x * v[j].x + v[j].y * v[j].y) + (v[j].z * v[j].z + v[j].w * v[j].w); }
              const float rstd = rsqrtf(wave_sum(s) * (1.0f / DM) + EPS);
              u32x2* o8 = (u32x2*)(XN + (size_t)m * DM) + lane;
#pragma unroll
              for (int j = 0; j < 4; ++j) { const f32x4 y = v[j] * rstd * gv[j]; u32x2 w2; w2.x = cvt_pk_bf16(y.x, y.y); w2.y = cvt_pk_bf16(y.z, y.w); o8[64 * j] = w2; } } }
    }
    SEAM(0);
    if (IN(1)) {
        pg8::Gemm g{XN, XN, WIN, WIN, 1024, 1024, 1024, 0, 0}; pg8::StaticOrder S; S.init(T, DIN_PAD, G, bid);
        EpiProj E{QA, KVA, KR, LX, LY, GATES, SSQ, SSKV, ROPE};
        pg8::gemm_phase<EpiProj, pg8::StaticOrder, true>(lds, g, S, E);
    }
    SEAM(1);
    if (IN(2)) {
        if (P2SUB & 1) { const float* cw = args.in[8]; const float* cb = args.in[9]; const int c8 = (gtid & 63) * 8;
          float w[4][8], bias[8];
#pragma unroll
          for (int e = 0; e < 8; ++e) { bias[e] = cb[c8 + e];
#pragma unroll
              for (int j = 0; j < 4; ++j) w[j][e] = cw[j * 512 + c8 + e]; }
          for (int row = gtid >> 6; row < T; row += NTH >> 6) { const int t = row & (SEQ - 1); float a[8];
#pragma unroll
              for (int e = 0; e < 8; ++e) a[e] = bias[e];
#pragma unroll
              for (int j = 0; j < 4; ++j) { const int tt = t - 2 + j; if (tt >= 0 && tt < SEQ) { f32x4 x0, x1; unpack8(*(const u32x4*)(LX + (size_t)(row - 2 + j) * 512 + c8), x0, x1);
#pragma unroll
                      for (int e = 0; e < 4; ++e) { a[e] += w[j][e] * x0[e]; a[4 + e] += w[j][4 + e] * x1[e]; } } }
              u32x4 o; o.x = cvt_pk_bf16(a[0], a[1]); o.y = cvt_pk_bf16(a[2], a[3]); o.z = cvt_pk_bf16(a[4], a[5]); o.w = cvt_pk_bf16(a[6], a[7]);
              *(u32x4*)(XC + (size_t)row * 512 + c8) = o; } }
        if (P2SUB & 2) { pg8::Gemm g{QA, QA, WQB, WQB, 256, 256, 256, 0, 0}; pg8::StaticOrder S; S.init(T, 768, G, bid); EpiQ E{Qb, SSQ, ROPE};
          pg8::gemm_phase<EpiQ, pg8::StaticOrder, true>(lds, g, S, E); }
        if (P2SUB & 4) { pg8::Gemm g{KVA, KVA, WKVB, WKVB, 128, 128, 128, 0, 0}; pg8::StaticOrder S; S.init(T, 1024, G, bid); EpiKV E{KN, Vb, SSKV};
          pg8::gemm_phase<EpiKV, pg8::StaticOrder, true>(lds, g, S, E); }
    }
    SEAM(2);
    if (IN(3)) {
        pg8::Gemm g{XC, XC, WG, WG, 512, 128, 128, 1, 128}; pg8::StaticOrder S; S.init(T, 2048, G, bid);
        EpiGates E{XC, AU, args.in[11], args.in[13], SP8};
        pg8::gemm_phase<EpiGates, pg8::StaticOrder, true>(lds, g, S, E);
    }
    SEAM(3);
    if (IN(4)) {
        __syncthreads();
        for (int it = bid; it < NBATCH * 8; it += G) scan_item(it >> 3, it & 7, AU, LY, REC, (float*)lds_raw);
        const int vcu = (G % 8 == 0) ? (bid % 8) * (G / 8) + bid / 8 : bid;
        for (int un = vcu; un < NBATCH * 8 * 8; un += G) { const int bh = un >> 3, qb = un & 7, b = bh >> 3, h = bh & 7; const size_t rb = (size_t)b * SEQ;
            att::attn_unit(Qb + (rb + qb * 256) * 768 + h * 96, KN + rb * 512 + h * 64, KR + rb * 32, Vb + rb * 512 + h * 64, ATT + (rb + qb * 256) * 512 + h * 64, (char*)lds_raw); }
    }
    SEAM(4);
    if (IN(5)) {
        pg8::Gemm g{ATT, REC, WOA, WOL, 512, 512, 512, 0, 0}; pg8::DualOrder S; S.S.init(T, 1024, G, bid);
        EpiMerge E{GATES, MERGED};
        pg8::gemm_phase<EpiMerge, pg8::DualOrder, true>(lds, g, S, E);
    }
    SEAM(5);
    if (IN(6)) {
        pg8::Gemm g{MERGED, MERGED, WOUT, WOUT, 1024, 1024, 1024, 0, 0}; pg8::StaticOrder S; S.init(T, 1024, G, bid);
        EpiOut E{args.in[0], X1, X1B, SS2};
        pg8::gemm_phase<EpiOut, pg8::StaticOrder, true>(lds, g, S, E);
    }
    SEAM(6);
    if (IN(7)) {
        pg8::Gemm g{X1B, X1B, WGU, WGU, 1024, 1024, 1024, 0, 0}; pg8::StaticOrder S; S.init(T, 2 * DFF, G, bid);
        EpiFfn E{HID, SS2};
        pg8::gemm_phase<EpiFfn, pg8::StaticOrder, true>(lds, g, S, E);
    }
    SEAM(7);
    if (IN(8)) {
        pg8::Gemm g{HID, HID, WD, WD, DFF, DFF, DFF, 0, 0}; pg8::StaticOrder S; S.init(T, 1024, G, bid);
        EpiDown E{X1, SS3};
        pg8::gemm_phase<EpiDown, pg8::StaticOrder, true>(lds, g, S, E);
    }
    SEAM(8);
    if (IN(9)) {
        const float* gf = args.in[21]; f32x4 gv[4];
#pragma unroll
        for (int j = 0; j < 4; ++j) gv[j] = *((const f32x4*)gf + lane + 64 * j);
        for (int m = gw; m < T; m += NGW) { f32x4* xr = (f32x4*)(args.out + (size_t)m * DM) + lane; const float rstd = rsqrtf(SS3[m] * (1.0f / DM) + EPS);
#pragma unroll
            for (int j = 0; j < 4; ++j) xr[64 * j] = xr[64 * j] * rstd * gv[j]; }
    }
#undef IN
#undef SEAM
}

constexpr int LDS_BYTES = 147456;
constexpr int N_PHASES = 10;
extern "C" void kernel_launch(void* const* d_in, const int* in_sizes, int n_in, void* d_out, int out_size, void* d_ws, size_t ws_size, hipStream_t stream) {
    static int grid = 0;
    if (grid == 0) {
        if (n_in != 22 || out_size != T * DM || ws_size < WS_END) { fprintf(stderr, "kernel_launch: unexpected shapes n_in %d out %d ws %zu\n", n_in, out_size, ws_size); grid = -1; return; }
        int dev = 0, cus = 0, per_cu = 0;
        hipGetDevice(&dev); hipDeviceGetAttribute(&cus, hipDeviceAttributeMultiprocessorCount, dev);
        if (hipFuncSetAttribute((const void*)mega_fwd, hipFuncAttributeMaxDynamicSharedMemorySize, LDS_BYTES) != hipSuccess) { fprintf(stderr, "kernel_launch: hipFuncSetAttribute failed\n"); grid = -1; return; }
        if (hipOccupancyMaxActiveBlocksPerMultiprocessor(&per_cu, (const void*)mega_fwd, 512, LDS_BYTES) != hipSuccess || per_cu < 1) { fprintf(stderr, "kernel_launch: occupancy query gives %d\n", per_cu); per_cu = 1; }
        (void)hipGetLastError();
        grid = cus * (per_cu > 1 ? 1 : per_cu);
        if (grid > 256) grid = 256;
    }
    if (grid < 0) return;
    Args a{};
    for (int i = 0; i < 22; ++i) a.in[i] = (const float*)d_in[i];
    a.out = (float*)d_out; a.ws = (unsigned char*)d_ws;
#if MK_SINGLE
    a.ph_lo = 0; a.ph_hi = N_PHASES;
    void* kargs[] = {&a};
    hipError_t e = hipLaunchCooperativeKernel((const void*)mega_fwd, dim3(grid), dim3(512), kargs, LDS_BYTES, stream);
    if (e != hipSuccess) fprintf(stderr, "cooperative launch failed: %s (grid %d)\n", hipGetErrorString(e), grid);
#else
    for (int p = 0; p < N_PHASES; ++p) { a.ph_lo = p; a.ph_hi = p + 1; hipLaunchKernelGGL(mega_fwd, dim3(grid), dim3(512), LDS_BYTES, stream, a); }
#endif
}
```

```cpp
#include <hip/hip_runtime.h>
#include <hip/hip_cooperative_groups.h>
#include <hip/hip_bf16.h>
#include <hip/hip_fp16.h>
#include <cstdio>
#include <cstdint>
namespace cg = cooperative_groups;

#ifndef PHASE_MASK
#define PHASE_MASK 0x3ff
#endif
#ifndef P2SUB
#define P2SUB 7
#endif
#ifndef PROBE_MASK
#define PROBE_MASK 0
#endif
#ifndef MK_SINGLE
#define MK_SINGLE 1
#endif

constexpr int T = 65536, DM = 1024, SEQ = 2048, NBATCH = 32;
constexpr int DIN_SRC = 3488, DIN_PAD = 3584, DFF = 2816;
constexpr float EPS = 1e-6f;
constexpr float LOG2E = 1.4426950408889634f;

typedef unsigned short bf16_t;
typedef short bf16x8 __attribute__((ext_vector_type(8)));
typedef short s16x4 __attribute__((ext_vector_type(4)));
typedef float f32x4 __attribute__((ext_vector_type(4)));
typedef float f32x2 __attribute__((ext_vector_type(2)));
typedef float f32x16 __attribute__((ext_vector_type(16)));
typedef unsigned u32x4 __attribute__((ext_vector_type(4)));
typedef unsigned u32x2 __attribute__((ext_vector_type(2)));
#define LAS __attribute__((address_space(3)))

__device__ __forceinline__ unsigned cvt_pk_bf16(float lo, float hi) { unsigned r; asm volatile("v_cvt_pk_bf16_f32 %0, %1, %2" : "=v"(r) : "v"(lo), "v"(hi)); return r; }
__device__ __forceinline__ float bf_lo(unsigned w) { return __uint_as_float(w << 16); }
__device__ __forceinline__ float bf_hi(unsigned w) { return __uint_as_float(w & 0xffff0000u); }
__device__ __forceinline__ float fsigmoid(float x) { return __builtin_amdgcn_rcpf(1.0f + __builtin_amdgcn_exp2f(-x * LOG2E)); }
__device__ __forceinline__ u32x4 pack8(f32x4 a, f32x4 b) { u32x4 w; w.x = cvt_pk_bf16(a[0], a[1]); w.y = cvt_pk_bf16(a[2], a[3]); w.z = cvt_pk_bf16(b[0], b[1]); w.w = cvt_pk_bf16(b[2], b[3]); return w; }
__device__ __forceinline__ void unpack8(u32x4 w, f32x4& a, f32x4& b) { a = (f32x4){bf_lo(w.x), bf_hi(w.x), bf_lo(w.y), bf_hi(w.y)}; b = (f32x4){bf_lo(w.z), bf_hi(w.z), bf_lo(w.w), bf_hi(w.w)}; }
__device__ __forceinline__ float wave_sum(float v) {
#pragma unroll
    for (int o = 1; o < 64; o <<= 1) v += __shfl_xor(v, o);
    return v;
}

namespace pg8 {
constexpr int BM = 256, BK = 64, HALF = 128, HTB = HALF * BK * 2, STAGE_BYTES = 8 * HTB, NXCD = 8, WGM = 8;
__host__ __device__ __forceinline__ int lds_byte(int r, int c) { const int st = (r >> 4) * 2 + (c >> 5), rr = r & 15, cc = c & 31, ob = rr * 64 + cc * 2; return st * 1024 + (ob ^ (((ob >> 9) & 1) << 5)); }
__host__ __device__ __forceinline__ void stage_rc(int b, int& R, int& C) { const int st = b / 1024, sb = b % 1024, swz = sb ^ (((sb >> 9) & 1) << 5); R = (st >> 1) * 16 + swz / 64; C = (st & 1) * 32 + (swz % 64) / 2; }
__host__ __device__ __forceinline__ int perm32(int rho) { const int n = rho >> 4, i = rho & 15; return 8 * (i >> 2) + 4 * n + (i & 3); }

struct Unit { int pm, pn, sel; };
struct Gemm {
    const bf16_t *A0, *A1, *B0, *B1; int lda, ldb, K; int a_grp_shift, a_grp_cols;
    __device__ __forceinline__ const char* a_ptr(const Unit& u) const { return (const char*)(u.sel ? A1 : A0) + ((size_t)u.pm * BM * lda + (size_t)(u.pn >> a_grp_shift) * a_grp_cols) * 2; }
    __device__ __forceinline__ const char* b_ptr(const Unit& u) const { return (const char*)(u.sel ? B1 : B0) + (size_t)u.pn * BM * ldb * 2; }
};

struct StaticOrder {
    int nM, nN, nwg, G, c;
    __device__ void init(int M, int N, int G_, int c_) { nM = M / BM; nN = N / BM; nwg = nM * nN; G = G_; c = c_; }
    __device__ bool next(int i, Unit& u) const {
        const long L = (long)i * G + c; if (L >= nwg) return false;
        int wgid = (int)L; { const int q = nwg / NXCD, r = nwg % NXCD, xcd = wgid % NXCD, off = wgid / NXCD; wgid = (xcd < r ? xcd * (q + 1) : r * (q + 1) + (xcd - r) * q) + off; }
        const int nig = WGM * nN, gid = wgid / nig, fm = gid * WGM, gsz = (nM - fm) < WGM ? (nM - fm) : WGM;
        u.pm = fm + ((wgid % nig) % gsz); u.pn = (wgid % nig) / gsz; u.sel = 0; return true;
    }
};
struct DualOrder {
    StaticOrder S;
    __device__ bool next(int i, Unit& u) const { if (!S.next(i >> 1, u)) return false; u.sel = i & 1; return true; }
};

template <class Epi, class Sched, bool ALIGN_EPI>
__device__ __forceinline__ void gemm_phase(LAS unsigned char* lds, const Gemm g, const Sched& S, const Epi& E) {
    int tid = threadIdx.x; asm volatile("" : "+v"(tid) :: "memory");
    const int wid = __builtin_amdgcn_readfirstlane(tid >> 6), lane = tid & 63, wr = wid >> 2, wc = wid & 3, fr = lane & 15, fq = lane >> 4;
    int lda_ = g.lda, ldb_ = g.ldb, K = g.K; asm volatile("" : "+s"(lda_), "+s"(ldb_), "+s"(K) :: "memory");
    const int nt = K / BK;
    unsigned voffA[2], voffB[2];
#pragma unroll
    for (int i = 0; i < 2; ++i) { int R, C; stage_rc(tid * 16 + i * 8192, R, C); const int Rb = Epi::PERM ? ((R & ~31) + perm32(R & 31)) : R;
        voffA[i] = (unsigned)(R * lda_ + C) * 2u; voffB[i] = (unsigned)(Rb * ldb_ + C) * 2u; }
    const size_t kstep = (size_t)(BK * 2);
    const size_t hstepA = (size_t)HALF * lda_ * 2, hstepB = (size_t)HALF * ldb_ * 2;
    const unsigned ldsw = (unsigned)wid * 1024u;
    const int aoff = lds_byte(wr * 64 + fr, fq * 8), boff = lds_byte(wc * 32 + fr, fq * 8);
#define PG8_SA(b, h) (((b) * 2 + (h)) * HTB)
#define PG8_SB(b, h) ((4 + (b) * 2 + (h)) * HTB)
#define PG8_STAGE(bufoff, gbase, voff) do { _Pragma("unroll") for (int _i = 0; _i < 2; ++_i) \
        __builtin_amdgcn_global_load_lds((const unsigned*)((const char*)(gbase) + (voff)[_i]), (LAS unsigned*)(lds + (bufoff) + ldsw + _i * 8192), 16, 0, 0); } while (0)
#define PG8_LDA(dst, b, h) do { _Pragma("unroll") for (int m = 0; m < 4; ++m) _Pragma("unroll") for (int k = 0; k < 2; ++k) dst[m][k] = *(const LAS bf16x8*)(lds + PG8_SA(b, h) + aoff + m * 2048 + k * 1024); } while (0)
#define PG8_LDB(dst, b, h) do { _Pragma("unroll") for (int n = 0; n < 2; ++n) _Pragma("unroll") for (int k = 0; k < 2; ++k) dst[n][k] = *(const LAS bf16x8*)(lds + PG8_SB(b, h) + boff + n * 2048 + k * 1024); } while (0)
#define PG8_MMA(ai, bj, At, Bt) do { __builtin_amdgcn_s_setprio(1); _Pragma("unroll") for (int m = 0; m < 4; ++m) _Pragma("unroll") for (int n = 0; n < 2; ++n) _Pragma("unroll") for (int k = 0; k < 2; ++k) \
        acc[ai][bj][m][n] = __builtin_amdgcn_mfma_f32_16x16x32_bf16(Bt[n][k], At[m][k], acc[ai][bj][m][n], 0, 0, 0); __builtin_amdgcn_s_setprio(0); } while (0)
#define PG8_WAIT_V(n) asm volatile("s_waitcnt vmcnt(" #n ")" ::: "memory")
#define PG8_WAIT_L(n) asm volatile("s_waitcnt lgkmcnt(" #n ")" ::: "memory")
#define PG8_BAR __builtin_amdgcn_s_barrier()
#define PG8_SCHED __builtin_amdgcn_sched_barrier(0)
    Unit cur, nxt; int ui = 0;
    if (!S.next(0, cur)) return;
    f32x4 acc[2][2][4][2];
#pragma unroll
    for (int a = 0; a < 2; ++a)
#pragma unroll
        for (int b = 0; b < 2; ++b)
#pragma unroll
            for (int m = 0; m < 4; ++m)
#pragma unroll
                for (int n = 0; n < 2; ++n) acc[a][b][m][n] = (f32x4){0.f, 0.f, 0.f, 0.f};
    bf16x8 At[4][2], B0[2][2], B1[2][2];
    const char* cA = g.a_ptr(cur); const char* cB = g.b_ptr(cur);
    PG8_STAGE(PG8_SB(0, 0), cB, voffB); PG8_STAGE(PG8_SB(0, 1), cB + hstepB, voffB); PG8_STAGE(PG8_SA(0, 0), cA, voffA); PG8_STAGE(PG8_SA(0, 1), cA + hstepA, voffA);
    if (wr == 1) PG8_BAR;
    PG8_WAIT_V(2); PG8_BAR;
    PG8_STAGE(PG8_SB(1, 0), cB + kstep, voffB); PG8_STAGE(PG8_SA(1, 0), cA + kstep, voffA); PG8_STAGE(PG8_SB(1, 1), cB + hstepB + kstep, voffB);
    PG8_WAIT_V(6); PG8_BAR;
    for (;;) {
        const bool has_next = S.next(ui + 1, nxt);
        const char* nA = has_next ? g.a_ptr(nxt) : cA; const char* nB = has_next ? g.b_ptr(nxt) : cB;
        for (int t = 0; t < nt; t += 2) {
            const bool last = (t == nt - 2);
            const char* a1 = cA + (size_t)(t + 1) * kstep;
            const char* a2 = last ? nA : cA + (size_t)(t + 2) * kstep; const char* b2 = last ? nB : cB + (size_t)(t + 2) * kstep;
            const char* a3 = a2 + kstep; const char* b3 = b2 + kstep;
            PG8_LDB(B0, 0, 0); PG8_LDB(B1, 0, 1); PG8_SCHED; PG8_LDA(At, 0, 0); PG8_STAGE(PG8_SA(1, 1), a1 + hstepA, voffA);
            PG8_WAIT_V(8); PG8_WAIT_L(0); PG8_BAR; PG8_MMA(0, 0, At, B0); PG8_MMA(0, 1, At, B1); PG8_BAR; PG8_SCHED;
            PG8_LDA(At, 0, 1); PG8_STAGE(PG8_SB(0, 0), b2, voffB); PG8_STAGE(PG8_SB(0, 1), b2 + hstepB, voffB); PG8_STAGE(PG8_SA(0, 0), a2, voffA);
            PG8_WAIT_V(8); PG8_WAIT_L(0); PG8_BAR; PG8_MMA(1, 0, At, B0); PG8_MMA(1, 1, At, B1); PG8_BAR; PG8_SCHED;
            PG8_LDB(B0, 1, 0); PG8_LDB(B1, 1, 1); PG8_SCHED; PG8_LDA(At, 1, 0); PG8_STAGE(PG8_SA(0, 1), a2 + hstepA, voffA);
            PG8_WAIT_V(8); PG8_WAIT_L(0); PG8_BAR; PG8_MMA(0, 0, At, B0); PG8_MMA(0, 1, At, B1); PG8_BAR; PG8_SCHED;
            PG8_LDA(At, 1, 1); PG8_STAGE(PG8_SB(1, 0), b3, voffB); PG8_STAGE(PG8_SB(1, 1), b3 + hstepB, voffB); PG8_STAGE(PG8_SA(1, 0), a3, voffA);
            PG8_WAIT_V(8); PG8_WAIT_L(0); PG8_BAR; PG8_MMA(1, 0, At, B0); PG8_MMA(1, 1, At, B1); PG8_BAR; PG8_SCHED;
        }
        if constexpr (ALIGN_EPI) { if (wr == 0) PG8_BAR; }
        PG8_SCHED; E(acc, cur, wr, wc, fr, fq); PG8_SCHED;
        if (!has_next) break;
        bool keep_ = false; if constexpr (Epi::DUAL) keep_ = (cur.sel == 0);
        if (!keep_)
#pragma unroll
        for (int a = 0; a < 2; ++a)
#pragma unroll
            for (int b = 0; b < 2; ++b)
#pragma unroll
                for (int m = 0; m < 4; ++m)
#pragma unroll
                    for (int n = 0; n < 2; ++n) acc[a][b][m][n] = (f32x4){0.f, 0.f, 0.f, 0.f};
        cur = nxt; cA = nA; cB = nB; ++ui;
        if constexpr (ALIGN_EPI) { if (wr == 1) PG8_BAR; }
    }
    PG8_WAIT_V(0);
    if constexpr (!ALIGN_EPI) { if (wr == 0) PG8_BAR; }
    PG8_BAR;
#undef PG8_SA
#undef PG8_SB
#undef PG8_STAGE
#undef PG8_LDA
#undef PG8_LDB
#undef PG8_MMA
#undef PG8_WAIT_V
#undef PG8_WAIT_L
#undef PG8_BAR
#undef PG8_SCHED
}
}
using pg8::Unit;
typedef f32x4 Acc[2][2][4][2];

__device__ __forceinline__ void rope4(f32x4& v0, f32x4& v1, const float* rp, int i0) {
    const f32x4 c = *(const f32x4*)(rp + i0), s = *(const f32x4*)(rp + 16 + i0);
    const f32x4 a = v0, b = v1;
    v0[0] = a[0] * c[0] - a[1] * s[0]; v0[1] = a[1] * c[0] + a[0] * s[0];
    v0[2] = a[2] * c[1] - a[3] * s[1]; v0[3] = a[3] * c[1] + a[2] * s[1];
    v1[0] = b[0] * c[2] - b[1] * s[2]; v1[1] = b[1] * c[2] + b[0] * s[2];
    v1[2] = b[2] * c[3] - b[3] * s[3]; v1[3] = b[3] * c[3] + b[2] * s[3];
}
__device__ __forceinline__ float gelu_tanh(float y) { const float z = 0.7978845608028654f * (y + 0.044715f * y * y * y); return y * fsigmoid(2.0f * z); }

struct EpiProj {
    static constexpr bool PERM = true, DUAL = false;
    bf16_t *QA, *KVA, *KR, *LX, *LY, *GATES; float *SSQ, *SSKV; const float* rope;
    __device__ __forceinline__ void operator()(const Acc& acc, const Unit& u, int wr, int wc, int fr, int fq) const {
        const int pn = u.pn, rowt = u.pm * 256 + wr * 64 + fr, cw = wc * 32 + 8 * fq;
        if (pn >= 2) {
            bf16_t* base; int ld, mode;
            if (pn >= 6) { base = GATES + (pn - 6) * 256; ld = 2048; mode = 2; } else if (pn >= 4) { base = LY + (pn - 4) * 256; ld = 512; mode = 1; } else { base = LX + (pn - 2) * 256; ld = 512; mode = 0; }
#pragma unroll
            for (int ai = 0; ai < 2; ++ai)
#pragma unroll
                for (int m = 0; m < 4; ++m) { const unsigned row = rowt + ai * 128 + m * 16;
#pragma unroll
                    for (int bj = 0; bj < 2; ++bj) { f32x4 v0 = acc[ai][bj][m][0], v1 = acc[ai][bj][m][1];
                        if (mode == 2) {
#pragma unroll
                            for (int e = 0; e < 4; ++e) { v0[e] = fsigmoid(v0[e]); v1[e] = fsigmoid(v1[e]); } }
                        else if (mode == 1) {
#pragma unroll
                            for (int e = 0; e < 4; ++e) { v0[e] = gelu_tanh(v0[e]); v1[e] = gelu_tanh(v1[e]); } }
                        *(u32x4*)(base + row * ld + bj * 128 + cw) = pack8(v0, v1); } }
        } else if (pn == 0) {
#pragma unroll
            for (int ai = 0; ai < 2; ++ai)
#pragma unroll
                for (int m = 0; m < 4; ++m) { const unsigned row = rowt + ai * 128 + m * 16; float ss = 0.f;
#pragma unroll
                    for (int bj = 0; bj < 2; ++bj) { const f32x4 v0 = acc[ai][bj][m][0], v1 = acc[ai][bj][m][1];
                        ss += (v0[0] * v0[0] + v0[1] * v0[1]) + (v0[2] * v0[2] + v0[3] * v0[3]) + (v1[0] * v1[0] + v1[1] * v1[1]) + (v1[2] * v1[2] + v1[3] * v1[3]);
                        *(u32x4*)(QA + row * 256 + bj * 128 + cw) = pack8(v0, v1); }
                    ss += __shfl_xor(ss, 16); ss += __shfl_xor(ss, 32);
                    if (fq == 0) atomicAdd(SSQ + row, ss); }
        } else {
#pragma unroll
            for (int ai = 0; ai < 2; ++ai)
#pragma unroll
                for (int m = 0; m < 4; ++m) { const unsigned row = rowt + ai * 128 + m * 16;
                    { const f32x4 v0 = acc[ai][0][m][0], v1 = acc[ai][0][m][1];
                      float ss = (v0[0] * v0[0] + v0[1] * v0[1]) + (v0[2] * v0[2] + v0[3] * v0[3]) + (v1[0] * v1[0] + v1[1] * v1[1]) + (v1[2] * v1[2] + v1[3] * v1[3]);
                      *(u32x4*)(KVA + row * 128 + cw) = pack8(v0, v1);
                      ss += __shfl_xor(ss, 16); ss += __shfl_xor(ss, 32);
                      if (fq == 0) atomicAdd(SSKV + row, ss); }
                    if (wc == 0) { f32x4 v0 = acc[ai][1][m][0], v1 = acc[ai][1][m][1];
                      rope4(v0, v1, rope + (row & (SEQ - 1)) * 32, 4 * fq);
                      *(u32x4*)(KR + row * 32 + 8 * fq) = pack8(v0, v1); } }
        }
    }
};

constexpr float QSCALE = 0.10206207261596577f * 1.4426950408889634f;
struct EpiQ {
    static constexpr bool PERM = true, DUAL = false;
    bf16_t* Q; const float* SSQ; const float* rope;
    __device__ __forceinline__ void operator()(const Acc& acc, const Unit& u, int wr, int wc, int fr, int fq) const {
        const int rowt = u.pm * 256 + wr * 64 + fr;
        const int c00 = u.pn * 256 + wc * 32 + 8 * fq, c01 = c00 + 128, d0 = c00 % 96, d1 = c01 % 96;
#pragma unroll
        for (int am = 0; am < 4; ++am) { const int ai = am >> 1, mb = (am & 1) * 2;
            f32x4 cs[2][2][2]; float ss[2];
#pragma unroll
            for (int mm = 0; mm < 2; ++mm) ss[mm] = SSQ[(unsigned)(rowt + ai * 128 + (mb + mm) * 16)];
#pragma unroll
            for (int mm = 0; mm < 2; ++mm) { const unsigned pos = (unsigned)(rowt + ai * 128 + (mb + mm) * 16) & (SEQ - 1);
#pragma unroll
                for (int bj = 0; bj < 2; ++bj) { const int d = bj ? d1 : d0; if (d >= 64) { const float* rp = rope + (pos * 32 + ((d - 64) >> 1)); cs[mm][bj][0] = *(const f32x4*)rp; cs[mm][bj][1] = *(const f32x4*)(rp + 16); }
                    else { cs[mm][bj][0] = (f32x4){1.f, 1.f, 1.f, 1.f}; cs[mm][bj][1] = (f32x4){0.f, 0.f, 0.f, 0.f}; } } }
#pragma unroll
            for (int mm = 0; mm < 2; ++mm) { const int m = mb + mm; const unsigned row = rowt + ai * 128 + m * 16; const float rstd = rsqrtf(ss[mm] * (1.0f / 256.0f) + EPS) * QSCALE;
#pragma unroll
                for (int bj = 0; bj < 2; ++bj) { const int c0 = bj ? c01 : c00;
                    const f32x4 a = acc[ai][bj][m][0] * rstd, b = acc[ai][bj][m][1] * rstd, c = cs[mm][bj][0], sn = cs[mm][bj][1]; f32x4 v0, v1;
                    v0[0] = a[0] * c[0] - a[1] * sn[0]; v0[1] = a[1] * c[0] + a[0] * sn[0]; v0[2] = a[2] * c[1] - a[3] * sn[1]; v0[3] = a[3] * c[1] + a[2] * sn[1];
                    v1[0] = b[0] * c[2] - b[1] * sn[2]; v1[1] = b[1] * c[2] + b[0] * sn[2]; v1[2] = b[2] * c[3] - b[3] * sn[3]; v1[3] = b[3] * c[3] + b[2] * sn[3];
                    if ((bj ? d1 : d0) < 64) { v0 = a; v1 = b; }
                    *(u32x4*)(Q + (row * 768 + c0)) = pack8(v0, v1); } }
            asm volatile("" ::: "memory"); }
    }
};

struct EpiKV {
    static constexpr bool PERM = true, DUAL = false;
    bf16_t *KN, *V; const float* SSKV;
    __device__ __forceinline__ void operator()(const Acc& acc, const Unit& u, int wr, int wc, int fr, int fq) const {
        const int rowt = u.pm * 256 + wr * 64 + fr; bf16_t* base = (u.pn < 2 ? KN : V) + (u.pn & 1) * 256; const unsigned cw = wc * 32 + 8 * fq;
        float ss[8];
#pragma unroll
        for (int i = 0; i < 8; ++i) ss[i] = SSKV[(unsigned)(rowt + (i >> 2) * 128 + (i & 3) * 16)];
#pragma unroll
        for (int ai = 0; ai < 2; ++ai)
#pragma unroll
            for (int m = 0; m < 4; ++m) { const unsigned row = rowt + ai * 128 + m * 16; const float rstd = rsqrtf(ss[ai * 4 + m] * (1.0f / 128.0f) + EPS);
#pragma unroll
                for (int bj = 0; bj < 2; ++bj) *(u32x4*)(base + (row * 512 + bj * 128 + cw)) = pack8(acc[ai][bj][m][0] * rstd, acc[ai][bj][m][1] * rstd); }
    }
};

__device__ __forceinline__ unsigned pack_h2(float lo, float hi) { const __half2 h = __floats2half2_rn(lo, hi); return *(const unsigned*)&h; }
struct EpiGates {
    static constexpr bool PERM = true, DUAL = false;
    const bf16_t* XC; unsigned* AU; const float *br, *bi, *sp8;
    __device__ __forceinline__ void operator()(const Acc& acc, const Unit& u, int wr, int wc, int fr, int fq) const {
        const int blk = u.pn >> 1, dir = u.pn & 1, rowt = u.pm * 256 + wr * 64 + fr, j0 = wc * 32 + 8 * fq, ch = blk * 128 + j0;
        const float* pbr = br + (dir * 4 + blk) * 128; const float* pbi = bi + (dir * 4 + blk) * 128; const float* psp = sp8 + dir * 512 + blk * 128;
        u32x4 xw[8];
#pragma unroll
        for (int i = 0; i < 8; ++i) xw[i] = *(const u32x4*)(XC + (unsigned)((rowt + (i >> 2) * 128 + (i & 3) * 16) * 512 + ch));
        f32x4 cbr[2], cbi[2], csp[2];
#pragma unroll
        for (int h = 0; h < 2; ++h) { cbr[h] = *(const f32x4*)(pbr + (unsigned)(j0 + 4 * h)); cbi[h] = *(const f32x4*)(pbi + (unsigned)(j0 + 4 * h)); csp[h] = *(const f32x4*)(psp + (unsigned)(j0 + 4 * h)); }
        unsigned* dst = AU + (size_t)dir * T * 512;
#pragma unroll
        for (int ai = 0; ai < 2; ++ai)
#pragma unroll
            for (int m = 0; m < 4; ++m) { const unsigned row = rowt + ai * 128 + m * 16;
                f32x4 x0, x1; unpack8(xw[ai * 4 + m], x0, x1);
                u32x4 o0, o1;
#pragma unroll
                for (int h = 0; h < 2; ++h) { const f32x4 ar = acc[ai][0][m][h] + cbr[h], aiq = acc[ai][1][m][h] + cbi[h], sp = csp[h], xx = h ? x1 : x0; u32x4 o;
#pragma unroll
                    for (int e = 0; e < 4; ++e) { const float rr = fsigmoid(ar[e]), ii = fsigmoid(aiq[e]); const float la = -rr * sp[e], y = 2.0f * la;
                        float m2 = -y * (1.0f + y * (0.5f + y * (0.16666667f + y * (0.041666668f + y * 0.0083333338f))));
                        if (__builtin_expect(__any(y < -0.25f), 0)) m2 = (y < -0.25f) ? 1.0f - __builtin_amdgcn_exp2f(y * LOG2E) : m2;
                        const float uu = ii * xx[e] * __builtin_amdgcn_sqrtf(m2); o[e] = pack_h2(la * LOG2E, uu); }
                    if (h) o1 = o; else o0 = o; }
                *(u32x4*)(dst + (row * 512 + ch)) = o0; *(u32x4*)(dst + (row * 512 + ch + 4)) = o1; }
    }
};

struct EpiMerge {
    static constexpr bool PERM = true, DUAL = true;
    const bf16_t* GATES; bf16_t* MERGED;
    __device__ __forceinline__ void operator()(Acc& acc, const Unit& u, int wr, int wc, int fr, int fq) const {
        const int rowt = u.pm * 256 + wr * 64 + fr, c0 = u.pn * 256 + wc * 32 + 8 * fq;
#pragma unroll
        for (int ai = 0; ai < 2; ++ai) {
            u32x4 gw_[4][2], hw_[4][2];
#pragma unroll
            for (int m = 0; m < 4; ++m)
#pragma unroll
                for (int bj = 0; bj < 2; ++bj) { const unsigned o = (unsigned)((rowt + ai * 128 + m * 16) * 2048 + c0 + bj * 128);
                    gw_[m][bj] = *(const u32x4*)(GATES + (o + 1024)); if (u.sel == 0) hw_[m][bj] = *(const u32x4*)(GATES + o); else hw_[m][bj] = gw_[m][bj]; }
#pragma unroll
            for (int m = 0; m < 4; ++m) { const unsigned row = rowt + ai * 128 + m * 16;
#pragma unroll
                for (int bj = 0; bj < 2; ++bj) { f32x4 r0, r1, a0, a1; unpack8(gw_[m][bj], r0, r1); unpack8(hw_[m][bj], a0, a1);
                    if (u.sel == 0) {
#pragma unroll
                        for (int e = 0; e < 4; ++e) { acc[ai][bj][m][0][e] *= a0[e] * __builtin_amdgcn_rcpf(r0[e]); acc[ai][bj][m][1][e] *= a1[e] * __builtin_amdgcn_rcpf(r1[e]); } }
                    else { *(u32x4*)(MERGED + (row * 1024 + c0 + bj * 128)) = pack8(acc[ai][bj][m][0] * r0, acc[ai][bj][m][1] * r1); } } }
            asm volatile("" ::: "memory"); }
    }
};

struct EpiOut {
    static constexpr bool PERM = true, DUAL = false;
    const float* X; bf16_t* X1B; float* SS2;
    __device__ __forceinline__ void operator()(const Acc& acc, const Unit& u, int wr, int wc, int fr, int fq) const {
        const int rowt = u.pm * 256 + wr * 64 + fr, c0 = u.pn * 256 + wc * 32 + 8 * fq;
#pragma unroll
        for (int ai = 0; ai < 2; ++ai) {
            f32x4 xv[4][2][2];
#pragma unroll
            for (int m = 0; m < 4; ++m)
#pragma unroll
                for (int bj = 0; bj < 2; ++bj) { const unsigned o = (rowt + ai * 128 + m * 16) * 1024 + c0 + bj * 128; xv[m][bj][0] = *(const f32x4*)(X + o); xv[m][bj][1] = *(const f32x4*)(X + (o + 4)); }
#pragma unroll
            for (int m = 0; m < 4; ++m) { const unsigned row = rowt + ai * 128 + m * 16; float ss = 0.f;
#pragma unroll
                for (int bj = 0; bj < 2; ++bj) { const unsigned o = row * 1024 + c0 + bj * 128;
                    const f32x4 v0 = acc[ai][bj][m][0] + xv[m][bj][0], v1 = acc[ai][bj][m][1] + xv[m][bj][1];
                    ss += (v0[0] * v0[0] + v0[1] * v0[1]) + (v0[2] * v0[2] + v0[3] * v0[3]) + (v1[0] * v1[0] + v1[1] * v1[1]) + (v1[2] * v1[2] + v1[3] * v1[3]);
                    *(u32x4*)(X1B + o) = pack8(v0, v1); }
                ss += __shfl_xor(ss, 16); ss += __shfl_xor(ss, 32);
                if (fq == 0) atomicAdd(SS2 + row, ss); }
            asm volatile("" ::: "memory"); }
    }
};

struct EpiFfn {
    static constexpr bool PERM = true, DUAL = false;
    bf16_t* HID; const float* SS2;
    __device__ __forceinline__ void operator()(const Acc& acc, const Unit& u, int wr, int wc, int fr, int fq) const {
        const int rowt = u.pm * 256 + wr * 64 + fr, c0 = u.pn * 128 + wc * 32 + 8 * fq;
        float ss[8];
#pragma unroll
        for (int i = 0; i < 8; ++i) ss[i] = SS2[(unsigned)(rowt + (i >> 2) * 128 + (i & 3) * 16)];
#pragma unroll
        for (int ai = 0; ai < 2; ++ai)
#pragma unroll
            for (int m = 0; m < 4; ++m) { const unsigned row = rowt + ai * 128 + m * 16; const float rstd = rsqrtf(ss[ai * 4 + m] * (1.0f / 1024.0f) + EPS);
                f32x4 h0, h1;
#pragma unroll
                for (int e = 0; e < 4; ++e) { const float g0 = acc[ai][0][m][0][e] * rstd, g1 = acc[ai][0][m][1][e] * rstd;
                    h0[e] = g0 * fsigmoid(g0) * (acc[ai][1][m][0][e] * rstd); h1[e] = g1 * fsigmoid(g1) * (acc[ai][1][m][1][e] * rstd); }
                *(u32x4*)(HID + (row * DFF + c0)) = pack8(h0, h1); }
    }
};

struct EpiDown {
    static constexpr bool PERM = true, DUAL = false;
    bf16_t* X1B; float* SS3;
    __device__ __forceinline__ void operator()(const Acc& acc, const Unit& u, int wr, int wc, int fr, int fq) const {
        const int rowt = u.pm * 256 + wr * 64 + fr, c0 = u.pn * 256 + wc * 32 + 8 * fq;
        u32x4 xv[8][2];
#pragma unroll
        for (int i = 0; i < 8; ++i)
#pragma unroll
            for (int bj = 0; bj < 2; ++bj) xv[i][bj] = *(const u32x4*)(X1B + (unsigned)((rowt + (i >> 2) * 128 + (i & 3) * 16) * 1024 + c0 + bj * 128));
#pragma unroll
        for (int ai = 0; ai < 2; ++ai)
#pragma unroll
            for (int m = 0; m < 4; ++m) { const unsigned row = rowt + ai * 128 + m * 16; float ss = 0.f;
#pragma unroll
                for (int bj = 0; bj < 2; ++bj) { const unsigned o = row * 1024 + c0 + bj * 128; f32x4 p0, p1; unpack8(xv[ai * 4 + m][bj], p0, p1);
                    const f32x4 v0 = acc[ai][bj][m][0] + p0, v1 = acc[ai][bj][m][1] + p1;
                    ss += (v0[0] * v0[0] + v0[1] * v0[1]) + (v0[2] * v0[2] + v0[3] * v0[3]) + (v1[0] * v1[0] + v1[1] * v1[1]) + (v1[2] * v1[2] + v1[3] * v1[3]);
                    *(u32x4*)(X1B + o) = pack8(v0, v1); }
                ss += __shfl_xor(ss, 16); ss += __shfl_xor(ss, 32);
                if (fq == 0) atomicAdd(SS3 + row, ss); }
    }
};

namespace att {
constexpr int NW = 8, QBLK = 32, KVBLK = 64;
constexpr float SCALE = 0.10206207261596577f;
constexpr float THR = 8.f;
constexpr int SHM_V = 16384, SHM_K = 16384;
#define KSWZ(row, colB) ((row) * 256 + ((colB) ^ (((row) & 7) << 4)))
#define SBAR() __builtin_amdgcn_sched_barrier(0)
__device__ __forceinline__ int crow(int r, int hi) { return (r & 3) + 8 * (r >> 2) + 4 * hi; }
template <bool FIRST> __device__ __forceinline__ void partialSM(f32x16& p0, f32x16& p1, float& mref, float& alpha, bool& hasref) {
  constexpr float THRL = THR * 1.4426950408889634f;
  float pmax = p0[0];
#pragma unroll
  for (int r = 1; r < 16; ++r) pmax = fmaxf(pmax, p0[r]);
#pragma unroll
  for (int r = 0; r < 16; ++r) pmax = fmaxf(pmax, p1[r]);
  { auto rr = __builtin_amdgcn_permlane32_swap(__float_as_uint(pmax), __float_as_uint(pmax), false, false);
    pmax = fmaxf(__uint_as_float(rr[0]), __uint_as_float(rr[1])); }
  if (__builtin_expect(__all(FIRST ? (fabsf(pmax) <= THRL) : (pmax <= THRL)), 1)) { alpha = 1.f; }
  else { const float dl = FIRST ? pmax : fmaxf(pmax, 0.f); mref += dl; alpha = FIRST ? 1.f : __builtin_amdgcn_exp2f(-dl); hasref = true;
#pragma unroll
    for (int r = 0; r < 16; ++r) { p0[r] -= dl; p1[r] -= dl; }
  }
#pragma unroll
  for (int r = 0; r < 16; ++r) p0[r] = __builtin_amdgcn_exp2f(p0[r]);
}
__device__ __forceinline__ void finishSM(f32x16& p0, f32x16& p1, float alpha, float& l_reg, bf16x8& pa0, bf16x8& pa1, bf16x8& pa2, bf16x8& pa3) {
#pragma unroll
  for (int r = 0; r < 16; ++r) p1[r] = __builtin_amdgcn_exp2f(p1[r]);
  float ps = 0;
#pragma unroll
  for (int r = 0; r < 16; ++r) ps += p0[r];
#pragma unroll
  for (int r = 0; r < 16; ++r) ps += p1[r];
  { auto rr = __builtin_amdgcn_permlane32_swap(__float_as_uint(ps), __float_as_uint(ps), false, false);
    ps = __uint_as_float(rr[0]) + __uint_as_float(rr[1]); }
  l_reg = l_reg * alpha + ps;
#define PK4(P, BASE, OUT) do { u32x4 w = {cvt_pk_bf16(P[BASE + 0], P[BASE + 1]), cvt_pk_bf16(P[BASE + 2], P[BASE + 3]), cvt_pk_bf16(P[BASE + 4], P[BASE + 5]), cvt_pk_bf16(P[BASE + 6], P[BASE + 7])}; \
    OUT = *reinterpret_cast<bf16x8*>(&w); } while (0)
  PK4(p0, 0, pa0); PK4(p0, 8, pa1); PK4(p1, 0, pa2); PK4(p1, 8, pa3);
#undef PK4
}
__device__ __forceinline__ void qkt(f32x16& p0, f32x16& p1, const char* Ks, const bf16x8* qr, float mref, bool hasref, int r32, int hi) {
  p0 = f32x16{}; p1 = f32x16{};
#pragma unroll
  for (int d0 = 0; d0 < 6; ++d0) { int cb = (d0 * 16 + hi * 8) * 2;
    bf16x8 b0 = *reinterpret_cast<const bf16x8*>(Ks + KSWZ(r32, cb));
    bf16x8 b1 = *reinterpret_cast<const bf16x8*>(Ks + KSWZ(32 + r32, cb));
    p0 = __builtin_amdgcn_mfma_f32_32x32x16_bf16(b0, qr[d0], p0, 0, 0, 0);
    p1 = __builtin_amdgcn_mfma_f32_32x32x16_bf16(b1, qr[d0], p1, 0, 0, 0); }
  if (__builtin_expect(hasref, 0)) {
#pragma unroll
    for (int r = 0; r < 16; ++r) { p0[r] -= mref; p1[r] -= mref; } }
}
__device__ __forceinline__ int v_st(int k, int c) { const int kk = k; return ((kk >> 3) * 4 + (c >> 5)) * 512 + ((kk & 7) * 32 + (c & 31)) * 2; }
__device__ __forceinline__ int v_rd_base(int lane) { return ((lane & 3) << 3) | (((lane >> 2) & 3) << 6) | (((lane >> 4) & 1) << 5) | (((lane >> 5) & 1) << 8); }
constexpr int v_rd_off(int d0, int ks, int half) { return d0 * 512 + ks * 4096 + half * 2048; }
typedef short v4i16_t __attribute__((ext_vector_type(4)));
typedef LAS const char* lds_cptr;
__device__ __forceinline__ s16x4 vtr(lds_cptr p) { return __builtin_bit_cast(s16x4, __builtin_amdgcn_ds_read_tr16_b64_v4i16((LAS v4i16_t*)p)); }
template <int D0> __device__ __forceinline__ void pv_one(f32x16& od, lds_cptr vp, bf16x8 pa0, bf16x8 pa1, bf16x8 pa2, bf16x8 pa3) {
  const s16x4 l0 = vtr(vp + v_rd_off(D0, 0, 0)), h0 = vtr(vp + v_rd_off(D0, 0, 1)), l1 = vtr(vp + v_rd_off(D0, 1, 0)), h1 = vtr(vp + v_rd_off(D0, 1, 1));
  const s16x4 l2 = vtr(vp + v_rd_off(D0, 2, 0)), h2 = vtr(vp + v_rd_off(D0, 2, 1)), l3 = vtr(vp + v_rd_off(D0, 3, 0)), h3 = vtr(vp + v_rd_off(D0, 3, 1));
#define PK(L, H) (bf16x8){L[0], L[1], L[2], L[3], H[0], H[1], H[2], H[3]}
  od = __builtin_amdgcn_mfma_f32_32x32x16_bf16(pa0, PK(l0, h0), od, 0, 0, 0);
  od = __builtin_amdgcn_mfma_f32_32x32x16_bf16(pa1, PK(l1, h1), od, 0, 0, 0);
  od = __builtin_amdgcn_mfma_f32_32x32x16_bf16(pa2, PK(l2, h2), od, 0, 0, 0);
  od = __builtin_amdgcn_mfma_f32_32x32x16_bf16(pa3, PK(l3, h3), od, 0, 0, 0);
#undef PK
}
__device__ __forceinline__ void pv_d0(f32x16* o, lds_cptr vp, bf16x8 pa0, bf16x8 pa1, bf16x8 pa2, bf16x8 pa3) {
  pv_one<0>(o[0], vp, pa0, pa1, pa2, pa3); pv_one<1>(o[1], vp, pa0, pa1, pa2, pa3);
}
__device__ __forceinline__ void attn_unit(const bf16_t* __restrict__ Qb, const bf16_t* __restrict__ KNh, const bf16_t* __restrict__ KRb, const bf16_t* __restrict__ Vh, bf16_t* __restrict__ Ob, char* lds) {
  const int tid = threadIdx.x, wid = tid >> 6, lane = tid & 63, r32 = lane & 31, hi = lane >> 5;
  char* V_lds = lds; char* K_lds = lds + 2 * SHM_V;
  float* ws = (float*)(lds + 2 * SHM_V + 2 * SHM_K) + wid * 64; float* li_l = ws; float* al_l = ws + 32;
  float mref = 0.f, l_reg = 0; bool hasref = false; f32x16 o[2] = {}; bf16x8 qr[6];
  const bf16_t* Qw = Qb + (long)(wid * QBLK + r32) * 768 + hi * 8;
#pragma unroll
  for (int d0 = 0; d0 < 6; ++d0) qr[d0] = *reinterpret_cast<const bf16x8*>(Qw + d0 * 16);
  const int sr = tid >> 3, sc = (tid & 7) * 8, vst = v_st(sr, sc), kst = KSWZ(sr, sc * 2), krst = KSWZ(sr, 128 + (tid & 7) * 8);
  const lds_cptr vb0 = (lds_cptr)(LAS char*)lds + v_rd_base(lane);
  struct { bf16x8 vs, ks; s16x4 kr; } sr_[2];
  const unsigned lo_kv = (unsigned)(sr * 512 + sc), lo_kr = (unsigned)(sr * 32 + (tid & 7) * 4);
#define SLOAD(i, k0) do { const bf16_t* vt_ = Vh + (size_t)(k0) * 512; const bf16_t* kt_ = KNh + (size_t)(k0) * 512; const bf16_t* rt_ = KRb + (size_t)(k0) * 32; \
    sr_[i].vs = *reinterpret_cast<const bf16x8*>(vt_ + lo_kv); sr_[i].ks = *reinterpret_cast<const bf16x8*>(kt_ + lo_kv); sr_[i].kr = *reinterpret_cast<const s16x4*>(rt_ + lo_kr); } while (0)
#define SWRITE(b, i) do { *(bf16x8*)(V_lds + (b) * SHM_V + vst) = sr_[i].vs; *(bf16x8*)(K_lds + (b) * SHM_K + kst) = sr_[i].ks; *(s16x4*)(K_lds + (b) * SHM_K + krst) = sr_[i].kr; } while (0)
#define SWAIT() asm volatile("s_waitcnt vmcnt(3)" ::: "memory")
#define RESC(a) do { if (__any((a) < 1.f)) { if (hi == 0) al_l[r32] = (a); asm volatile("s_waitcnt lgkmcnt(0)" ::: "memory"); \
    _Pragma("unroll") for (int d = 0; d < 2; ++d) _Pragma("unroll") for (int r = 0; r < 16; ++r) o[d][r] *= al_l[crow(r, hi)]; } } while (0)
  f32x16 pA0, pA1, pB0, pB1; float alA, alB; bf16x8 pa0, pa1, pa2, pa3; constexpr int NT = SEQ / KVBLK;
  constexpr int SE = 0, SO = 1;
  SLOAD(SE, 0); asm volatile("s_waitcnt vmcnt(0)" ::: "memory"); SWRITE(0, SE); __syncthreads();
  qkt(pA0, pA1, K_lds, qr, mref, hasref, r32, hi); partialSM<true>(pA0, pA1, mref, alA, hasref);
  SLOAD(SO, KVBLK); SLOAD(SE, 2 * KVBLK);
  SWAIT(); SWRITE(1, SO); __syncthreads();
  for (int j = 1; j + 1 < NT; j += 2) {
    SBAR(); qkt(pB0, pB1, K_lds + SHM_K, qr, mref, hasref, r32, hi);
    finishSM(pA0, pA1, alA, l_reg, pa0, pa1, pa2, pa3); SBAR();
    SLOAD(SO, (j + 2) * KVBLK); SBAR();
    pv_d0(o, vb0, pa0, pa1, pa2, pa3); partialSM<false>(pB0, pB1, mref, alB, hasref);
    __syncthreads(); SWAIT(); SWRITE(0, SE);
    RESC(alB); __syncthreads();
    SBAR(); qkt(pA0, pA1, K_lds, qr, mref, hasref, r32, hi);
    finishSM(pB0, pB1, alB, l_reg, pa0, pa1, pa2, pa3); SBAR();
    if (j + 3 < NT) SLOAD(SE, (j + 3) * KVBLK); SBAR();
    pv_d0(o, vb0 + SHM_V, pa0, pa1, pa2, pa3); partialSM<false>(pA0, pA1, mref, alA, hasref);
    __syncthreads(); SWAIT(); SWRITE(1, SO);
    RESC(alA); __syncthreads();
  }
  SBAR(); qkt(pB0, pB1, K_lds + SHM_K, qr, mref, hasref, r32, hi);
  finishSM(pA0, pA1, alA, l_reg, pa0, pa1, pa2, pa3); SBAR();
  pv_d0(o, vb0, pa0, pa1, pa2, pa3); partialSM<false>(pB0, pB1, mref, alB, hasref);
  __syncthreads(); RESC(alB);
  finishSM(pB0, pB1, alB, l_reg, pa0, pa1, pa2, pa3); SBAR();
  pv_d0(o, vb0 + SHM_V, pa0, pa1, pa2, pa3);
  if (hi == 0) li_l[r32] = l_reg; asm volatile("s_waitcnt lgkmcnt(0)" ::: "memory");
  float rli[16];
#pragma unroll
  for (int r = 0; r < 16; ++r) rli[r] = __builtin_amdgcn_rcpf(li_l[crow(r, hi)]);
  bf16_t* Ow = Ob + (long)(wid * QBLK) * 512;
#pragma unroll
  for (int r = 0; r < 16; ++r) { int orow = crow(r, hi);
#pragma unroll
    for (int d0 = 0; d0 < 2; ++d0) Ow[(long)orow * 512 + d0 * 32 + r32] = (bf16_t)(cvt_pk_bf16(o[d0][r] * rli[r], 0.f) & 0xffffu); }
  __syncthreads();
#undef SLOAD
#undef SWRITE
#undef SWAIT
#undef RESC
}
#undef KSWZ
#undef SBAR
}

__device__ __forceinline__ void h2f(unsigned w, float& lo, float& hi) { const __half2 h = *(const __half2*)&w; const float2 f = __half22float2(h); lo = f.x; hi = f.y; }
__device__ __forceinline__ void scan_item(int b, int cgp, unsigned* AU, const bf16_t* LY, bf16_t* REC, float* sc) {
    const int tid = threadIdx.x, wid = tid >> 6, lane = tid & 63, c = cgp * 64 + lane;
    const unsigned r0 = (unsigned)b * SEQ + wid * 256;
    unsigned* au0 = AU + c; unsigned* au1 = AU + (size_t)T * 512 + c; const bf16_t* ly = LY + c; bf16_t* rec = REC + c;
#define SC_STEP(W, H) do { float la_, u_; h2f(W, la_, u_); H = __builtin_amdgcn_exp2f(la_) * H + u_; } while (0)
    { float hf = 0.f, hb = 0.f, slf = 0.f, slb = 0.f; unsigned fa[16], ba[16], fb[16], bb[16];
#pragma unroll
      for (int k = 0; k < 16; ++k) { fa[k] = au0[(r0 + k) * 512]; ba[k] = au1[(r0 + 255 - k) * 512]; }
#pragma unroll 1
      for (int blk = 0; blk < 16; blk += 2) {
#pragma unroll
          for (int k = 0; k < 16; ++k) { fb[k] = au0[(r0 + (blk + 1) * 16 + k) * 512]; bb[k] = au1[(r0 + 255 - ((blk + 1) * 16 + k)) * 512]; }
#pragma unroll
          for (int k = 0; k < 16; ++k) { float la, u; h2f(fa[k], la, u); hf = __builtin_amdgcn_exp2f(la) * hf + u; slf += la; h2f(ba[k], la, u); hb = __builtin_amdgcn_exp2f(la) * hb + u; slb += la; }
          if (blk + 2 < 16) {
#pragma unroll
              for (int k = 0; k < 16; ++k) { fa[k] = au0[(r0 + (blk + 2) * 16 + k) * 512]; ba[k] = au1[(r0 + 255 - ((blk + 2) * 16 + k)) * 512]; } }
#pragma unroll
          for (int k = 0; k < 16; ++k) { float la, u; h2f(fb[k], la, u); hf = __builtin_amdgcn_exp2f(la) * hf + u; slf += la; h2f(bb[k], la, u); hb = __builtin_amdgcn_exp2f(la) * hb + u; slb += la; }
      }
      sc[wid * 64 + lane] = __builtin_amdgcn_exp2f(slf); sc[1024 + wid * 64 + lane] = hf;
      sc[(8 + wid) * 64 + lane] = __builtin_amdgcn_exp2f(slb); sc[1024 + (8 + wid) * 64 + lane] = hb; }
    __syncthreads();
    float cin0 = 0.f, cin1 = 0.f;
    for (int k = 0; k < wid; ++k) cin0 = sc[k * 64 + lane] * cin0 + sc[1024 + k * 64 + lane];
    for (int k = 7; k > wid; --k) cin1 = sc[(8 + k) * 64 + lane] * cin1 + sc[1024 + (8 + k) * 64 + lane];
    { float h = cin0; unsigned wa[16], wb[16];
#pragma unroll
      for (int k = 0; k < 16; ++k) wa[k] = au0[(r0 + k) * 512];
#pragma unroll 1
      for (int blk = 0; blk < 16; blk += 2) {
#pragma unroll
          for (int k = 0; k < 16; ++k) wb[k] = au0[(r0 + (blk + 1) * 16 + k) * 512];
#pragma unroll
          for (int k = 0; k < 16; ++k) { SC_STEP(wa[k], h); rec[(r0 + blk * 16 + k) * 512] = (bf16_t)(cvt_pk_bf16(h, 0.f) & 0xffffu); }
          if (blk + 2 < 16) {
#pragma unroll
              for (int k = 0; k < 16; ++k) wa[k] = au0[(r0 + (blk + 2) * 16 + k) * 512]; }
#pragma unroll
          for (int k = 0; k < 16; ++k) { SC_STEP(wb[k], h); rec[(r0 + (blk + 1) * 16 + k) * 512] = (bf16_t)(cvt_pk_bf16(h, 0.f) & 0xffffu); }
      } }
    { float h = cin1; unsigned wa[16], wb[16]; bf16_t fa[16], fb[16], ya[16], yb[16];
#pragma unroll
      for (int k = 0; k < 16; ++k) { const unsigned row = r0 + 255 - k; wa[k] = au1[row * 512]; fa[k] = rec[row * 512]; ya[k] = ly[row * 512]; }
#pragma unroll 1
      for (int blk = 0; blk < 16; blk += 2) {
#pragma unroll
          for (int k = 0; k < 16; ++k) { const unsigned row = r0 + 255 - ((blk + 1) * 16 + k); wb[k] = au1[row * 512]; fb[k] = rec[row * 512]; yb[k] = ly[row * 512]; }
#pragma unroll
          for (int k = 0; k < 16; ++k) { const unsigned row = r0 + 255 - (blk * 16 + k); SC_STEP(wa[k], h);
              const float tot = (h + __uint_as_float((unsigned)fa[k] << 16)) * __uint_as_float((unsigned)ya[k] << 16); rec[row * 512] = (bf16_t)(cvt_pk_bf16(tot, 0.f) & 0xffffu); }
          if (blk + 2 < 16) {
#pragma unroll
              for (int k = 0; k < 16; ++k) { const unsigned row = r0 + 255 - ((blk + 2) * 16 + k); wa[k] = au1[row * 512]; fa[k] = rec[row * 512]; ya[k] = ly[row * 512]; } }
#pragma unroll
          for (int k = 0; k < 16; ++k) { const unsigned row = r0 + 255 - ((blk + 1) * 16 + k); SC_STEP(wb[k], h);
              const float tot = (h + __uint_as_float((unsigned)fb[k] << 16)) * __uint_as_float((unsigned)yb[k] << 16); rec[row * 512] = (bf16_t)(cvt_pk_bf16(tot, 0.f) & 0xffffu); }
      } }
#undef SC_STEP
    __syncthreads();
}

template <class F> __device__ __forceinline__ void xpose(bf16_t* Bt, int N, int K, F f, int gw, int NGW, int lane) {
    const int nN = N / 64, total = nN * (K / 8);
    for (int item = gw; item < total; item += NGW) { const int ng = item % nN, kc = item / nN, n = ng * 64 + lane, k0 = kc * 8;
        float v[8];
#pragma unroll
        for (int e = 0; e < 8; ++e) v[e] = f(n, k0 + e);
        u32x4 w; w.x = cvt_pk_bf16(v[0], v[1]); w.y = cvt_pk_bf16(v[2], v[3]); w.z = cvt_pk_bf16(v[4], v[5]); w.w = cvt_pk_bf16(v[6], v[7]);
        *(u32x4*)(Bt + (size_t)n * K + k0) = w; }
}


template <class F> __device__ __forceinline__ void xpose_one(bf16_t* Bt, int N, int K, F f, int item, int lane) {
    const int nN = N / 64, n = (item % nN) * 64 + lane, k0 = (item / nN) * 8;
    float v[8];
#pragma unroll
    for (int e = 0; e < 8; ++e) v[e] = f(n, k0 + e);
    u32x4 w; w.x = cvt_pk_bf16(v[0], v[1]); w.y = cvt_pk_bf16(v[2], v[3]); w.z = cvt_pk_bf16(v[4], v[5]); w.w = cvt_pk_bf16(v[6], v[7]);
    *(u32x4*)(Bt + (size_t)n * K + k0) = w;
}

#define XB_TMO      128
#define XB_XCNT(j)  (256  + 64 * (j))
#define XB_XSUB(j)  (1280 + 64 * (j))
#define XB_XGEN(j)  (2304 + 64 * (j))
#define XB_TOP      3328
#define XB_TOPGEN   3392
#define XCD_BAR_WORDS 3456
#define XB_SPIN_CAP (1u << 18)
__device__ __forceinline__ unsigned xb_ld(unsigned* p)              { return __hip_atomic_load(p, __ATOMIC_RELAXED, __HIP_MEMORY_SCOPE_AGENT); }
__device__ __forceinline__ unsigned xb_add(unsigned* p, unsigned v) { return __hip_atomic_fetch_add(p, v, __ATOMIC_RELAXED, __HIP_MEMORY_SCOPE_AGENT); }
__device__ __forceinline__ unsigned xb_xcc_id() { return (unsigned)__builtin_amdgcn_s_getreg((3 << 11) | 20) & 0xFu; }
#define XB_SPIN(cond, bar) do { unsigned _sp = 0; while (cond) { __builtin_amdgcn_s_sleep(1); \
    if ((++_sp & 255u) == 0u) { if (xb_ld(&(bar)[XB_TMO])) break; if (_sp > XB_SPIN_CAP) { atomicAdd(&(bar)[XB_TMO], 1u); break; } } } } while (0)
struct XcdBarrier { unsigned* bar; unsigned x; volatile LAS unsigned* st; };
__device__ __forceinline__ XcdBarrier xcd_barrier_post(unsigned* bar, volatile LAS unsigned* st) {
    XcdBarrier b; b.bar = bar; b.x = xb_xcc_id(); b.st = st;
    if (threadIdx.x == 0) (void)xb_add(&bar[XB_XCNT(b.x)], 1u);
    return b;
}
__device__ __forceinline__ void xcd_barrier_complete(unsigned* bar, unsigned x, unsigned& nloc, unsigned& nx) {
    const unsigned G = gridDim.x * gridDim.y * gridDim.z;
    unsigned sum, cnt, mine, sp = 0u;
    for (;;) {
        sum = 0u; cnt = 0u; mine = 0u;
#pragma unroll
        for (unsigned j = 0; j < 16; ++j) { const unsigned c = xb_ld(&bar[XB_XCNT(j)]); sum += c; cnt += (c > 0u) ? 1u : 0u; mine = (j == x) ? c : mine; }
        if (sum == G) break;
        __builtin_amdgcn_s_sleep(1);
        if ((++sp & 255u) == 0u) { if (xb_ld(&bar[XB_TMO])) break; if (sp > XB_SPIN_CAP) { atomicAdd(&bar[XB_TMO], 1u); break; } }
    }
    nloc = mine > 0u ? mine : 1u; nx = cnt > 0u ? cnt : 1u;
}
__device__ __forceinline__ void xcd_barrier(const XcdBarrier& b) {
    asm volatile("s_waitcnt vmcnt(0)" ::: "memory");
    __syncthreads();
    if (threadIdx.x == 0) {
        unsigned* bar = b.bar;
        __builtin_amdgcn_s_waitcnt(0);
        unsigned nloc = b.st[0], nx = b.st[1];
        if (nloc == 0u) { xcd_barrier_complete(bar, b.x, nloc, nx); b.st[0] = nloc; b.st[1] = nx; }
        const unsigned old = xb_add(&bar[XB_XSUB(b.x)], 1u);
        const unsigned gen = old / nloc;
        if (old + 1u == (gen + 1u) * nloc) {
            __builtin_amdgcn_fence(__ATOMIC_RELEASE, "agent");
            asm volatile("s_waitcnt vmcnt(0)" ::: "memory");
            const unsigned og = xb_add(&bar[XB_TOP], 1u);
            const unsigned tg = og / nx;
            if (og + 1u == (tg + 1u) * nx) xb_add(&bar[XB_TOPGEN], 1u);
            else XB_SPIN(xb_ld(&bar[XB_TOPGEN]) == tg, bar);
            __builtin_amdgcn_fence(__ATOMIC_ACQUIRE, "agent");
            xb_add(&bar[XB_XGEN(b.x)], 1u);
            asm volatile("s_waitcnt vmcnt(0)" ::: "memory");
        } else {
            XB_SPIN(xb_ld(&bar[XB_XGEN(b.x)]) == gen, bar);
            __builtin_amdgcn_fence(__ATOMIC_ACQUIRE, "agent");
            asm volatile("s_waitcnt vmcnt(0)" ::: "memory");
        }
    }
    __syncthreads();
}

constexpr size_t MiB = 1u << 20;
constexpr size_t WS_SS = 0;
constexpr size_t WS_ROPE = 1 * MiB;
constexpr size_t WS_SP8 = WS_ROPE + 256 * 1024;
constexpr size_t WS_BAR = 1 * MiB + 512 * 1024;
constexpr size_t WS_WIN = 2 * MiB;
constexpr size_t WS_WQB = 9 * MiB;
constexpr size_t WS_WKVB = WS_WQB + 512 * 1024;
constexpr size_t WS_WG = 10 * MiB;
constexpr size_t WS_WOA = 11 * MiB;
constexpr size_t WS_WOL = 12 * MiB;
constexpr size_t WS_WOUT = 13 * MiB;
constexpr size_t WS_WGU = 15 * MiB;
constexpr size_t WS_WD = 26 * MiB;
constexpr size_t WS_A = 40 * MiB;
constexpr size_t WS_GATES = 168 * MiB;
constexpr size_t WS_LY = 424 * MiB;
constexpr size_t WS_LX = 488 * MiB;
constexpr size_t WS_QA = 552 * MiB;
constexpr size_t WS_KVA = 584 * MiB;
constexpr size_t WS_KN = 616 * MiB;
constexpr size_t WS_V = 680 * MiB;
constexpr size_t WS_KR = 744 * MiB;
constexpr size_t WS_XC = 748 * MiB;
constexpr size_t WS_X1B = 616 * MiB;
constexpr size_t WS_HID = 168 * MiB;
constexpr size_t WS_END = 812 * MiB;

struct Args { const float* in[22]; float* out; unsigned char* ws; int ph_lo, ph_hi; };

__global__ void __launch_bounds__(512, 2) mega_fwd(Args args) {
    extern __shared__ __attribute__((aligned(16))) unsigned char lds_raw[];
    LAS unsigned char* lds = (LAS unsigned char*)lds_raw;
    const int tid = threadIdx.x;
#define PHASE_IDS const int lane = threadIdx.x & 63, wave = __builtin_amdgcn_readfirstlane(threadIdx.x >> 6), gw = bid * 8 + wave, NGW = G * 8, gtid = bid * 512 + (int)threadIdx.x, NTH = G * 512; (void)lane; (void)gw; (void)NGW; (void)gtid; (void)NTH
    const int G = gridDim.x, bid = blockIdx.x;
    unsigned char* ws = args.ws;
    float* SSQ = (float*)(ws + WS_SS); float* SSKV = SSQ + T; float* SS2 = SSKV + T; float* SS3 = SS2 + T;
    float* ROPE = (float*)(ws + WS_ROPE); float* SP8 = (float*)(ws + WS_SP8);
    bf16_t* WIN = (bf16_t*)(ws + WS_WIN); bf16_t* WQB = (bf16_t*)(ws + WS_WQB); bf16_t* WKVB = (bf16_t*)(ws + WS_WKVB); bf16_t* WG = (bf16_t*)(ws + WS_WG);
    bf16_t* WOA = (bf16_t*)(ws + WS_WOA); bf16_t* WOL = (bf16_t*)(ws + WS_WOL); bf16_t* WOUT = (bf16_t*)(ws + WS_WOUT); bf16_t* WGU = (bf16_t*)(ws + WS_WGU); bf16_t* WD = (bf16_t*)(ws + WS_WD);
    bf16_t* XN = (bf16_t*)(ws + WS_A); bf16_t* Qb = (bf16_t*)(ws + WS_A); bf16_t* MERGED = (bf16_t*)(ws + WS_A);
    bf16_t* GATES = (bf16_t*)(ws + WS_GATES); bf16_t* LY = (bf16_t*)(ws + WS_LY); bf16_t* LX = (bf16_t*)(ws + WS_LX); bf16_t* ATT = (bf16_t*)(ws + WS_LX);
    bf16_t* QA = (bf16_t*)(ws + WS_QA); bf16_t* KVA = (bf16_t*)(ws + WS_KVA); bf16_t* REC = (bf16_t*)(ws + WS_QA);
    bf16_t* KN = (bf16_t*)(ws + WS_KN); bf16_t* Vb = (bf16_t*)(ws + WS_V); bf16_t* KR = (bf16_t*)(ws + WS_KR); bf16_t* XC = (bf16_t*)(ws + WS_XC);
    bf16_t* X1B = (bf16_t*)(ws + WS_X1B); bf16_t* HID = (bf16_t*)(ws + WS_HID);
    unsigned* AU = (unsigned*)args.out;
    const int lo = args.ph_lo, hi = args.ph_hi;
    volatile LAS unsigned* xst = (volatile LAS unsigned*)(lds + 140032);
    if (tid < 2) xst[tid] = 0u;
    __syncthreads();
    XcdBarrier xbar; xbar.bar = (unsigned*)(ws + WS_BAR); xbar.x = 0; xbar.st = xst;
    if (hi - lo > 1) xbar = xcd_barrier_post((unsigned*)(ws + WS_BAR), xst);
#define IN(k) (((PHASE_MASK >> (k)) & 1) && lo <= (k) && (k) < hi)
#if PROBE_MASK
    unsigned long long pr_acc = 0, pr_t0 = __builtin_amdgcn_s_memrealtime();
#define SEAM(k) do { if (IN(k) && IN((k) + 1)) { if ((k) == 0) cg::this_grid().sync(); else xcd_barrier(xbar); } { const unsigned long long t1_ = __builtin_amdgcn_s_memrealtime(); if ((PROBE_MASK >> (k)) & 1) pr_acc += t1_ - pr_t0; pr_t0 = t1_; } } while (0)
#else
#define SEAM(k) do { if (IN(k) && IN((k) + 1)) { if ((k) == 0) cg::this_grid().sync(); else xcd_barrier(xbar); } } while (0)
#endif

    if (IN(0)) { PHASE_IDS;
        for (int i = gtid; i < 4 * T; i += NTH) SSQ[i] = 0.f;
        for (int i = gtid; i < SEQ * 16; i += NTH) { const int pos = i >> 4, fi = i & 15; const float inv = 1.0f / powf(10000.0f, (float)fi * (1.0f / 16.0f)); const float ang = (float)pos * inv;
            float s, c; sincosf(ang, &s, &c); ROPE[pos * 32 + fi] = c; ROPE[pos * 32 + 16 + fi] = s; }
        for (int i = gtid; i < 1024; i += NTH) { const float lam = args.in[14][i]; SP8[i] = 8.0f * log1pf(expf(-lam)); }
        {
          const float* w_in = args.in[2]; const float* w_qb = args.in[4]; const float* g_q = args.in[3]; const float* w_kvb = args.in[6]; const float* g_kv = args.in[5];
          const float* wr_ = args.in[10]; const float* wi_ = args.in[12]; const float* w_oa = args.in[7]; const float* w_ol = args.in[15]; const float* w_o = args.in[16];
          const float* wg_ = args.in[18]; const float* wu_ = args.in[19]; const float* g2 = args.in[17]; const float* w_d = args.in[20];
          constexpr int I0 = (DIN_PAD / 64) * (1024 / 8), I1 = (768 / 64) * (256 / 8), I2 = (1024 / 64) * (128 / 8), I3 = (2048 / 64) * (128 / 8), I4 = (1024 / 64) * (512 / 8), I5 = I4,
                        I6 = (1024 / 64) * (1024 / 8), I7 = (2 * DFF / 64) * (1024 / 8), I8 = (1024 / 64) * (DFF / 8), ITOT = I0 + I1 + I2 + I3 + I4 + I5 + I6 + I7 + I8;
          auto do_item = [&](int gi) { int r = gi;
              if (r < I0) { xpose_one(WIN, DIN_PAD, 1024, [=](int n, int k) -> float { int src;
                  if (n < 384) src = n; else if (n < 416) { const int j = n - 384; src = 384 + (j & 1) * 16 + (j >> 1); } else if (n < 512) src = -1;
                  else if (n < 1024) src = 416 + (n - 512); else if (n < 1536) src = 928 + (n - 1024); else src = 1440 + (n - 1536);
                  return src < 0 ? 0.f : w_in[(size_t)k * DIN_SRC + src]; }, r, lane); return; } r -= I0;
              if (r < I1) { xpose_one(WQB, 768, 256, [=](int n, int k) -> float { const int h = n / 96, dp = n % 96; int d = dp; if (dp >= 64) { const int j = dp - 64; d = 64 + (j & 1) * 16 + (j >> 1); }
                  return w_qb[(size_t)k * 768 + h * 96 + d] * g_q[k]; }, r, lane); return; } r -= I1;
              if (r < I2) { xpose_one(WKVB, 1024, 128, [=](int n, int k) -> float { const int nn = n & 511, h = nn >> 6, d = nn & 63; return w_kvb[(size_t)k * 1024 + h * 128 + (n >> 9) * 64 + d] * g_kv[k]; }, r, lane); return; } r -= I2;
              if (r < I3) { xpose_one(WG, 2048, 128, [=](int n, int k) -> float { const int g = n >> 8, bj = (n >> 7) & 1, j = n & 127, blk = g >> 1, dir = g & 1;
                  return (bj ? wi_ : wr_)[((size_t)(dir * 4 + blk) * 128 + k) * 128 + j]; }, r, lane); return; } r -= I3;
              if (r < I4) { xpose_one(WOA, 1024, 512, [=](int n, int k) -> float { return w_oa[(size_t)k * 1024 + n]; }, r, lane); return; } r -= I4;
              if (r < I5) { xpose_one(WOL, 1024, 512, [=](int n, int k) -> float { return w_ol[(size_t)k * 1024 + n]; }, r, lane); return; } r -= I5;
              if (r < I6) { xpose_one(WOUT, 1024, 1024, [=](int n, int k) -> float { return w_o[(size_t)k * 1024 + n]; }, r, lane); return; } r -= I6;
              if (r < I7) { xpose_one(WGU, 2 * DFF, 1024, [=](int n, int k) -> float { const int pn = n >> 8, bj = (n >> 7) & 1, j = n & 127; return (bj ? wu_ : wg_)[(size_t)k * DFF + pn * 128 + j] * g2[k]; }, r, lane); return; } r -= I7;
              xpose_one(WD, 1024, DFF, [=](int n, int k) -> float { return w_d[(size_t)k * 1024 + n]; }, r, lane); };
          const float* x = args.in[0]; const float* g1 = args.in[1];
          f32x4 gv[4];
#pragma unroll
          for (int j = 0; j < 4; ++j) gv[j] = *((const f32x4*)g1 + lane + 64 * j);
          int gi = gw;
          for (int m = gw; m < T; m += 2 * NGW) { const int m2 = m + NGW; const bool two = m2 < T; const int mb = two ? m2 : m;
              const f32x4* xr = (const f32x4*)(x + (size_t)m * DM) + lane; const f32x4* xr2 = (const f32x4*)(x + (size_t)mb * DM) + lane; f32x4 v[4], v2[4]; float s = 0.f, s2 = 0.f;
#pragma unroll
              for (int j = 0; j < 4; ++j) { v[j] = xr[64 * j]; v2[j] = xr2[64 * j]; }
              if (gi < ITOT) { do_item(gi); gi += NGW; }
#pragma unroll
              for (int j = 0; j < 4; ++j) { s += (v[j].x * v[j].x + v[j].y * v[j].y) + (v[j].z * v[j].z + v[j].w * v[j].w); s2 += (v2[j].x * v2[j].x + v2[j].y * v2[j].y) + (v2[j].z * v2[j].z + v2[j].w * v2[j].w); }
              const float rstd = rsqrtf(wave_sum(s) * (1.0f / DM) + EPS), rstd2 = rsqrtf(wave_sum(s2) * (1.0f / DM) + EPS);
              u32x2* o8 = (u32x2*)(XN + (size_t)m * DM) + lane; u32x2* o82 = (u32x2*)(XN + (size_t)mb * DM) + lane;
#pragma unroll
              for (int j = 0; j < 4; ++j) { const f32x4 y = v[j] * rstd * gv[j]; u32x2 w2; w2.x = cvt_pk_bf16(y.x, y.y); w2.y = cvt_pk_bf16(y.z, y.w); o8[64 * j] = w2; }
              if (two) {
#pragma unroll
                  for (int j = 0; j < 4; ++j) { const f32x4 y = v2[j] * rstd2 * gv[j]; u32x2 w2; w2.x = cvt_pk_bf16(y.x, y.y); w2.y = cvt_pk_bf16(y.z, y.w); o82[64 * j] = w2; } } }
          for (; gi < ITOT; gi += NGW) do_item(gi);
        }
    }
    SEAM(0);
    if (IN(1)) {
        pg8::Gemm g{XN, XN, WIN, WIN, 1024, 1024, 1024, 0, 0}; pg8::StaticOrder S; S.init(T, DIN_PAD, G, bid);
        EpiProj E{QA, KVA, KR, LX, LY, GATES, SSQ, SSKV, ROPE};
        pg8::gemm_phase<EpiProj, pg8::StaticOrder, true>(lds, g, S, E);
    }
    SEAM(1);
    if (IN(2)) { PHASE_IDS;
        if (P2SUB & 1) { const float* cw = args.in[8]; const float* cb = args.in[9]; const int c8 = (gtid & 63) * 8;
          float w[4][8], bias[8];
#pragma unroll
          for (int e = 0; e < 8; ++e) { bias[e] = cb[c8 + e];
#pragma unroll
              for (int j = 0; j < 4; ++j) w[j][e] = cw[j * 512 + c8 + e]; }
          const int rstride = NTH >> 6;
          for (int row = gtid >> 6; row < T; row += 2 * rstride) { const int rowb = (row + rstride < T) ? row + rstride : row;
              u32x4 xa[4], xb[4];
#pragma unroll
              for (int j = 0; j < 4; ++j) { const int ta = (row & (SEQ - 1)) - 2 + j, tb = (rowb & (SEQ - 1)) - 2 + j;
                  xa[j] = (ta >= 0 && ta < SEQ) ? *(const u32x4*)(LX + (size_t)(row - 2 + j) * 512 + c8) : (u32x4){0u, 0u, 0u, 0u};
                  xb[j] = (tb >= 0 && tb < SEQ) ? *(const u32x4*)(LX + (size_t)(rowb - 2 + j) * 512 + c8) : (u32x4){0u, 0u, 0u, 0u}; }
              float a[8], bq[8];
#pragma unroll
              for (int e = 0; e < 8; ++e) { a[e] = bias[e]; bq[e] = bias[e]; }
#pragma unroll
              for (int j = 0; j < 4; ++j) { f32x4 x0, x1, y0, y1; unpack8(xa[j], x0, x1); unpack8(xb[j], y0, y1);
#pragma unroll
                  for (int e = 0; e < 4; ++e) { a[e] += w[j][e] * x0[e]; a[4 + e] += w[j][4 + e] * x1[e]; bq[e] += w[j][e] * y0[e]; bq[4 + e] += w[j][4 + e] * y1[e]; } }
              u32x4 o; o.x = cvt_pk_bf16(a[0], a[1]); o.y = cvt_pk_bf16(a[2], a[3]); o.z = cvt_pk_bf16(a[4], a[5]); o.w = cvt_pk_bf16(a[6], a[7]);
              *(u32x4*)(XC + (size_t)row * 512 + c8) = o;
              if (rowb != row) { u32x4 o2; o2.x = cvt_pk_bf16(bq[0], bq[1]); o2.y = cvt_pk_bf16(bq[2], bq[3]); o2.z = cvt_pk_bf16(bq[4], bq[5]); o2.w = cvt_pk_bf16(bq[6], bq[7]);
                  *(u32x4*)(XC + (size_t)rowb * 512 + c8) = o2; } } }
        if (P2SUB & 2) { pg8::Gemm g{QA, QA, WQB, WQB, 256, 256, 256, 0, 0}; pg8::StaticOrder S; S.init(T, 768, G, bid); EpiQ E{Qb, SSQ, ROPE};
          pg8::gemm_phase<EpiQ, pg8::StaticOrder, true>(lds, g, S, E); }
        if (P2SUB & 4) { pg8::Gemm g{KVA, KVA, WKVB, WKVB, 128, 128, 128, 0, 0}; pg8::StaticOrder S; S.init(T, 1024, G, bid); EpiKV E{KN, Vb, SSKV};
          pg8::gemm_phase<EpiKV, pg8::StaticOrder, true>(lds, g, S, E); }
    }
    SEAM(2);
    if (IN(3)) {
        pg8::Gemm g{XC, XC, WG, WG, 512, 128, 128, 1, 128}; pg8::StaticOrder S; S.init(T, 2048, G, bid);
        EpiGates E{XC, AU, args.in[11], args.in[13], SP8};
        pg8::gemm_phase<EpiGates, pg8::StaticOrder, true>(lds, g, S, E);
    }
    SEAM(3);
    if (IN(4)) {
        __syncthreads();
        for (int it = bid; it < NBATCH * 8; it += G) scan_item(it >> 3, it & 7, AU, LY, REC, (float*)lds_raw);
        const int vcu = (G % 8 == 0) ? (bid % 8) * (G / 8) + bid / 8 : bid;
        for (int un = vcu; un < NBATCH * 8 * 8; un += G) { const int bh = un >> 3, qb = un & 7, b = bh >> 3, h = bh & 7; const size_t rb = (size_t)b * SEQ;
            att::attn_unit(Qb + (rb + qb * 256) * 768 + h * 96, KN + rb * 512 + h * 64, KR + rb * 32, Vb + rb * 512 + h * 64, ATT + (rb + qb * 256) * 512 + h * 64, (char*)lds_raw); }
    }
    SEAM(4);
    if (IN(5)) {
        pg8::Gemm g{ATT, REC, WOA, WOL, 512, 512, 512, 0, 0}; pg8::DualOrder S; S.S.init(T, 1024, G, bid);
        EpiMerge E{GATES, MERGED};
        pg8::gemm_phase<EpiMerge, pg8::DualOrder, true>(lds, g, S, E);
    }
    SEAM(5);
    if (IN(6)) {
        pg8::Gemm g{MERGED, MERGED, WOUT, WOUT, 1024, 1024, 1024, 0, 0}; pg8::StaticOrder S; S.init(T, 1024, G, bid);
        EpiOut E{args.in[0], X1B, SS2};
        pg8::gemm_phase<EpiOut, pg8::StaticOrder, true>(lds, g, S, E);
    }
    SEAM(6);
    if (IN(7)) {
        pg8::Gemm g{X1B, X1B, WGU, WGU, 1024, 1024, 1024, 0, 0}; pg8::StaticOrder S; S.init(T, 2 * DFF, G, bid);
        EpiFfn E{HID, SS2};
        pg8::gemm_phase<EpiFfn, pg8::StaticOrder, true>(lds, g, S, E);
    }
    SEAM(7);
    if (IN(8)) {
        pg8::Gemm g{HID, HID, WD, WD, DFF, DFF, DFF, 0, 0}; pg8::StaticOrder S; S.init(T, 1024, G, bid);
        EpiDown E{X1B, SS3};
        pg8::gemm_phase<EpiDown, pg8::StaticOrder, true>(lds, g, S, E);
    }
    SEAM(8);
    if (IN(9)) { PHASE_IDS;
        const float* gf = args.in[21]; f32x4 gv[4];
#pragma unroll
        for (int j = 0; j < 4; ++j) gv[j] = *((const f32x4*)gf + lane + 64 * j);
        for (int m = gw; m < T; m += NGW) { f32x4* xr = (f32x4*)(args.out + (size_t)m * DM) + lane; const u32x2* br_ = (const u32x2*)(X1B + (size_t)m * DM) + lane; const float rstd = rsqrtf(SS3[m] * (1.0f / DM) + EPS);
            u32x2 w2[4];
#pragma unroll
            for (int j = 0; j < 4; ++j) w2[j] = br_[64 * j];
#pragma unroll
            for (int j = 0; j < 4; ++j) { const f32x4 v = (f32x4){bf_lo(w2[j].x), bf_hi(w2[j].x), bf_lo(w2[j].y), bf_hi(w2[j].y)}; xr[64 * j] = v * rstd * gv[j]; } }
    }
#if PROBE_MASK
    SEAM(9);
    if (bid == 0 && tid == 0) { const unsigned long long t0_ = __builtin_amdgcn_s_memrealtime(); while (__builtin_amdgcn_s_memrealtime() - t0_ < pr_acc) __builtin_amdgcn_s_sleep(8); }
#endif
#undef IN
#undef SEAM
}

constexpr int LDS_BYTES = 147456;
constexpr int N_PHASES = 10;
extern "C" void kernel_launch(void* const* d_in, const int* in_sizes, int n_in, void* d_out, int out_size, void* d_ws, size_t ws_size, hipStream_t stream) {
    static int grid = 0;
    if (grid == 0) {
        if (n_in != 22 || out_size != T * DM || ws_size < WS_END) { fprintf(stderr, "kernel_launch: unexpected shapes n_in %d out %d ws %zu\n", n_in, out_size, ws_size); grid = -1; return; }
        int dev = 0, cus = 0, per_cu = 0;
        hipGetDevice(&dev); hipDeviceGetAttribute(&cus, hipDeviceAttributeMultiprocessorCount, dev);
        if (hipFuncSetAttribute((const void*)mega_fwd, hipFuncAttributeMaxDynamicSharedMemorySize, LDS_BYTES) != hipSuccess) { fprintf(stderr, "kernel_launch: hipFuncSetAttribute failed\n"); grid = -1; return; }
        if (hipOccupancyMaxActiveBlocksPerMultiprocessor(&per_cu, (const void*)mega_fwd, 512, LDS_BYTES) != hipSuccess || per_cu < 1) { fprintf(stderr, "kernel_launch: occupancy query gives %d\n", per_cu); per_cu = 1; }
        (void)hipGetLastError();
        grid = cus * (per_cu > 1 ? 1 : per_cu);
        if (grid > 256) grid = 256;
    }
    if (grid < 0) return;
    Args a{};
    for (int i = 0; i < 22; ++i) a.in[i] = (const float*)d_in[i];
    a.out = (float*)d_out; a.ws = (unsigned char*)d_ws;
#if MK_SINGLE
    if (hipMemsetAsync((char*)d_ws + WS_BAR, 0, 16384, stream) != hipSuccess) { fprintf(stderr, "kernel_launch: memset failed\n"); return; }
    a.ph_lo = 0; a.ph_hi = N_PHASES;
    void* kargs[] = {&a};
    hipError_t e = hipLaunchCooperativeKernel((const void*)mega_fwd, dim3(grid), dim3(512), kargs, LDS_BYTES, stream);
    if (e != hipSuccess) fprintf(stderr, "cooperative launch failed: %s (grid %d)\n", hipGetErrorString(e), grid);
#else
    for (int p = 0; p < N_PHASES; ++p) { a.ph_lo = p; a.ph_hi = p + 1; hipLaunchKernelGGL(mega_fwd, dim3(grid), dim3(512), LDS_BYTES, stream, a); }
#endif
}
```

```cpp
#include <hip/hip_runtime.h>
#include <hip/hip_cooperative_groups.h>
#include <hip/hip_bf16.h>
#include <hip/hip_fp16.h>
#include <cstdio>
#include <cstdint>
namespace cg = cooperative_groups;

#ifndef PHASE_MASK
#define PHASE_MASK 0x3ff
#endif
#ifndef P2SUB
#define P2SUB 7
#endif
#ifndef PROBE_MASK
#define PROBE_MASK 0
#endif
#ifndef MK_SINGLE
#define MK_SINGLE 1
#endif

constexpr int T = 65536, DM = 1024, SEQ = 2048, NBATCH = 32;
constexpr int DIN_SRC = 3488, DIN_PAD = 3584, DFF = 2816;
constexpr float EPS = 1e-6f;
constexpr float LOG2E = 1.4426950408889634f;

typedef unsigned short bf16_t;
typedef short bf16x8 __attribute__((ext_vector_type(8)));
typedef short s16x4 __attribute__((ext_vector_type(4)));
typedef float f32x4 __attribute__((ext_vector_type(4)));
typedef float f32x2 __attribute__((ext_vector_type(2)));
typedef float f32x16 __attribute__((ext_vector_type(16)));
typedef unsigned u32x4 __attribute__((ext_vector_type(4)));
typedef unsigned u32x2 __attribute__((ext_vector_type(2)));
#define LAS __attribute__((address_space(3)))

__device__ __forceinline__ unsigned cvt_pk_bf16(float lo, float hi) { unsigned r; asm volatile("v_cvt_pk_bf16_f32 %0, %1, %2" : "=v"(r) : "v"(lo), "v"(hi)); return r; }
__device__ __forceinline__ float bf_lo(unsigned w) { return __uint_as_float(w << 16); }
__device__ __forceinline__ float bf_hi(unsigned w) { return __uint_as_float(w & 0xffff0000u); }
__device__ __forceinline__ float fsigmoid(float x) { return __builtin_amdgcn_rcpf(1.0f + __builtin_amdgcn_exp2f(-x * LOG2E)); }
__device__ __forceinline__ u32x4 pack8(f32x4 a, f32x4 b) { u32x4 w; w.x = cvt_pk_bf16(a[0], a[1]); w.y = cvt_pk_bf16(a[2], a[3]); w.z = cvt_pk_bf16(b[0], b[1]); w.w = cvt_pk_bf16(b[2], b[3]); return w; }
__device__ __forceinline__ void unpack8(u32x4 w, f32x4& a, f32x4& b) { a = (f32x4){bf_lo(w.x), bf_hi(w.x), bf_lo(w.y), bf_hi(w.y)}; b = (f32x4){bf_lo(w.z), bf_hi(w.z), bf_lo(w.w), bf_hi(w.w)}; }
__device__ __forceinline__ float wave_sum(float v) {
#pragma unroll
    for (int o = 1; o < 64; o <<= 1) v += __shfl_xor(v, o);
    return v;
}

namespace pg8 {
constexpr int BM = 256, BK = 64, HALF = 128, HTB = HALF * BK * 2, STAGE_BYTES = 8 * HTB, NXCD = 8, WGM = 8;
__host__ __device__ __forceinline__ int lds_byte(int r, int c) { const int st = (r >> 4) * 2 + (c >> 5), rr = r & 15, cc = c & 31, ob = rr * 64 + cc * 2; return st * 1024 + (ob ^ (((ob >> 9) & 1) << 5)); }
__host__ __device__ __forceinline__ void stage_rc(int b, int& R, int& C) { const int st = b / 1024, sb = b % 1024, swz = sb ^ (((sb >> 9) & 1) << 5); R = (st >> 1) * 16 + swz / 64; C = (st & 1) * 32 + (swz % 64) / 2; }
__host__ __device__ __forceinline__ int perm32(int rho) { const int n = rho >> 4, i = rho & 15; return 8 * (i >> 2) + 4 * n + (i & 3); }

struct Unit { int pm, pn, sel; };
struct Gemm {
    const bf16_t *A0, *A1, *B0, *B1; int lda, ldb, K; int a_grp_shift, a_grp_cols;
    __device__ __forceinline__ const char* a_ptr(const Unit& u) const { return (const char*)(u.sel ? A1 : A0) + ((size_t)u.pm * BM * lda + (size_t)(u.pn >> a_grp_shift) * a_grp_cols) * 2; }
    __device__ __forceinline__ const char* b_ptr(const Unit& u) const { return (const char*)(u.sel ? B1 : B0) + (size_t)u.pn * BM * ldb * 2; }
};

struct StaticOrder {
    int nM, nN, nwg, G, c;
    __device__ void init(int M, int N, int G_, int c_) { nM = M / BM; nN = N / BM; nwg = nM * nN; G = G_; c = c_; }
    __device__ bool next(int i, Unit& u) const {
        const long L = (long)i * G + c; if (L >= nwg) return false;
        int wgid = (int)L; { const int q = nwg / NXCD, r = nwg % NXCD, xcd = wgid % NXCD, off = wgid / NXCD; wgid = (xcd < r ? xcd * (q + 1) : r * (q + 1) + (xcd - r) * q) + off; }
        const int nig = WGM * nN, gid = wgid / nig, fm = gid * WGM, gsz = (nM - fm) < WGM ? (nM - fm) : WGM;
        u.pm = fm + ((wgid % nig) % gsz); u.pn = (wgid % nig) / gsz; u.sel = 0; return true;
    }
};
struct DualOrder {
    StaticOrder S;
    __device__ bool next(int i, Unit& u) const { if (!S.next(i >> 1, u)) return false; u.sel = i & 1; return true; }
};

template <class Epi, class Sched, bool ALIGN_EPI>
__device__ __forceinline__ void gemm_phase(LAS unsigned char* lds, const Gemm g, const Sched& S, const Epi& E) {
    int tid = threadIdx.x; asm volatile("" : "+v"(tid) :: "memory");
    const int wid = __builtin_amdgcn_readfirstlane(tid >> 6), lane = tid & 63, wr = wid >> 2, wc = wid & 3, fr = lane & 15, fq = lane >> 4;
    int lda_ = g.lda, ldb_ = g.ldb, K = g.K; asm volatile("" : "+s"(lda_), "+s"(ldb_), "+s"(K) :: "memory");
    const int nt = K / BK;
    unsigned voffA[2], voffB[2];
#pragma unroll
    for (int i = 0; i < 2; ++i) { int R, C; stage_rc(tid * 16 + i * 8192, R, C); const int Rb = Epi::PERM ? ((R & ~31) + perm32(R & 31)) : R;
        voffA[i] = (unsigned)(R * lda_ + C) * 2u; voffB[i] = (unsigned)(Rb * ldb_ + C) * 2u; }
    const size_t kstep = (size_t)(BK * 2);
    const size_t hstepA = (size_t)HALF * lda_ * 2, hstepB = (size_t)HALF * ldb_ * 2;
    const unsigned ldsw = (unsigned)wid * 1024u;
    const int aoff = lds_byte(wr * 64 + fr, fq * 8), boff = lds_byte(wc * 32 + fr, fq * 8);
#define PG8_SA(b, h) (((b) * 2 + (h)) * HTB)
#define PG8_SB(b, h) ((4 + (b) * 2 + (h)) * HTB)
#define PG8_STAGE(bufoff, gbase, voff) do { _Pragma("unroll") for (int _i = 0; _i < 2; ++_i) \
        __builtin_amdgcn_global_load_lds((const unsigned*)((const char*)(gbase) + (voff)[_i]), (LAS unsigned*)(lds + (bufoff) + ldsw + _i * 8192), 16, 0, 0); } while (0)
#define PG8_LDA(dst, b, h) do { _Pragma("unroll") for (int m = 0; m < 4; ++m) _Pragma("unroll") for (int k = 0; k < 2; ++k) dst[m][k] = *(const LAS bf16x8*)(lds + PG8_SA(b, h) + aoff + m * 2048 + k * 1024); } while (0)
#define PG8_LDB(dst, b, h) do { _Pragma("unroll") for (int n = 0; n < 2; ++n) _Pragma("unroll") for (int k = 0; k < 2; ++k) dst[n][k] = *(const LAS bf16x8*)(lds + PG8_SB(b, h) + boff + n * 2048 + k * 1024); } while (0)
#define PG8_MMA(ai, bj, At, Bt) do { __builtin_amdgcn_s_setprio(1); _Pragma("unroll") for (int m = 0; m < 4; ++m) _Pragma("unroll") for (int n = 0; n < 2; ++n) _Pragma("unroll") for (int k = 0; k < 2; ++k) \
        acc[ai][bj][m][n] = __builtin_amdgcn_mfma_f32_16x16x32_bf16(Bt[n][k], At[m][k], acc[ai][bj][m][n], 0, 0, 0); __builtin_amdgcn_s_setprio(0); } while (0)
#define PG8_WAIT_V(n) asm volatile("s_waitcnt vmcnt(" #n ")" ::: "memory")
#define PG8_WAIT_L(n) asm volatile("s_waitcnt lgkmcnt(" #n ")" ::: "memory")
#define PG8_BAR __builtin_amdgcn_s_barrier()
#define PG8_SCHED __builtin_amdgcn_sched_barrier(0)
    Unit cur, nxt; int ui = 0;
    if (!S.next(0, cur)) return;
    f32x4 acc[2][2][4][2];
#pragma unroll
    for (int a = 0; a < 2; ++a)
#pragma unroll
        for (int b = 0; b < 2; ++b)
#pragma unroll
            for (int m = 0; m < 4; ++m)
#pragma unroll
                for (int n = 0; n < 2; ++n) acc[a][b][m][n] = (f32x4){0.f, 0.f, 0.f, 0.f};
    bf16x8 At[4][2], B0[2][2], B1[2][2];
    const char* cA = g.a_ptr(cur); const char* cB = g.b_ptr(cur);
    PG8_STAGE(PG8_SB(0, 0), cB, voffB); PG8_STAGE(PG8_SB(0, 1), cB + hstepB, voffB); PG8_STAGE(PG8_SA(0, 0), cA, voffA); PG8_STAGE(PG8_SA(0, 1), cA + hstepA, voffA);
    if (wr == 1) PG8_BAR;
    PG8_WAIT_V(2); PG8_BAR;
    PG8_STAGE(PG8_SB(1, 0), cB + kstep, voffB); PG8_STAGE(PG8_SA(1, 0), cA + kstep, voffA); PG8_STAGE(PG8_SB(1, 1), cB + hstepB + kstep, voffB);
    PG8_WAIT_V(6); PG8_BAR;
    for (;;) {
        const bool has_next = S.next(ui + 1, nxt);
        const char* nA = has_next ? g.a_ptr(nxt) : cA; const char* nB = has_next ? g.b_ptr(nxt) : cB;
        for (int t = 0; t < nt; t += 2) {
            const bool last = (t == nt - 2);
            const char* a1 = cA + (size_t)(t + 1) * kstep;
            const char* a2 = last ? nA : cA + (size_t)(t + 2) * kstep; const char* b2 = last ? nB : cB + (size_t)(t + 2) * kstep;
            const char* a3 = a2 + kstep; const char* b3 = b2 + kstep;
            PG8_LDB(B0, 0, 0); PG8_LDB(B1, 0, 1); PG8_SCHED; PG8_LDA(At, 0, 0); PG8_STAGE(PG8_SA(1, 1), a1 + hstepA, voffA);
            PG8_WAIT_V(8); PG8_WAIT_L(0); PG8_BAR; PG8_MMA(0, 0, At, B0); PG8_MMA(0, 1, At, B1); PG8_BAR; PG8_SCHED;
            PG8_LDA(At, 0, 1); PG8_STAGE(PG8_SB(0, 0), b2, voffB); PG8_STAGE(PG8_SB(0, 1), b2 + hstepB, voffB); PG8_STAGE(PG8_SA(0, 0), a2, voffA);
            PG8_WAIT_V(8); PG8_WAIT_L(0); PG8_BAR; PG8_MMA(1, 0, At, B0); PG8_MMA(1, 1, At, B1); PG8_BAR; PG8_SCHED;
            PG8_LDB(B0, 1, 0); PG8_LDB(B1, 1, 1); PG8_SCHED; PG8_LDA(At, 1, 0); PG8_STAGE(PG8_SA(0, 1), a2 + hstepA, voffA);
            PG8_WAIT_V(8); PG8_WAIT_L(0); PG8_BAR; PG8_MMA(0, 0, At, B0); PG8_MMA(0, 1, At, B1); PG8_BAR; PG8_SCHED;
            PG8_LDA(At, 1, 1); PG8_STAGE(PG8_SB(1, 0), b3, voffB); PG8_STAGE(PG8_SB(1, 1), b3 + hstepB, voffB); PG8_STAGE(PG8_SA(1, 0), a3, voffA);
            PG8_WAIT_V(8); PG8_WAIT_L(0); PG8_BAR; PG8_MMA(1, 0, At, B0); PG8_MMA(1, 1, At, B1); PG8_BAR; PG8_SCHED;
        }
        if constexpr (ALIGN_EPI) { if (wr == 0) PG8_BAR; }
        PG8_SCHED; E(acc, cur, wr, wc, fr, fq); PG8_SCHED;
        if (!has_next) break;
        bool keep_ = false; if constexpr (Epi::DUAL) keep_ = (cur.sel == 0);
        if (!keep_)
#pragma unroll
        for (int a = 0; a < 2; ++a)
#pragma unroll
            for (int b = 0; b < 2; ++b)
#pragma unroll
                for (int m = 0; m < 4; ++m)
#pragma unroll
                    for (int n = 0; n < 2; ++n) acc[a][b][m][n] = (f32x4){0.f, 0.f, 0.f, 0.f};
        cur = nxt; cA = nA; cB = nB; ++ui;
        if constexpr (ALIGN_EPI) { if (wr == 1) PG8_BAR; }
    }
    PG8_WAIT_V(0);
    if constexpr (!ALIGN_EPI) { if (wr == 0) PG8_BAR; }
    PG8_BAR;
#undef PG8_SA
#undef PG8_SB
#undef PG8_STAGE
#undef PG8_LDA
#undef PG8_LDB
#undef PG8_MMA
#undef PG8_WAIT_V
#undef PG8_WAIT_L
#undef PG8_BAR
#undef PG8_SCHED
}
}
using pg8::Unit;
typedef f32x4 Acc[2][2][4][2];

__device__ __forceinline__ void rope4(f32x4& v0, f32x4& v1, const float* rp, int i0) {
    const f32x4 c = *(const f32x4*)(rp + i0), s = *(const f32x4*)(rp + 16 + i0);
    const f32x4 a = v0, b = v1;
    v0[0] = a[0] * c[0] - a[1] * s[0]; v0[1] = a[1] * c[0] + a[0] * s[0];
    v0[2] = a[2] * c[1] - a[3] * s[1]; v0[3] = a[3] * c[1] + a[2] * s[1];
    v1[0] = b[0] * c[2] - b[1] * s[2]; v1[1] = b[1] * c[2] + b[0] * s[2];
    v1[2] = b[2] * c[3] - b[3] * s[3]; v1[3] = b[3] * c[3] + b[2] * s[3];
}
__device__ __forceinline__ float gelu_tanh(float y) { const float z = 0.7978845608028654f * (y + 0.044715f * y * y * y); return y * fsigmoid(2.0f * z); }

struct EpiProj {
    static constexpr bool PERM = true, DUAL = false;
    bf16_t *QA, *KVA, *KR, *LX, *LY, *GATES; float *SSQ, *SSKV; const float* rope;
    __device__ __forceinline__ void operator()(const Acc& acc, const Unit& u, int wr, int wc, int fr, int fq) const {
        const int pn = u.pn, rowt = u.pm * 256 + wr * 64 + fr, cw = wc * 32 + 8 * fq;
        if (pn >= 2) {
            bf16_t* base; int ld, mode;
            if (pn >= 6) { base = GATES + (pn - 6) * 256; ld = 2048; mode = 2; } else if (pn >= 4) { base = LY + (pn - 4) * 256; ld = 512; mode = 1; } else { base = LX + (pn - 2) * 256; ld = 512; mode = 0; }
#pragma unroll
            for (int ai = 0; ai < 2; ++ai)
#pragma unroll
                for (int m = 0; m < 4; ++m) { const unsigned row = rowt + ai * 128 + m * 16;
#pragma unroll
                    for (int bj = 0; bj < 2; ++bj) { f32x4 v0 = acc[ai][bj][m][0], v1 = acc[ai][bj][m][1];
                        if (mode == 2) {
#pragma unroll
                            for (int e = 0; e < 4; ++e) { v0[e] = fsigmoid(v0[e]); v1[e] = fsigmoid(v1[e]); } }
                        else if (mode == 1) {
#pragma unroll
                            for (int e = 0; e < 4; ++e) { v0[e] = gelu_tanh(v0[e]); v1[e] = gelu_tanh(v1[e]); } }
                        *(u32x4*)(base + row * ld + bj * 128 + cw) = pack8(v0, v1); } }
        } else if (pn == 0) {
#pragma unroll
            for (int ai = 0; ai < 2; ++ai)
#pragma unroll
                for (int m = 0; m < 4; ++m) { const unsigned row = rowt + ai * 128 + m * 16; float ss = 0.f;
#pragma unroll
                    for (int bj = 0; bj < 2; ++bj) { const f32x4 v0 = acc[ai][bj][m][0], v1 = acc[ai][bj][m][1];
                        ss += (v0[0] * v0[0] + v0[1] * v0[1]) + (v0[2] * v0[2] + v0[3] * v0[3]) + (v1[0] * v1[0] + v1[1] * v1[1]) + (v1[2] * v1[2] + v1[3] * v1[3]);
                        *(u32x4*)(QA + row * 256 + bj * 128 + cw) = pack8(v0, v1); }
                    ss += __shfl_xor(ss, 16); ss += __shfl_xor(ss, 32);
                    if (fq == 0) atomicAdd(SSQ + row, ss); }
        } else {
#pragma unroll
            for (int ai = 0; ai < 2; ++ai)
#pragma unroll
                for (int m = 0; m < 4; ++m) { const unsigned row = rowt + ai * 128 + m * 16;
                    { const f32x4 v0 = acc[ai][0][m][0], v1 = acc[ai][0][m][1];
                      float ss = (v0[0] * v0[0] + v0[1] * v0[1]) + (v0[2] * v0[2] + v0[3] * v0[3]) + (v1[0] * v1[0] + v1[1] * v1[1]) + (v1[2] * v1[2] + v1[3] * v1[3]);
                      *(u32x4*)(KVA + row * 128 + cw) = pack8(v0, v1);
                      ss += __shfl_xor(ss, 16); ss += __shfl_xor(ss, 32);
                      if (fq == 0) atomicAdd(SSKV + row, ss); }
                    if (wc == 0) { f32x4 v0 = acc[ai][1][m][0], v1 = acc[ai][1][m][1];
                      rope4(v0, v1, rope + (row & (SEQ - 1)) * 32, 4 * fq);
                      *(u32x4*)(KR + row * 32 + 8 * fq) = pack8(v0, v1); } }
        }
    }
};

constexpr float QSCALE = 0.10206207261596577f * 1.4426950408889634f;
struct EpiQ {
    static constexpr bool PERM = true, DUAL = false;
    bf16_t* Q; const float* SSQ; const float* rope;
    __device__ __forceinline__ void operator()(const Acc& acc, const Unit& u, int wr, int wc, int fr, int fq) const {
        const int rowt = u.pm * 256 + wr * 64 + fr;
        const int c00 = u.pn * 256 + wc * 32 + 8 * fq, c01 = c00 + 128, d0 = c00 % 96, d1 = c01 % 96;
#pragma unroll
        for (int am = 0; am < 4; ++am) { const int ai = am >> 1, mb = (am & 1) * 2;
            f32x4 cs[2][2][2]; float ss[2];
#pragma unroll
            for (int mm = 0; mm < 2; ++mm) ss[mm] = SSQ[(unsigned)(rowt + ai * 128 + (mb + mm) * 16)];
#pragma unroll
            for (int mm = 0; mm < 2; ++mm) { const unsigned pos = (unsigned)(rowt + ai * 128 + (mb + mm) * 16) & (SEQ - 1);
#pragma unroll
                for (int bj = 0; bj < 2; ++bj) { const int d = bj ? d1 : d0; if (d >= 64) { const float* rp = rope + (pos * 32 + ((d - 64) >> 1)); cs[mm][bj][0] = *(const f32x4*)rp; cs[mm][bj][1] = *(const f32x4*)(rp + 16); }
                    else { cs[mm][bj][0] = (f32x4){1.f, 1.f, 1.f, 1.f}; cs[mm][bj][1] = (f32x4){0.f, 0.f, 0.f, 0.f}; } } }
#pragma unroll
            for (int mm = 0; mm < 2; ++mm) { const int m = mb + mm; const unsigned row = rowt + ai * 128 + m * 16; const float rstd = rsqrtf(ss[mm] * (1.0f / 256.0f) + EPS) * QSCALE;
#pragma unroll
                for (int bj = 0; bj < 2; ++bj) { const int c0 = bj ? c01 : c00;
                    const f32x4 a = acc[ai][bj][m][0] * rstd, b = acc[ai][bj][m][1] * rstd, c = cs[mm][bj][0], sn = cs[mm][bj][1]; f32x4 v0, v1;
                    v0[0] = a[0] * c[0] - a[1] * sn[0]; v0[1] = a[1] * c[0] + a[0] * sn[0]; v0[2] = a[2] * c[1] - a[3] * sn[1]; v0[3] = a[3] * c[1] + a[2] * sn[1];
                    v1[0] = b[0] * c[2] - b[1] * sn[2]; v1[1] = b[1] * c[2] + b[0] * sn[2]; v1[2] = b[2] * c[3] - b[3] * sn[3]; v1[3] = b[3] * c[3] + b[2] * sn[3];
                    if ((bj ? d1 : d0) < 64) { v0 = a; v1 = b; }
                    *(u32x4*)(Q + (row * 768 + c0)) = pack8(v0, v1); } }
            asm volatile("" ::: "memory"); }
    }
};

struct EpiKV {
    static constexpr bool PERM = true, DUAL = false;
    bf16_t *KN, *V; const float* SSKV;
    __device__ __forceinline__ void operator()(const Acc& acc, const Unit& u, int wr, int wc, int fr, int fq) const {
        const int rowt = u.pm * 256 + wr * 64 + fr; bf16_t* base = (u.pn < 2 ? KN : V) + (u.pn & 1) * 256; const unsigned cw = wc * 32 + 8 * fq;
        float ss[8];
#pragma unroll
        for (int i = 0; i < 8; ++i) ss[i] = SSKV[(unsigned)(rowt + (i >> 2) * 128 + (i & 3) * 16)];
#pragma unroll
        for (int ai = 0; ai < 2; ++ai)
#pragma unroll
            for (int m = 0; m < 4; ++m) { const unsigned row = rowt + ai * 128 + m * 16; const float rstd = rsqrtf(ss[ai * 4 + m] * (1.0f / 128.0f) + EPS);
#pragma unroll
                for (int bj = 0; bj < 2; ++bj) *(u32x4*)(base + (row * 512 + bj * 128 + cw)) = pack8(acc[ai][bj][m][0] * rstd, acc[ai][bj][m][1] * rstd); }
    }
};

__device__ __forceinline__ unsigned pack_h2(float lo, float hi) { const __half2 h = __floats2half2_rn(lo, hi); return *(const unsigned*)&h; }
struct EpiGates {
    static constexpr bool PERM = true, DUAL = false;
    const bf16_t* XC; unsigned* AU; const float *br, *bi, *sp8;
    __device__ __forceinline__ void operator()(const Acc& acc, const Unit& u, int wr, int wc, int fr, int fq) const {
        const int blk = u.pn >> 1, dir = u.pn & 1, rowt = u.pm * 256 + wr * 64 + fr, j0 = wc * 32 + 8 * fq, ch = blk * 128 + j0;
        const float* pbr = br + (dir * 4 + blk) * 128; const float* pbi = bi + (dir * 4 + blk) * 128; const float* psp = sp8 + dir * 512 + blk * 128;
        u32x4 xw[8];
#pragma unroll
        for (int i = 0; i < 8; ++i) xw[i] = *(const u32x4*)(XC + (unsigned)((rowt + (i >> 2) * 128 + (i & 3) * 16) * 512 + ch));
        f32x4 cbr[2], cbi[2], csp[2];
#pragma unroll
        for (int h = 0; h < 2; ++h) { cbr[h] = *(const f32x4*)(pbr + (unsigned)(j0 + 4 * h)); cbi[h] = *(const f32x4*)(pbi + (unsigned)(j0 + 4 * h)); csp[h] = *(const f32x4*)(psp + (unsigned)(j0 + 4 * h)); }
        unsigned* dst = AU + (size_t)dir * T * 512;
#pragma unroll
        for (int ai = 0; ai < 2; ++ai)
#pragma unroll
            for (int m = 0; m < 4; ++m) { const unsigned row = rowt + ai * 128 + m * 16;
                f32x4 x0, x1; unpack8(xw[ai * 4 + m], x0, x1);
                u32x4 o0, o1;
#pragma unroll
                for (int h = 0; h < 2; ++h) { const f32x4 ar = acc[ai][0][m][h] + cbr[h], aiq = acc[ai][1][m][h] + cbi[h], sp = csp[h], xx = h ? x1 : x0; u32x4 o;
#pragma unroll
                    for (int e = 0; e < 4; ++e) { const float rr = fsigmoid(ar[e]), ii = fsigmoid(aiq[e]); const float la = -rr * sp[e], y = 2.0f * la;
                        float m2 = -y * (1.0f + y * (0.5f + y * (0.16666667f + y * (0.041666668f + y * 0.0083333338f))));
                        if (__builtin_expect(__any(y < -0.25f), 0)) m2 = (y < -0.25f) ? 1.0f - __builtin_amdgcn_exp2f(y * LOG2E) : m2;
                        const float uu = ii * xx[e] * __builtin_amdgcn_sqrtf(m2); o[e] = pack_h2(la * LOG2E, uu); }
                    if (h) o1 = o; else o0 = o; }
                *(u32x4*)(dst + (row * 512 + ch)) = o0; *(u32x4*)(dst + (row * 512 + ch + 4)) = o1; }
    }
};

struct EpiMerge {
    static constexpr bool PERM = true, DUAL = true;
    const bf16_t* GATES; bf16_t* MERGED;
    __device__ __forceinline__ void operator()(Acc& acc, const Unit& u, int wr, int wc, int fr, int fq) const {
        const int rowt = u.pm * 256 + wr * 64 + fr, c0 = u.pn * 256 + wc * 32 + 8 * fq;
#pragma unroll
        for (int ai = 0; ai < 2; ++ai) {
            u32x4 gw_[4][2], hw_[4][2];
#pragma unroll
            for (int m = 0; m < 4; ++m)
#pragma unroll
                for (int bj = 0; bj < 2; ++bj) { const unsigned o = (unsigned)((rowt + ai * 128 + m * 16) * 2048 + c0 + bj * 128);
                    gw_[m][bj] = *(const u32x4*)(GATES + (o + 1024)); if (u.sel == 0) hw_[m][bj] = *(const u32x4*)(GATES + o); else hw_[m][bj] = gw_[m][bj]; }
#pragma unroll
            for (int m = 0; m < 4; ++m) { const unsigned row = rowt + ai * 128 + m * 16;
#pragma unroll
                for (int bj = 0; bj < 2; ++bj) { f32x4 r0, r1, a0, a1; unpack8(gw_[m][bj], r0, r1); unpack8(hw_[m][bj], a0, a1);
                    if (u.sel == 0) {
#pragma unroll
                        for (int e = 0; e < 4; ++e) { acc[ai][bj][m][0][e] *= a0[e] * __builtin_amdgcn_rcpf(r0[e]); acc[ai][bj][m][1][e] *= a1[e] * __builtin_amdgcn_rcpf(r1[e]); } }
                    else { *(u32x4*)(MERGED + (row * 1024 + c0 + bj * 128)) = pack8(acc[ai][bj][m][0] * r0, acc[ai][bj][m][1] * r1); } } }
            asm volatile("" ::: "memory"); }
    }
};

struct EpiOut {
    static constexpr bool PERM = true, DUAL = false;
    const float* X; bf16_t* X1B; float* SS2;
    __device__ __forceinline__ void operator()(const Acc& acc, const Unit& u, int wr, int wc, int fr, int fq) const {
        const int rowt = u.pm * 256 + wr * 64 + fr, c0 = u.pn * 256 + wc * 32 + 8 * fq;
#pragma unroll
        for (int ai = 0; ai < 2; ++ai) {
            f32x4 xv[4][2][2];
#pragma unroll
            for (int m = 0; m < 4; ++m)
#pragma unroll
                for (int bj = 0; bj < 2; ++bj) { const unsigned o = (rowt + ai * 128 + m * 16) * 1024 + c0 + bj * 128; xv[m][bj][0] = *(const f32x4*)(X + o); xv[m][bj][1] = *(const f32x4*)(X + (o + 4)); }
#pragma unroll
            for (int m = 0; m < 4; ++m) { const unsigned row = rowt + ai * 128 + m * 16; float ss = 0.f;
#pragma unroll
                for (int bj = 0; bj < 2; ++bj) { const unsigned o = row * 1024 + c0 + bj * 128;
                    const f32x4 v0 = acc[ai][bj][m][0] + xv[m][bj][0], v1 = acc[ai][bj][m][1] + xv[m][bj][1];
                    ss += (v0[0] * v0[0] + v0[1] * v0[1]) + (v0[2] * v0[2] + v0[3] * v0[3]) + (v1[0] * v1[0] + v1[1] * v1[1]) + (v1[2] * v1[2] + v1[3] * v1[3]);
                    *(u32x4*)(X1B + o) = pack8(v0, v1); }
                ss += __shfl_xor(ss, 16); ss += __shfl_xor(ss, 32);
                if (fq == 0) atomicAdd(SS2 + row, ss); }
            asm volatile("" ::: "memory"); }
    }
};

struct EpiFfn {
    static constexpr bool PERM = true, DUAL = false;
    bf16_t* HID; const float* SS2;
    __device__ __forceinline__ void operator()(const Acc& acc, const Unit& u, int wr, int wc, int fr, int fq) const {
        const int rowt = u.pm * 256 + wr * 64 + fr, c0 = u.pn * 128 + wc * 32 + 8 * fq;
        float ss[8];
#pragma unroll
        for (int i = 0; i < 8; ++i) ss[i] = SS2[(unsigned)(rowt + (i >> 2) * 128 + (i & 3) * 16)];
#pragma unroll
        for (int ai = 0; ai < 2; ++ai)
#pragma unroll
            for (int m = 0; m < 4; ++m) { const unsigned row = rowt + ai * 128 + m * 16; const float rstd = rsqrtf(ss[ai * 4 + m] * (1.0f / 1024.0f) + EPS);
                f32x4 h0, h1;
#pragma unroll
                for (int e = 0; e < 4; ++e) { const float g0 = acc[ai][0][m][0][e] * rstd, g1 = acc[ai][0][m][1][e] * rstd;
                    h0[e] = g0 * fsigmoid(g0) * (acc[ai][1][m][0][e] * rstd); h1[e] = g1 * fsigmoid(g1) * (acc[ai][1][m][1][e] * rstd); }
                *(u32x4*)(HID + (row * DFF + c0)) = pack8(h0, h1); }
    }
};

struct EpiDown {
    static constexpr bool PERM = true, DUAL = false;
    bf16_t* X1B; float* SS3;
    __device__ __forceinline__ void operator()(const Acc& acc, const Unit& u, int wr, int wc, int fr, int fq) const {
        const int rowt = u.pm * 256 + wr * 64 + fr, c0 = u.pn * 256 + wc * 32 + 8 * fq;
        u32x4 xv[8][2];
#pragma unroll
        for (int i = 0; i < 8; ++i)
#pragma unroll
            for (int bj = 0; bj < 2; ++bj) xv[i][bj] = *(const u32x4*)(X1B + (unsigned)((rowt + (i >> 2) * 128 + (i & 3) * 16) * 1024 + c0 + bj * 128));
#pragma unroll
        for (int ai = 0; ai < 2; ++ai)
#pragma unroll
            for (int m = 0; m < 4; ++m) { const unsigned row = rowt + ai * 128 + m * 16; float ss = 0.f;
#pragma unroll
                for (int bj = 0; bj < 2; ++bj) { const unsigned o = row * 1024 + c0 + bj * 128; f32x4 p0, p1; unpack8(xv[ai * 4 + m][bj], p0, p1);
                    const f32x4 v0 = acc[ai][bj][m][0] + p0, v1 = acc[ai][bj][m][1] + p1;
                    ss += (v0[0] * v0[0] + v0[1] * v0[1]) + (v0[2] * v0[2] + v0[3] * v0[3]) + (v1[0] * v1[0] + v1[1] * v1[1]) + (v1[2] * v1[2] + v1[3] * v1[3]);
                    *(u32x4*)(X1B + o) = pack8(v0, v1); }
                ss += __shfl_xor(ss, 16); ss += __shfl_xor(ss, 32);
                if (fq == 0) atomicAdd(SS3 + row, ss); }
    }
};

namespace att {
constexpr int NW = 8, QBLK = 32, KVBLK = 64;
constexpr float SCALE = 0.10206207261596577f;
constexpr float THR = 8.f;
constexpr int SHM_V = 16384, SHM_K = 16384;
#define KSWZ(row, colB) ((row) * 256 + ((colB) ^ (((row) & 7) << 4)))
#define SBAR() __builtin_amdgcn_sched_barrier(0)
__device__ __forceinline__ int crow(int r, int hi) { return (r & 3) + 8 * (r >> 2) + 4 * hi; }
template <bool FIRST> __device__ __forceinline__ void partialSM(f32x16& p0, f32x16& p1, float& mref, f32x16& negm, float& alpha) {
  constexpr float THRL = THR * 1.4426950408889634f;
  float pmax = p0[0];
#pragma unroll
  for (int r = 1; r < 16; ++r) pmax = fmaxf(pmax, p0[r]);
#pragma unroll
  for (int r = 0; r < 16; ++r) pmax = fmaxf(pmax, p1[r]);
  { auto rr = __builtin_amdgcn_permlane32_swap(__float_as_uint(pmax), __float_as_uint(pmax), false, false);
    pmax = fmaxf(__uint_as_float(rr[0]), __uint_as_float(rr[1])); }
  if (!FIRST && __builtin_expect(__all(pmax <= THRL), 1)) { alpha = 1.f; }
  else { const float dl = FIRST ? pmax : fmaxf(pmax, 0.f); mref += dl; alpha = FIRST ? 1.f : __builtin_amdgcn_exp2f(-dl);
#pragma unroll
    for (int r = 0; r < 16; ++r) { p0[r] -= dl; p1[r] -= dl; }
    const float nm = -mref;
#pragma unroll
    for (int r = 0; r < 16; ++r) negm[r] = nm; }
#pragma unroll
  for (int r = 0; r < 16; ++r) p0[r] = __builtin_amdgcn_exp2f(p0[r]);
}
__device__ __forceinline__ void finishSM(f32x16& p0, f32x16& p1, float alpha, float& l_reg, bf16x8& pa0, bf16x8& pa1, bf16x8& pa2, bf16x8& pa3) {
#pragma unroll
  for (int r = 0; r < 16; ++r) p1[r] = __builtin_amdgcn_exp2f(p1[r]);
  float ps = 0;
#pragma unroll
  for (int r = 0; r < 16; ++r) ps += p0[r];
#pragma unroll
  for (int r = 0; r < 16; ++r) ps += p1[r];
  { auto rr = __builtin_amdgcn_permlane32_swap(__float_as_uint(ps), __float_as_uint(ps), false, false);
    ps = __uint_as_float(rr[0]) + __uint_as_float(rr[1]); }
  l_reg = l_reg * alpha + ps;
#define PK4(P, BASE, OUT) do { u32x4 w = {cvt_pk_bf16(P[BASE + 0], P[BASE + 1]), cvt_pk_bf16(P[BASE + 2], P[BASE + 3]), cvt_pk_bf16(P[BASE + 4], P[BASE + 5]), cvt_pk_bf16(P[BASE + 6], P[BASE + 7])}; \
    OUT = *reinterpret_cast<bf16x8*>(&w); } while (0)
  PK4(p0, 0, pa0); PK4(p0, 8, pa1); PK4(p1, 0, pa2); PK4(p1, 8, pa3);
#undef PK4
}
__device__ __forceinline__ void qkt(f32x16& p0, f32x16& p1, const char* Ks, const bf16x8* qr, const f32x16& negm, int r32, int hi) {
  p0 = negm; p1 = negm;
#pragma unroll
  for (int d0 = 0; d0 < 6; ++d0) { int cb = (d0 * 16 + hi * 8) * 2;
    bf16x8 b0 = *reinterpret_cast<const bf16x8*>(Ks + KSWZ(r32, cb));
    bf16x8 b1 = *reinterpret_cast<const bf16x8*>(Ks + KSWZ(32 + r32, cb));
    p0 = __builtin_amdgcn_mfma_f32_32x32x16_bf16(b0, qr[d0], p0, 0, 0, 0);
    p1 = __builtin_amdgcn_mfma_f32_32x32x16_bf16(b1, qr[d0], p1, 0, 0, 0); }
}
__device__ __forceinline__ int v_st(int k, int c) { const int kk = k; return ((kk >> 3) * 4 + (c >> 5)) * 512 + ((kk & 7) * 32 + (c & 31)) * 2; }
__device__ __forceinline__ int v_rd_base(int lane) { return ((lane & 3) << 3) | (((lane >> 2) & 3) << 6) | (((lane >> 4) & 1) << 5) | (((lane >> 5) & 1) << 8); }
constexpr int v_rd_off(int d0, int ks, int half) { return d0 * 512 + ks * 4096 + half * 2048; }
typedef short v4i16_t __attribute__((ext_vector_type(4)));
typedef LAS const char* lds_cptr;
__device__ __forceinline__ s16x4 vtr(lds_cptr p) { return __builtin_bit_cast(s16x4, __builtin_amdgcn_ds_read_tr16_b64_v4i16((LAS v4i16_t*)p)); }
template <int D0> __device__ __forceinline__ void pv_one(f32x16& od, lds_cptr vp, bf16x8 pa0, bf16x8 pa1, bf16x8 pa2, bf16x8 pa3) {
  const s16x4 l0 = vtr(vp + v_rd_off(D0, 0, 0)), h0 = vtr(vp + v_rd_off(D0, 0, 1)), l1 = vtr(vp + v_rd_off(D0, 1, 0)), h1 = vtr(vp + v_rd_off(D0, 1, 1));
  const s16x4 l2 = vtr(vp + v_rd_off(D0, 2, 0)), h2 = vtr(vp + v_rd_off(D0, 2, 1)), l3 = vtr(vp + v_rd_off(D0, 3, 0)), h3 = vtr(vp + v_rd_off(D0, 3, 1));
#define PK(L, H) (bf16x8){L[0], L[1], L[2], L[3], H[0], H[1], H[2], H[3]}
  od = __builtin_amdgcn_mfma_f32_32x32x16_bf16(pa0, PK(l0, h0), od, 0, 0, 0);
  od = __builtin_amdgcn_mfma_f32_32x32x16_bf16(pa1, PK(l1, h1), od, 0, 0, 0);
  od = __builtin_amdgcn_mfma_f32_32x32x16_bf16(pa2, PK(l2, h2), od, 0, 0, 0);
  od = __builtin_amdgcn_mfma_f32_32x32x16_bf16(pa3, PK(l3, h3), od, 0, 0, 0);
#undef PK
}
__device__ __forceinline__ void pv_d0(f32x16* o, lds_cptr vp, bf16x8 pa0, bf16x8 pa1, bf16x8 pa2, bf16x8 pa3) {
  pv_one<0>(o[0], vp, pa0, pa1, pa2, pa3); pv_one<1>(o[1], vp, pa0, pa1, pa2, pa3);
}
__device__ __forceinline__ void attn_unit(const bf16_t* __restrict__ Qb, const bf16_t* __restrict__ KNh, const bf16_t* __restrict__ KRb, const bf16_t* __restrict__ Vh, bf16_t* __restrict__ Ob, char* lds) {
  const int tid = threadIdx.x, wid = tid >> 6, lane = tid & 63, r32 = lane & 31, hi = lane >> 5;
  char* V_lds = lds; char* K_lds = lds + 2 * SHM_V;
  float* ws = (float*)(lds + 2 * SHM_V + 2 * SHM_K) + wid * 64; float* li_l = ws; float* al_l = ws + 32;
  float mref = 0.f, l_reg = 0; f32x16 negm = {}; f32x16 o[2] = {}; bf16x8 qr[6];
  const bf16_t* Qw = Qb + (long)(wid * QBLK + r32) * 768 + hi * 8;
#pragma unroll
  for (int d0 = 0; d0 < 6; ++d0) qr[d0] = *reinterpret_cast<const bf16x8*>(Qw + d0 * 16);
  const int sr = tid >> 3, sc = (tid & 7) * 8, vst = v_st(sr, sc), kst = KSWZ(sr, sc * 2), krst = KSWZ(sr, 128 + (tid & 7) * 8);
  const lds_cptr vb0 = (lds_cptr)(LAS char*)lds + v_rd_base(lane);
  struct { bf16x8 vs, ks; s16x4 kr; } sr_[2];
  const unsigned lo_kv = (unsigned)(sr * 512 + sc), lo_kr = (unsigned)(sr * 32 + (tid & 7) * 4);
#define SLOAD(i, k0) do { const bf16_t* vt_ = Vh + (size_t)(k0) * 512; const bf16_t* kt_ = KNh + (size_t)(k0) * 512; const bf16_t* rt_ = KRb + (size_t)(k0) * 32; \
    sr_[i].vs = *reinterpret_cast<const bf16x8*>(vt_ + lo_kv); sr_[i].ks = *reinterpret_cast<const bf16x8*>(kt_ + lo_kv); sr_[i].kr = *reinterpret_cast<const s16x4*>(rt_ + lo_kr); } while (0)
#define SWRITE(b, i) do { *(bf16x8*)(V_lds + (b) * SHM_V + vst) = sr_[i].vs; *(bf16x8*)(K_lds + (b) * SHM_K + kst) = sr_[i].ks; *(s16x4*)(K_lds + (b) * SHM_K + krst) = sr_[i].kr; } while (0)
#define SWAIT() asm volatile("s_waitcnt vmcnt(3)" ::: "memory")
#define RESC(a) do { if (__any((a) < 1.f)) { if (hi == 0) al_l[r32] = (a); asm volatile("s_waitcnt lgkmcnt(0)" ::: "memory"); \
    _Pragma("unroll") for (int d = 0; d < 2; ++d) _Pragma("unroll") for (int r = 0; r < 16; ++r) o[d][r] *= al_l[crow(r, hi)]; } } while (0)
  f32x16 pA0, pA1, pB0, pB1; float alA, alB; bf16x8 pa0, pa1, pa2, pa3; constexpr int NT = SEQ / KVBLK;
  constexpr int SE = 0, SO = 1;
  SLOAD(SE, 0); asm volatile("s_waitcnt vmcnt(0)" ::: "memory"); SWRITE(0, SE); __syncthreads();
  qkt(pA0, pA1, K_lds, qr, negm, r32, hi); partialSM<true>(pA0, pA1, mref, negm, alA);
  SLOAD(SO, KVBLK); SLOAD(SE, 2 * KVBLK);
  SWAIT(); SWRITE(1, SO); __syncthreads();
  for (int j = 1; j + 1 < NT; j += 2) {
    SBAR(); qkt(pB0, pB1, K_lds + SHM_K, qr, negm, r32, hi);
    finishSM(pA0, pA1, alA, l_reg, pa0, pa1, pa2, pa3); SBAR();
    SLOAD(SO, (j + 2) * KVBLK); SBAR();
    pv_d0(o, vb0, pa0, pa1, pa2, pa3); partialSM<false>(pB0, pB1, mref, negm, alB);
    __syncthreads(); SWAIT(); SWRITE(0, SE);
    RESC(alB); __syncthreads();
    SBAR(); qkt(pA0, pA1, K_lds, qr, negm, r32, hi);
    finishSM(pB0, pB1, alB, l_reg, pa0, pa1, pa2, pa3); SBAR();
    if (j + 3 < NT) SLOAD(SE, (j + 3) * KVBLK); SBAR();
    pv_d0(o, vb0 + SHM_V, pa0, pa1, pa2, pa3); partialSM<false>(pA0, pA1, mref, negm, alA);
    __syncthreads(); SWAIT(); SWRITE(1, SO);
    RESC(alA); __syncthreads();
  }
  SBAR(); qkt(pB0, pB1, K_lds + SHM_K, qr, negm, r32, hi);
  finishSM(pA0, pA1, alA, l_reg, pa0, pa1, pa2, pa3); SBAR();
  pv_d0(o, vb0, pa0, pa1, pa2, pa3); partialSM<false>(pB0, pB1, mref, negm, alB);
  __syncthreads(); RESC(alB);
  finishSM(pB0, pB1, alB, l_reg, pa0, pa1, pa2, pa3); SBAR();
  pv_d0(o, vb0 + SHM_V, pa0, pa1, pa2, pa3);
  if (hi == 0) li_l[r32] = l_reg; asm volatile("s_waitcnt lgkmcnt(0)" ::: "memory");
  float rli[16];
#pragma unroll
  for (int r = 0; r < 16; ++r) rli[r] = __builtin_amdgcn_rcpf(li_l[crow(r, hi)]);
  bf16_t* Ow = Ob + (long)(wid * QBLK) * 512;
#pragma unroll
  for (int r = 0; r < 16; ++r) { int orow = crow(r, hi);
#pragma unroll
    for (int d0 = 0; d0 < 2; ++d0) Ow[(long)orow * 512 + d0 * 32 + r32] = (bf16_t)(cvt_pk_bf16(o[d0][r] * rli[r], 0.f) & 0xffffu); }
  __syncthreads();
#undef SLOAD
#undef SWRITE
#undef SWAIT
#undef RESC
}
#undef KSWZ
#undef SBAR
}

__device__ __forceinline__ void h2f(unsigned w, float& lo, float& hi) { const __half2 h = *(const __half2*)&w; const float2 f = __half22float2(h); lo = f.x; hi = f.y; }
__device__ __forceinline__ void scan_item(int b, int cgp, unsigned* AU, const bf16_t* LY, bf16_t* REC, float* sc) {
    const int tid = threadIdx.x, wid = tid >> 6, lane = tid & 63, c = cgp * 64 + lane;
    const unsigned r0 = (unsigned)b * SEQ + wid * 256;
    unsigned* au0 = AU + c; unsigned* au1 = AU + (size_t)T * 512 + c; const bf16_t* ly = LY + c; bf16_t* rec = REC + c;
#define SC_STEP(W, H) do { float la_, u_; h2f(W, la_, u_); H = __builtin_amdgcn_exp2f(la_) * H + u_; } while (0)
    { float hf = 0.f, hb = 0.f, slf = 0.f, slb = 0.f; unsigned fa[16], ba[16], fb[16], bb[16];
#pragma unroll
      for (int k = 0; k < 16; ++k) { fa[k] = au0[(r0 + k) * 512]; ba[k] = au1[(r0 + 255 - k) * 512]; }
#pragma unroll 1
      for (int blk = 0; blk < 16; blk += 2) {
#pragma unroll
          for (int k = 0; k < 16; ++k) { fb[k] = au0[(r0 + (blk + 1) * 16 + k) * 512]; bb[k] = au1[(r0 + 255 - ((blk + 1) * 16 + k)) * 512]; }
#pragma unroll
          for (int k = 0; k < 16; ++k) { float la, u; h2f(fa[k], la, u); hf = __builtin_amdgcn_exp2f(la) * hf + u; slf += la; h2f(ba[k], la, u); hb = __builtin_amdgcn_exp2f(la) * hb + u; slb += la; }
          if (blk + 2 < 16) {
#pragma unroll
              for (int k = 0; k < 16; ++k) { fa[k] = au0[(r0 + (blk + 2) * 16 + k) * 512]; ba[k] = au1[(r0 + 255 - ((blk + 2) * 16 + k)) * 512]; } }
#pragma unroll
          for (int k = 0; k < 16; ++k) { float la, u; h2f(fb[k], la, u); hf = __builtin_amdgcn_exp2f(la) * hf + u; slf += la; h2f(bb[k], la, u); hb = __builtin_amdgcn_exp2f(la) * hb + u; slb += la; }
      }
      sc[wid * 64 + lane] = __builtin_amdgcn_exp2f(slf); sc[1024 + wid * 64 + lane] = hf;
      sc[(8 + wid) * 64 + lane] = __builtin_amdgcn_exp2f(slb); sc[1024 + (8 + wid) * 64 + lane] = hb; }
    __syncthreads();
    float cin0 = 0.f, cin1 = 0.f;
    for (int k = 0; k < wid; ++k) cin0 = sc[k * 64 + lane] * cin0 + sc[1024 + k * 64 + lane];
    for (int k = 7; k > wid; --k) cin1 = sc[(8 + k) * 64 + lane] * cin1 + sc[1024 + (8 + k) * 64 + lane];
    { float h = cin0; unsigned wa[16], wb[16];
#pragma unroll
      for (int k = 0; k < 16; ++k) wa[k] = au0[(r0 + k) * 512];
#pragma unroll 1
      for (int blk = 0; blk < 16; blk += 2) {
#pragma unroll
          for (int k = 0; k < 16; ++k) wb[k] = au0[(r0 + (blk + 1) * 16 + k) * 512];
#pragma unroll
          for (int k = 0; k < 16; ++k) { SC_STEP(wa[k], h); rec[(r0 + blk * 16 + k) * 512] = (bf16_t)(cvt_pk_bf16(h, 0.f) & 0xffffu); }
          if (blk + 2 < 16) {
#pragma unroll
              for (int k = 0; k < 16; ++k) wa[k] = au0[(r0 + (blk + 2) * 16 + k) * 512]; }
#pragma unroll
          for (int k = 0; k < 16; ++k) { SC_STEP(wb[k], h); rec[(r0 + (blk + 1) * 16 + k) * 512] = (bf16_t)(cvt_pk_bf16(h, 0.f) & 0xffffu); }
      } }
    { float h = cin1; unsigned wa[16], wb[16]; bf16_t fa[16], fb[16], ya[16], yb[16];
#pragma unroll
      for (int k = 0; k < 16; ++k) { const unsigned row = r0 + 255 - k; wa[k] = au1[row * 512]; fa[k] = rec[row * 512]; ya[k] = ly[row * 512]; }
#pragma unroll 1
      for (int blk = 0; blk < 16; blk += 2) {
#pragma unroll
          for (int k = 0; k < 16; ++k) { const unsigned row = r0 + 255 - ((blk + 1) * 16 + k); wb[k] = au1[row * 512]; fb[k] = rec[row * 512]; yb[k] = ly[row * 512]; }
#pragma unroll
          for (int k = 0; k < 16; ++k) { const unsigned row = r0 + 255 - (blk * 16 + k); SC_STEP(wa[k], h);
              const float tot = (h + __uint_as_float((unsigned)fa[k] << 16)) * __uint_as_float((unsigned)ya[k] << 16); rec[row * 512] = (bf16_t)(cvt_pk_bf16(tot, 0.f) & 0xffffu); }
          if (blk + 2 < 16) {
#pragma unroll
              for (int k = 0; k < 16; ++k) { const unsigned row = r0 + 255 - ((blk + 2) * 16 + k); wa[k] = au1[row * 512]; fa[k] = rec[row * 512]; ya[k] = ly[row * 512]; } }
#pragma unroll
          for (int k = 0; k < 16; ++k) { const unsigned row = r0 + 255 - ((blk + 1) * 16 + k); SC_STEP(wb[k], h);
              const float tot = (h + __uint_as_float((unsigned)fb[k] << 16)) * __uint_as_float((unsigned)yb[k] << 16); rec[row * 512] = (bf16_t)(cvt_pk_bf16(tot, 0.f) & 0xffffu); }
      } }
#undef SC_STEP
    __syncthreads();
}

template <class F> __device__ __forceinline__ void xpose(bf16_t* Bt, int N, int K, F f, int gw, int NGW, int lane) {
    const int nN = N / 64, total = nN * (K / 8);
    for (int item = gw; item < total; item += NGW) { const int ng = item % nN, kc = item / nN, n = ng * 64 + lane, k0 = kc * 8;
        float v[8];
#pragma unroll
        for (int e = 0; e < 8; ++e) v[e] = f(n, k0 + e);
        u32x4 w; w.x = cvt_pk_bf16(v[0], v[1]); w.y = cvt_pk_bf16(v[2], v[3]); w.z = cvt_pk_bf16(v[4], v[5]); w.w = cvt_pk_bf16(v[6], v[7]);
        *(u32x4*)(Bt + (size_t)n * K + k0) = w; }
}


template <class F> __device__ __forceinline__ void xpose_one(bf16_t* Bt, int N, int K, F f, int item, int lane) {
    const int nN = N / 64, n = (item % nN) * 64 + lane, k0 = (item / nN) * 8;
    float v[8];
#pragma unroll
    for (int e = 0; e < 8; ++e) v[e] = f(n, k0 + e);
    u32x4 w; w.x = cvt_pk_bf16(v[0], v[1]); w.y = cvt_pk_bf16(v[2], v[3]); w.z = cvt_pk_bf16(v[4], v[5]); w.w = cvt_pk_bf16(v[6], v[7]);
    *(u32x4*)(Bt + (size_t)n * K + k0) = w;
}

#define XB_TMO      128
#define XB_XCNT(j)  (256  + 64 * (j))
#define XB_XSUB(j)  (1280 + 64 * (j))
#define XB_XGEN(j)  (2304 + 64 * (j))
#define XB_TOP      3328
#define XB_TOPGEN   3392
#define XCD_BAR_WORDS 3456
#define XB_SPIN_CAP (1u << 18)
__device__ __forceinline__ unsigned xb_ld(unsigned* p)              { return __hip_atomic_load(p, __ATOMIC_RELAXED, __HIP_MEMORY_SCOPE_AGENT); }
__device__ __forceinline__ unsigned xb_add(unsigned* p, unsigned v) { return __hip_atomic_fetch_add(p, v, __ATOMIC_RELAXED, __HIP_MEMORY_SCOPE_AGENT); }
__device__ __forceinline__ unsigned xb_xcc_id() { return (unsigned)__builtin_amdgcn_s_getreg((3 << 11) | 20) & 0xFu; }
#define XB_SPIN(cond, bar) do { unsigned _sp = 0; while (cond) { __builtin_amdgcn_s_sleep(1); \
    if ((++_sp & 255u) == 0u) { if (xb_ld(&(bar)[XB_TMO])) break; if (_sp > XB_SPIN_CAP) { atomicAdd(&(bar)[XB_TMO], 1u); break; } } } } while (0)
struct XcdBarrier { unsigned* bar; unsigned x; volatile LAS unsigned* st; };
__device__ __forceinline__ XcdBarrier xcd_barrier_post(unsigned* bar, volatile LAS unsigned* st) {
    XcdBarrier b; b.bar = bar; b.x = xb_xcc_id(); b.st = st;
    if (threadIdx.x == 0) (void)xb_add(&bar[XB_XCNT(b.x)], 1u);
    return b;
}
__device__ __forceinline__ void xcd_barrier_complete(unsigned* bar, unsigned x, unsigned& nloc, unsigned& nx) {
    const unsigned G = gridDim.x * gridDim.y * gridDim.z;
    unsigned sum, cnt, mine, sp = 0u;
    for (;;) {
        sum = 0u; cnt = 0u; mine = 0u;
#pragma unroll
        for (unsigned j = 0; j < 16; ++j) { const unsigned c = xb_ld(&bar[XB_XCNT(j)]); sum += c; cnt += (c > 0u) ? 1u : 0u; mine = (j == x) ? c : mine; }
        if (sum == G) break;
        __builtin_amdgcn_s_sleep(1);
        if ((++sp & 255u) == 0u) { if (xb_ld(&bar[XB_TMO])) break; if (sp > XB_SPIN_CAP) { atomicAdd(&bar[XB_TMO], 1u); break; } }
    }
    nloc = mine > 0u ? mine : 1u; nx = cnt > 0u ? cnt : 1u;
}
__device__ __forceinline__ void xcd_barrier(const XcdBarrier& b) {
    asm volatile("s_waitcnt vmcnt(0)" ::: "memory");
    __syncthreads();
    if (threadIdx.x == 0) {
        unsigned* bar = b.bar;
        __builtin_amdgcn_s_waitcnt(0);
        unsigned nloc = b.st[0], nx = b.st[1];
        if (nloc == 0u) { xcd_barrier_complete(bar, b.x, nloc, nx); b.st[0] = nloc; b.st[1] = nx; }
        const unsigned old = xb_add(&bar[XB_XSUB(b.x)], 1u);
        const unsigned gen = old / nloc;
        if (old + 1u == (gen + 1u) * nloc) {
            __builtin_amdgcn_fence(__ATOMIC_RELEASE, "agent");
            asm volatile("s_waitcnt vmcnt(0)" ::: "memory");
            const unsigned og = xb_add(&bar[XB_TOP], 1u);
            const unsigned tg = og / nx;
            if (og + 1u == (tg + 1u) * nx) xb_add(&bar[XB_TOPGEN], 1u);
            else XB_SPIN(xb_ld(&bar[XB_TOPGEN]) == tg, bar);
            __builtin_amdgcn_fence(__ATOMIC_ACQUIRE, "agent");
            xb_add(&bar[XB_XGEN(b.x)], 1u);
            asm volatile("s_waitcnt vmcnt(0)" ::: "memory");
        } else {
            XB_SPIN(xb_ld(&bar[XB_XGEN(b.x)]) == gen, bar);
            __builtin_amdgcn_fence(__ATOMIC_ACQUIRE, "agent");
            asm volatile("s_waitcnt vmcnt(0)" ::: "memory");
        }
    }
    __syncthreads();
}

constexpr size_t MiB = 1u << 20;
constexpr size_t WS_SS = 0;
constexpr size_t WS_ROPE = 1 * MiB;
constexpr size_t WS_SP8 = WS_ROPE + 256 * 1024;
constexpr size_t WS_BAR = 1 * MiB + 512 * 1024;
constexpr size_t WS_WIN = 2 * MiB;
constexpr size_t WS_WQB = 9 * MiB;
constexpr size_t WS_WKVB = WS_WQB + 512 * 1024;
constexpr size_t WS_WG = 10 * MiB;
constexpr size_t WS_WOA = 11 * MiB;
constexpr size_t WS_WOL = 12 * MiB;
constexpr size_t WS_WOUT = 13 * MiB;
constexpr size_t WS_WGU = 15 * MiB;
constexpr size_t WS_WD = 26 * MiB;
constexpr size_t WS_A = 40 * MiB;
constexpr size_t WS_GATES = 168 * MiB;
constexpr size_t WS_LY = 424 * MiB;
constexpr size_t WS_LX = 488 * MiB;
constexpr size_t WS_QA = 552 * MiB;
constexpr size_t WS_KVA = 584 * MiB;
constexpr size_t WS_KN = 616 * MiB;
constexpr size_t WS_V = 680 * MiB;
constexpr size_t WS_KR = 744 * MiB;
constexpr size_t WS_XC = 748 * MiB;
constexpr size_t WS_X1B = 616 * MiB;
constexpr size_t WS_HID = 168 * MiB;
constexpr size_t WS_END = 812 * MiB;

struct Args { const float* in[22]; float* out; unsigned char* ws; int ph_lo, ph_hi; };

__global__ void __launch_bounds__(512, 2) mega_fwd(Args args) {
    extern __shared__ __attribute__((aligned(16))) unsigned char lds_raw[];
    LAS unsigned char* lds = (LAS unsigned char*)lds_raw;
    const int tid = threadIdx.x;
#define PHASE_IDS const int lane = threadIdx.x & 63, wave = __builtin_amdgcn_readfirstlane(threadIdx.x >> 6), gw = bid * 8 + wave, NGW = G * 8, gtid = bid * 512 + (int)threadIdx.x, NTH = G * 512; (void)lane; (void)gw; (void)NGW; (void)gtid; (void)NTH
    const int G = gridDim.x, bid = blockIdx.x;
    unsigned char* ws = args.ws;
    float* SSQ = (float*)(ws + WS_SS); float* SSKV = SSQ + T; float* SS2 = SSKV + T; float* SS3 = SS2 + T;
    float* ROPE = (float*)(ws + WS_ROPE); float* SP8 = (float*)(ws + WS_SP8);
    bf16_t* WIN = (bf16_t*)(ws + WS_WIN); bf16_t* WQB = (bf16_t*)(ws + WS_WQB); bf16_t* WKVB = (bf16_t*)(ws + WS_WKVB); bf16_t* WG = (bf16_t*)(ws + WS_WG);
    bf16_t* WOA = (bf16_t*)(ws + WS_WOA); bf16_t* WOL = (bf16_t*)(ws + WS_WOL); bf16_t* WOUT = (bf16_t*)(ws + WS_WOUT); bf16_t* WGU = (bf16_t*)(ws + WS_WGU); bf16_t* WD = (bf16_t*)(ws + WS_WD);
    bf16_t* XN = (bf16_t*)(ws + WS_A); bf16_t* Qb = (bf16_t*)(ws + WS_A); bf16_t* MERGED = (bf16_t*)(ws + WS_A);
    bf16_t* GATES = (bf16_t*)(ws + WS_GATES); bf16_t* LY = (bf16_t*)(ws + WS_LY); bf16_t* LX = (bf16_t*)(ws + WS_LX); bf16_t* ATT = (bf16_t*)(ws + WS_LX);
    bf16_t* QA = (bf16_t*)(ws + WS_QA); bf16_t* KVA = (bf16_t*)(ws + WS_KVA); bf16_t* REC = (bf16_t*)(ws + WS_QA);
    bf16_t* KN = (bf16_t*)(ws + WS_KN); bf16_t* Vb = (bf16_t*)(ws + WS_V); bf16_t* KR = (bf16_t*)(ws + WS_KR); bf16_t* XC = (bf16_t*)(ws + WS_XC);
    bf16_t* X1B = (bf16_t*)(ws + WS_X1B); bf16_t* HID = (bf16_t*)(ws + WS_HID);
    unsigned* AU = (unsigned*)args.out;
    const int lo = args.ph_lo, hi = args.ph_hi;
    volatile LAS unsigned* xst = (volatile LAS unsigned*)(lds + 140032);
    if (tid < 2) xst[tid] = 0u;
    __syncthreads();
    XcdBarrier xbar; xbar.bar = (unsigned*)(ws + WS_BAR); xbar.x = 0; xbar.st = xst;
    if (hi - lo > 1) xbar = xcd_barrier_post((unsigned*)(ws + WS_BAR), xst);
#define IN(k) (((PHASE_MASK >> (k)) & 1) && lo <= (k) && (k) < hi)
#if PROBE_MASK
    unsigned long long pr_acc = 0, pr_t0 = __builtin_amdgcn_s_memrealtime();
#define SEAM(k) do { if (IN(k) && IN((k) + 1)) { if ((k) == 0) cg::this_grid().sync(); else xcd_barrier(xbar); } { const unsigned long long t1_ = __builtin_amdgcn_s_memrealtime(); if ((PROBE_MASK >> (k)) & 1) pr_acc += t1_ - pr_t0; pr_t0 = t1_; } } while (0)
#else
#define SEAM(k) do { if (IN(k) && IN((k) + 1)) { if ((k) == 0) cg::this_grid().sync(); else xcd_barrier(xbar); } } while (0)
#endif

    if (IN(0)) { PHASE_IDS;
        for (int i = gtid; i < 4 * T; i += NTH) SSQ[i] = 0.f;
        for (int i = gtid; i < SEQ * 16; i += NTH) { const int pos = i >> 4, fi = i & 15; const float inv = 1.0f / powf(10000.0f, (float)fi * (1.0f / 16.0f)); const float ang = (float)pos * inv;
            float s, c; sincosf(ang, &s, &c); ROPE[pos * 32 + fi] = c; ROPE[pos * 32 + 16 + fi] = s; }
        for (int i = gtid; i < 1024; i += NTH) { const float lam = args.in[14][i]; SP8[i] = 8.0f * log1pf(expf(-lam)); }
        {
          const float* w_in = args.in[2]; const float* w_qb = args.in[4]; const float* g_q = args.in[3]; const float* w_kvb = args.in[6]; const float* g_kv = args.in[5];
          const float* wr_ = args.in[10]; const float* wi_ = args.in[12]; const float* w_oa = args.in[7]; const float* w_ol = args.in[15]; const float* w_o = args.in[16];
          const float* wg_ = args.in[18]; const float* wu_ = args.in[19]; const float* g2 = args.in[17]; const float* w_d = args.in[20];
          constexpr int I0 = (DIN_PAD / 64) * (1024 / 8), I1 = (768 / 64) * (256 / 8), I2 = (1024 / 64) * (128 / 8), I3 = (2048 / 64) * (128 / 8), I4 = (1024 / 64) * (512 / 8), I5 = I4,
                        I6 = (1024 / 64) * (1024 / 8), I7 = (2 * DFF / 64) * (1024 / 8), I8 = (1024 / 64) * (DFF / 8), ITOT = I0 + I1 + I2 + I3 + I4 + I5 + I6 + I7 + I8;
          auto do_item = [&](int gi) { int r = gi;
              if (r < I0) { xpose_one(WIN, DIN_PAD, 1024, [=](int n, int k) -> float { int src;
                  if (n < 384) src = n; else if (n < 416) { const int j = n - 384; src = 384 + (j & 1) * 16 + (j >> 1); } else if (n < 512) src = -1;
                  else if (n < 1024) src = 416 + (n - 512); else if (n < 1536) src = 928 + (n - 1024); else src = 1440 + (n - 1536);
                  return src < 0 ? 0.f : w_in[(size_t)k * DIN_SRC + src]; }, r, lane); return; } r -= I0;
              if (r < I1) { xpose_one(WQB, 768, 256, [=](int n, int k) -> float { const int h = n / 96, dp = n % 96; int d = dp; if (dp >= 64) { const int j = dp - 64; d = 64 + (j & 1) * 16 + (j >> 1); }
                  return w_qb[(size_t)k * 768 + h * 96 + d] * g_q[k]; }, r, lane); return; } r -= I1;
              if (r < I2) { xpose_one(WKVB, 1024, 128, [=](int n, int k) -> float { const int nn = n & 511, h = nn >> 6, d = nn & 63; return w_kvb[(size_t)k * 1024 + h * 128 + (n >> 9) * 64 + d] * g_kv[k]; }, r, lane); return; } r -= I2;
              if (r < I3) { xpose_one(WG, 2048, 128, [=](int n, int k) -> float { const int g = n >> 8, bj = (n >> 7) & 1, j = n & 127, blk = g >> 1, dir = g & 1;
                  return (bj ? wi_ : wr_)[((size_t)(dir * 4 + blk) * 128 + k) * 128 + j]; }, r, lane); return; } r -= I3;
              if (r < I4) { xpose_one(WOA, 1024, 512, [=](int n, int k) -> float { return w_oa[(size_t)k * 1024 + n]; }, r, lane); return; } r -= I4;
              if (r < I5) { xpose_one(WOL, 1024, 512, [=](int n, int k) -> float { return w_ol[(size_t)k * 1024 + n]; }, r, lane); return; } r -= I5;
              if (r < I6) { xpose_one(WOUT, 1024, 1024, [=](int n, int k) -> float { return w_o[(size_t)k * 1024 + n]; }, r, lane); return; } r -= I6;
              if (r < I7) { xpose_one(WGU, 2 * DFF, 1024, [=](int n, int k) -> float { const int pn = n >> 8, bj = (n >> 7) & 1, j = n & 127; return (bj ? wu_ : wg_)[(size_t)k * DFF + pn * 128 + j] * g2[k]; }, r, lane); return; } r -= I7;
              xpose_one(WD, 1024, DFF, [=](int n, int k) -> float { return w_d[(size_t)k * 1024 + n]; }, r, lane); };
          const float* x = args.in[0]; const float* g1 = args.in[1];
          f32x4 gv[4];
#pragma unroll
          for (int j = 0; j < 4; ++j) gv[j] = *((const f32x4*)g1 + lane + 64 * j);
          int gi = gw;
          for (int m = gw; m < T; m += 2 * NGW) { const int m2 = m + NGW; const bool two = m2 < T; const int mb = two ? m2 : m;
              const f32x4* xr = (const f32x4*)(x + (size_t)m * DM) + lane; const f32x4* xr2 = (const f32x4*)(x + (size_t)mb * DM) + lane; f32x4 v[4], v2[4]; float s = 0.f, s2 = 0.f;
#pragma unroll
              for (int j = 0; j < 4; ++j) { v[j] = xr[64 * j]; v2[j] = xr2[64 * j]; }
              if (gi < ITOT) { do_item(gi); gi += NGW; }
#pragma unroll
              for (int j = 0; j < 4; ++j) { s += (v[j].x * v[j].x + v[j].y * v[j].y) + (v[j].z * v[j].z + v[j].w * v[j].w); s2 += (v2[j].x * v2[j].x + v2[j].y * v2[j].y) + (v2[j].z * v2[j].z + v2[j].w * v2[j].w); }
              const float rstd = rsqrtf(wave_sum(s) * (1.0f / DM) + EPS), rstd2 = rsqrtf(wave_sum(s2) * (1.0f / DM) + EPS);
              u32x2* o8 = (u32x2*)(XN + (size_t)m * DM) + lane; u32x2* o82 = (u32x2*)(XN + (size_t)mb * DM) + lane;
#pragma unroll
              for (int j = 0; j < 4; ++j) { const f32x4 y = v[j] * rstd * gv[j]; u32x2 w2; w2.x = cvt_pk_bf16(y.x, y.y); w2.y = cvt_pk_bf16(y.z, y.w); o8[64 * j] = w2; }
              if (two) {
#pragma unroll
                  for (int j = 0; j < 4; ++j) { const f32x4 y = v2[j] * rstd2 * gv[j]; u32x2 w2; w2.x = cvt_pk_bf16(y.x, y.y); w2.y = cvt_pk_bf16(y.z, y.w); o82[64 * j] = w2; } } }
          for (; gi < ITOT; gi += NGW) do_item(gi);
        }
    }
    SEAM(0);
    if (IN(1)) {
        pg8::Gemm g{XN, XN, WIN, WIN, 1024, 1024, 1024, 0, 0}; pg8::StaticOrder S; S.init(T, DIN_PAD, G, bid);
        EpiProj E{QA, KVA, KR, LX, LY, GATES, SSQ, SSKV, ROPE};
        pg8::gemm_phase<EpiProj, pg8::StaticOrder, true>(lds, g, S, E);
    }
    SEAM(1);
    if (IN(2)) { PHASE_IDS;
        if (P2SUB & 1) { const float* cw = args.in[8]; const float* cb = args.in[9]; const int c8 = (gtid & 63) * 8;
          float w[4][8], bias[8];
#pragma unroll
          for (int e = 0; e < 8; ++e) { bias[e] = cb[c8 + e];
#pragma unroll
              for (int j = 0; j < 4; ++j) w[j][e] = cw[j * 512 + c8 + e]; }
          const int rstride = NTH >> 6;
          for (int row = gtid >> 6; row < T; row += 2 * rstride) { const int rowb = (row + rstride < T) ? row + rstride : row;
              u32x4 xa[4], xb[4];
#pragma unroll
              for (int j = 0; j < 4; ++j) { const int ta = (row & (SEQ - 1)) - 2 + j, tb = (rowb & (SEQ - 1)) - 2 + j;
                  xa[j] = (ta >= 0 && ta < SEQ) ? *(const u32x4*)(LX + (size_t)(row - 2 + j) * 512 + c8) : (u32x4){0u, 0u, 0u, 0u};
                  xb[j] = (tb >= 0 && tb < SEQ) ? *(const u32x4*)(LX + (size_t)(rowb - 2 + j) * 512 + c8) : (u32x4){0u, 0u, 0u, 0u}; }
              float a[8], bq[8];
#pragma unroll
              for (int e = 0; e < 8; ++e) { a[e] = bias[e]; bq[e] = bias[e]; }
#pragma unroll
              for (int j = 0; j < 4; ++j) { f32x4 x0, x1, y0, y1; unpack8(xa[j], x0, x1); unpack8(xb[j], y0, y1);
#pragma unroll
                  for (int e = 0; e < 4; ++e) { a[e] += w[j][e] * x0[e]; a[4 + e] += w[j][4 + e] * x1[e]; bq[e] += w[j][e] * y0[e]; bq[4 + e] += w[j][4 + e] * y1[e]; } }
              u32x4 o; o.x = cvt_pk_bf16(a[0], a[1]); o.y = cvt_pk_bf16(a[2], a[3]); o.z = cvt_pk_bf16(a[4], a[5]); o.w = cvt_pk_bf16(a[6], a[7]);
              *(u32x4*)(XC + (size_t)row * 512 + c8) = o;
              if (rowb != row) { u32x4 o2; o2.x = cvt_pk_bf16(bq[0], bq[1]); o2.y = cvt_pk_bf16(bq[2], bq[3]); o2.z = cvt_pk_bf16(bq[4], bq[5]); o2.w = cvt_pk_bf16(bq[6], bq[7]);
                  *(u32x4*)(XC + (size_t)rowb * 512 + c8) = o2; } } }
        if (P2SUB & 2) { pg8::Gemm g{QA, QA, WQB, WQB, 256, 256, 256, 0, 0}; pg8::StaticOrder S; S.init(T, 768, G, bid); EpiQ E{Qb, SSQ, ROPE};
          pg8::gemm_phase<EpiQ, pg8::StaticOrder, true>(lds, g, S, E); }
        if (P2SUB & 4) { pg8::Gemm g{KVA, KVA, WKVB, WKVB, 128, 128, 128, 0, 0}; pg8::StaticOrder S; S.init(T, 1024, G, bid); EpiKV E{KN, Vb, SSKV};
          pg8::gemm_phase<EpiKV, pg8::StaticOrder, true>(lds, g, S, E); }
    }
    SEAM(2);
    if (IN(3)) {
        pg8::Gemm g{XC, XC, WG, WG, 512, 128, 128, 1, 128}; pg8::StaticOrder S; S.init(T, 2048, G, bid);
        EpiGates E{XC, AU, args.in[11], args.in[13], SP8};
        pg8::gemm_phase<EpiGates, pg8::StaticOrder, true>(lds, g, S, E);
    }
    SEAM(3);
    if (IN(4)) {
        __syncthreads();
        for (int it = bid; it < NBATCH * 8; it += G) scan_item(it >> 3, it & 7, AU, LY, REC, (float*)lds_raw);
        const int vcu = (G % 8 == 0) ? (bid % 8) * (G / 8) + bid / 8 : bid;
        for (int un = vcu; un < NBATCH * 8 * 8; un += G) { const int bh = un >> 3, qb = un & 7, b = bh >> 3, h = bh & 7; const size_t rb = (size_t)b * SEQ;
            att::attn_unit(Qb + (rb + qb * 256) * 768 + h * 96, KN + rb * 512 + h * 64, KR + rb * 32, Vb + rb * 512 + h * 64, ATT + (rb + qb * 256) * 512 + h * 64, (char*)lds_raw); }
    }
    SEAM(4);
    if (IN(5)) {
        pg8::Gemm g{ATT, REC, WOA, WOL, 512, 512, 512, 0, 0}; pg8::DualOrder S; S.S.init(T, 1024, G, bid);
        EpiMerge E{GATES, MERGED};
        pg8::gemm_phase<EpiMerge, pg8::DualOrder, true>(lds, g, S, E);
    }
    SEAM(5);
    if (IN(6)) {
        pg8::Gemm g{MERGED, MERGED, WOUT, WOUT, 1024, 1024, 1024, 0, 0}; pg8::StaticOrder S; S.init(T, 1024, G, bid);
        EpiOut E{args.in[0], X1B, SS2};
        pg8::gemm_phase<EpiOut, pg8::StaticOrder, true>(lds, g, S, E);
    }
    SEAM(6);
    if (IN(7)) {
        pg8::Gemm g{X1B, X1B, WGU, WGU, 1024, 1024, 1024, 0, 0}; pg8::StaticOrder S; S.init(T, 2 * DFF, G, bid);
        EpiFfn E{HID, SS2};
        pg8::gemm_phase<EpiFfn, pg8::StaticOrder, true>(lds, g, S, E);
    }
    SEAM(7);
    if (IN(8)) {
        pg8::Gemm g{HID, HID, WD, WD, DFF, DFF, DFF, 0, 0}; pg8::StaticOrder S; S.init(T, 1024, G, bid);
        EpiDown E{X1B, SS3};
        pg8::gemm_phase<EpiDown, pg8::StaticOrder, true>(lds, g, S, E);
    }
    SEAM(8);
    if (IN(9)) { PHASE_IDS;
        const float* gf = args.in[21]; f32x4 gv[4];
#pragma unroll
        for (int j = 0; j < 4; ++j) gv[j] = *((const f32x4*)gf + lane + 64 * j);
        for (int m = gw; m < T; m += NGW) { f32x4* xr = (f32x4*)(args.out + (size_t)m * DM) + lane; const u32x2* br_ = (const u32x2*)(X1B + (size_t)m * DM) + lane; const float rstd = rsqrtf(SS3[m] * (1.0f / DM) + EPS);
            u32x2 w2[4];
#pragma unroll
            for (int j = 0; j < 4; ++j) w2[j] = br_[64 * j];
#pragma unroll
            for (int j = 0; j < 4; ++j) { const f32x4 v = (f32x4){bf_lo(w2[j].x), bf_hi(w2[j].x), bf_lo(w2[j].y), bf_hi(w2[j].y)}; xr[64 * j] = v * rstd * gv[j]; } }
    }
#if PROBE_MASK
    SEAM(9);
    if (bid == 0 && tid == 0) { const unsigned long long t0_ = __builtin_amdgcn_s_memrealtime(); while (__builtin_amdgcn_s_memrealtime() - t0_ < pr_acc) __builtin_amdgcn_s_sleep(8); }
#endif
#undef IN
#undef SEAM
}

constexpr int LDS_BYTES = 147456;
constexpr int N_PHASES = 10;
extern "C" void kernel_launch(void* const* d_in, const int* in_sizes, int n_in, void* d_out, int out_size, void* d_ws, size_t ws_size, hipStream_t stream) {
    static int grid = 0;
    if (grid == 0) {
        if (n_in != 22 || out_size != T * DM || ws_size < WS_END) { fprintf(stderr, "kernel_launch: unexpected shapes n_in %d out %d ws %zu\n", n_in, out_size, ws_size); grid = -1; return; }
        int dev = 0, cus = 0, per_cu = 0;
        hipGetDevice(&dev); hipDeviceGetAttribute(&cus, hipDeviceAttributeMultiprocessorCount, dev);
        if (hipFuncSetAttribute((const void*)mega_fwd, hipFuncAttributeMaxDynamicSharedMemorySize, LDS_BYTES) != hipSuccess) { fprintf(stderr, "kernel_launch: hipFuncSetAttribute failed\n"); grid = -1; return; }
        if (hipOccupancyMaxActiveBlocksPerMultiprocessor(&per_cu, (const void*)mega_fwd, 512, LDS_BYTES) != hipSuccess || per_cu < 1) { fprintf(stderr, "kernel_launch: occupancy query gives %d\n", per_cu); per_cu = 1; }
        (void)hipGetLastError();
        grid = cus * (per_cu > 1 ? 1 : per_cu);
        if (grid > 256) grid = 256;
    }
    if (grid < 0) return;
    Args a{};
    for (int i = 0; i < 22; ++i) a.in[i] = (const float*)d_in[i];
    a.out = (float*)d_out; a.ws = (unsigned char*)d_ws;
#if MK_SINGLE
    if (hipMemsetAsync((char*)d_ws + WS_BAR, 0, 16384, stream) != hipSuccess) { fprintf(stderr, "kernel_launch: memset failed\n"); return; }
    a.ph_lo = 0; a.ph_hi = N_PHASES;
    void* kargs[] = {&a};
    hipError_t e = hipLaunchCooperativeKernel((const void*)mega_fwd, dim3(grid), dim3(512), kargs, LDS_BYTES, stream);
    if (e != hipSuccess) fprintf(stderr, "cooperative launch failed: %s (grid %d)\n", hipGetErrorString(e), grid);
#else
    for (int p = 0; p < N_PHASES; ++p) { a.ph_lo = p; a.ph_hi = p + 1; hipLaunchKernelGGL(mega_fwd, dim3(grid), dim3(512), LDS_BYTES, stream, a); }
#endif
}
```

```cpp
#include <hip/hip_runtime.h>
#include <hip/hip_cooperative_groups.h>
#include <hip/hip_bf16.h>
#include <hip/hip_fp16.h>
#include <cstdio>
#include <cstdint>
namespace cg = cooperative_groups;

#ifndef PHASE_MASK
#define PHASE_MASK 0x3ff
#endif
#ifndef P2SUB
#define P2SUB 7
#endif
#ifndef PROBE_MASK
#define PROBE_MASK 0
#endif
#ifndef MK_SINGLE
#define MK_SINGLE 1
#endif

constexpr int T = 65536, DM = 1024, SEQ = 2048, NBATCH = 32;
constexpr int DIN_SRC = 3488, DIN_PAD = 3584, DFF = 2816;
constexpr float EPS = 1e-6f;
constexpr float LOG2E = 1.4426950408889634f;

typedef unsigned short bf16_t;
typedef short bf16x8 __attribute__((ext_vector_type(8)));
typedef short s16x4 __attribute__((ext_vector_type(4)));
typedef float f32x4 __attribute__((ext_vector_type(4)));
typedef float f32x2 __attribute__((ext_vector_type(2)));
typedef float f32x16 __attribute__((ext_vector_type(16)));
typedef unsigned u32x4 __attribute__((ext_vector_type(4)));
typedef unsigned u32x2 __attribute__((ext_vector_type(2)));
#define LAS __attribute__((address_space(3)))

__device__ __forceinline__ unsigned cvt_pk_bf16(float lo, float hi) { unsigned r; asm volatile("v_cvt_pk_bf16_f32 %0, %1, %2" : "=v"(r) : "v"(lo), "v"(hi)); return r; }
__device__ __forceinline__ float bf_lo(unsigned w) { return __uint_as_float(w << 16); }
__device__ __forceinline__ float bf_hi(unsigned w) { return __uint_as_float(w & 0xffff0000u); }
__device__ __forceinline__ float fsigmoid(float x) { return __builtin_amdgcn_rcpf(1.0f + __builtin_amdgcn_exp2f(-x * LOG2E)); }
__device__ __forceinline__ u32x4 pack8(f32x4 a, f32x4 b) { u32x4 w; w.x = cvt_pk_bf16(a[0], a[1]); w.y = cvt_pk_bf16(a[2], a[3]); w.z = cvt_pk_bf16(b[0], b[1]); w.w = cvt_pk_bf16(b[2], b[3]); return w; }
__device__ __forceinline__ void unpack8(u32x4 w, f32x4& a, f32x4& b) { a = (f32x4){bf_lo(w.x), bf_hi(w.x), bf_lo(w.y), bf_hi(w.y)}; b = (f32x4){bf_lo(w.z), bf_hi(w.z), bf_lo(w.w), bf_hi(w.w)}; }
__device__ __forceinline__ float wave_sum(float v) {
#pragma unroll
    for (int o = 1; o < 64; o <<= 1) v += __shfl_xor(v, o);
    return v;
}

namespace pg8 {
constexpr int BM = 256, BK = 64, HALF = 128, HTB = HALF * BK * 2, STAGE_BYTES = 8 * HTB, NXCD = 8, WGM = 8;
__host__ __device__ __forceinline__ int lds_byte(int r, int c) { const int st = (r >> 4) * 2 + (c >> 5), rr = r & 15, cc = c & 31, ob = rr * 64 + cc * 2; return st * 1024 + (ob ^ (((ob >> 9) & 1) << 5)); }
__host__ __device__ __forceinline__ void stage_rc(int b, int& R, int& C) { const int st = b / 1024, sb = b % 1024, swz = sb ^ (((sb >> 9) & 1) << 5); R = (st >> 1) * 16 + swz / 64; C = (st & 1) * 32 + (swz % 64) / 2; }
__host__ __device__ __forceinline__ int perm32(int rho) { const int n = rho >> 4, i = rho & 15; return 8 * (i >> 2) + 4 * n + (i & 3); }

struct Unit { int pm, pn, sel; };
struct Gemm {
    const bf16_t *A0, *A1, *B0, *B1; int lda, ldb, K; int a_grp_shift, a_grp_cols;
    __device__ __forceinline__ const char* a_ptr(const Unit& u) const { return (const char*)(u.sel ? A1 : A0) + ((size_t)u.pm * BM * lda + (size_t)(u.pn >> a_grp_shift) * a_grp_cols) * 2; }
    __device__ __forceinline__ const char* b_ptr(const Unit& u) const { return (const char*)(u.sel ? B1 : B0) + (size_t)u.pn * BM * ldb * 2; }
};

struct StaticOrder {
    int nM, nN, nwg, G, c;
    __device__ void init(int M, int N, int G_, int c_) { nM = M / BM; nN = N / BM; nwg = nM * nN; G = G_; c = c_; }
    __device__ bool next(int i, Unit& u) const {
        const long L = (long)i * G + c; if (L >= nwg) return false;
        int wgid = (int)L; { const int q = nwg / NXCD, r = nwg % NXCD, xcd = wgid % NXCD, off = wgid / NXCD; wgid = (xcd < r ? xcd * (q + 1) : r * (q + 1) + (xcd - r) * q) + off; }
        const int nig = WGM * nN, gid = wgid / nig, fm = gid * WGM, gsz = (nM - fm) < WGM ? (nM - fm) : WGM;
        u.pm = fm + ((wgid % nig) % gsz); u.pn = (wgid % nig) / gsz; u.sel = 0; return true;
    }
};
struct DualOrder {
    StaticOrder S;
    __device__ bool next(int i, Unit& u) const { if (!S.next(i >> 1, u)) return false; u.sel = i & 1; return true; }
};

template <class Epi, class Sched, bool ALIGN_EPI>
__device__ __forceinline__ void gemm_phase(LAS unsigned char* lds, const Gemm g, const Sched& S, const Epi& E) {
    int tid = threadIdx.x; asm volatile("" : "+v"(tid) :: "memory");
    const int wid = __builtin_amdgcn_readfirstlane(tid >> 6), lane = tid & 63, wr = wid >> 2, wc = wid & 3, fr = lane & 15, fq = lane >> 4;
    int lda_ = g.lda, ldb_ = g.ldb, K = g.K; asm volatile("" : "+s"(lda_), "+s"(ldb_), "+s"(K) :: "memory");
    const int nt = K / BK;
    unsigned voffA[2], voffB[2];
#pragma unroll
    for (int i = 0; i < 2; ++i) { int R, C; stage_rc(tid * 16 + i * 8192, R, C); const int Rb = Epi::PERM ? ((R & ~31) + perm32(R & 31)) : R;
        voffA[i] = (unsigned)(R * lda_ + C) * 2u; voffB[i] = (unsigned)(Rb * ldb_ + C) * 2u; }
    const size_t kstep = (size_t)(BK * 2);
    const size_t hstepA = (size_t)HALF * lda_ * 2, hstepB = (size_t)HALF * ldb_ * 2;
    const unsigned ldsw = (unsigned)wid * 1024u;
    const int aoff = lds_byte(wr * 64 + fr, fq * 8), boff = lds_byte(wc * 32 + fr, fq * 8);
#define PG8_SA(b, h) (((b) * 2 + (h)) * HTB)
#define PG8_SB(b, h) ((4 + (b) * 2 + (h)) * HTB)
#define PG8_STAGE(bufoff, gbase, voff) do { _Pragma("unroll") for (int _i = 0; _i < 2; ++_i) \
        __builtin_amdgcn_global_load_lds((const unsigned*)((const char*)(gbase) + (voff)[_i]), (LAS unsigned*)(lds + (bufoff) + ldsw + _i * 8192), 16, 0, 0); } while (0)
#define PG8_LDA(dst, b, h) do { _Pragma("unroll") for (int m = 0; m < 4; ++m) _Pragma("unroll") for (int k = 0; k < 2; ++k) dst[m][k] = *(const LAS bf16x8*)(lds + PG8_SA(b, h) + aoff + m * 2048 + k * 1024); } while (0)
#define PG8_LDB(dst, b, h) do { _Pragma("unroll") for (int n = 0; n < 2; ++n) _Pragma("unroll") for (int k = 0; k < 2; ++k) dst[n][k] = *(const LAS bf16x8*)(lds + PG8_SB(b, h) + boff + n * 2048 + k * 1024); } while (0)
#define PG8_MMA(ai, bj, At, Bt) do { __builtin_amdgcn_s_setprio(1); _Pragma("unroll") for (int m = 0; m < 4; ++m) _Pragma("unroll") for (int n = 0; n < 2; ++n) _Pragma("unroll") for (int k = 0; k < 2; ++k) \
        acc[ai][bj][m][n] = __builtin_amdgcn_mfma_f32_16x16x32_bf16(Bt[n][k], At[m][k], acc[ai][bj][m][n], 0, 0, 0); __builtin_amdgcn_s_setprio(0); } while (0)
#define PG8_WAIT_V(n) asm volatile("s_waitcnt vmcnt(" #n ")" ::: "memory")
#define PG8_WAIT_L(n) asm volatile("s_waitcnt lgkmcnt(" #n ")" ::: "memory")
#define PG8_BAR __builtin_amdgcn_s_barrier()
#define PG8_SCHED __builtin_amdgcn_sched_barrier(0)
    Unit cur, nxt; int ui = 0;
    if (!S.next(0, cur)) return;
    f32x4 acc[2][2][4][2];
#pragma unroll
    for (int a = 0; a < 2; ++a)
#pragma unroll
        for (int b = 0; b < 2; ++b)
#pragma unroll
            for (int m = 0; m < 4; ++m)
#pragma unroll
                for (int n = 0; n < 2; ++n) acc[a][b][m][n] = (f32x4){0.f, 0.f, 0.f, 0.f};
    bf16x8 At[4][2], B0[2][2], B1[2][2];
    const char* cA = g.a_ptr(cur); const char* cB = g.b_ptr(cur);
    PG8_STAGE(PG8_SB(0, 0), cB, voffB); PG8_STAGE(PG8_SB(0, 1), cB + hstepB, voffB); PG8_STAGE(PG8_SA(0, 0), cA, voffA); PG8_STAGE(PG8_SA(0, 1), cA + hstepA, voffA);
    if (wr == 1) PG8_BAR;
    PG8_WAIT_V(2); PG8_BAR;
    PG8_STAGE(PG8_SB(1, 0), cB + kstep, voffB); PG8_STAGE(PG8_SA(1, 0), cA + kstep, voffA); PG8_STAGE(PG8_SB(1, 1), cB + hstepB + kstep, voffB);
    PG8_WAIT_V(6); PG8_BAR;
    for (;;) {
        const bool has_next = S.next(ui + 1, nxt);
        const char* nA = has_next ? g.a_ptr(nxt) : cA; const char* nB = has_next ? g.b_ptr(nxt) : cB;
        for (int t = 0; t < nt; t += 2) {
            const bool last = (t == nt - 2);
            const char* a1 = cA + (size_t)(t + 1) * kstep;
            const char* a2 = last ? nA : cA + (size_t)(t + 2) * kstep; const char* b2 = last ? nB : cB + (size_t)(t + 2) * kstep;
            const char* a3 = a2 + kstep; const char* b3 = b2 + kstep;
            PG8_LDB(B0, 0, 0); PG8_LDB(B1, 0, 1); PG8_SCHED; PG8_LDA(At, 0, 0); PG8_STAGE(PG8_SA(1, 1), a1 + hstepA, voffA);
            PG8_WAIT_V(8); PG8_WAIT_L(0); PG8_BAR; PG8_MMA(0, 0, At, B0); PG8_MMA(0, 1, At, B1); PG8_BAR; PG8_SCHED;
            PG8_LDA(At, 0, 1); PG8_STAGE(PG8_SB(0, 0), b2, voffB); PG8_STAGE(PG8_SB(0, 1), b2 + hstepB, voffB); PG8_STAGE(PG8_SA(0, 0), a2, voffA);
            PG8_WAIT_V(8); PG8_WAIT_L(0); PG8_BAR; PG8_MMA(1, 0, At, B0); PG8_MMA(1, 1, At, B1); PG8_BAR; PG8_SCHED;
            PG8_LDB(B0, 1, 0); PG8_LDB(B1, 1, 1); PG8_SCHED; PG8_LDA(At, 1, 0); PG8_STAGE(PG8_SA(0, 1), a2 + hstepA, voffA);
            PG8_WAIT_V(8); PG8_WAIT_L(0); PG8_BAR; PG8_MMA(0, 0, At, B0); PG8_MMA(0, 1, At, B1); PG8_BAR; PG8_SCHED;
            PG8_LDA(At, 1, 1); PG8_STAGE(PG8_SB(1, 0), b3, voffB); PG8_STAGE(PG8_SB(1, 1), b3 + hstepB, voffB); PG8_STAGE(PG8_SA(1, 0), a3, voffA);
            PG8_WAIT_V(8); PG8_WAIT_L(0); PG8_BAR; PG8_MMA(1, 0, At, B0); PG8_MMA(1, 1, At, B1); PG8_BAR; PG8_SCHED;
        }
        if constexpr (ALIGN_EPI) { if (wr == 0) PG8_BAR; }
        PG8_SCHED; E(acc, cur, wr, wc, fr, fq); PG8_SCHED;
        if (!has_next) break;
        bool keep_ = false; if constexpr (Epi::DUAL) keep_ = (cur.sel == 0);
        if (!keep_)
#pragma unroll
        for (int a = 0; a < 2; ++a)
#pragma unroll
            for (int b = 0; b < 2; ++b)
#pragma unroll
                for (int m = 0; m < 4; ++m)
#pragma unroll
                    for (int n = 0; n < 2; ++n) acc[a][b][m][n] = (f32x4){0.f, 0.f, 0.f, 0.f};
        cur = nxt; cA = nA; cB = nB; ++ui;
        if constexpr (ALIGN_EPI) { if (wr == 1) PG8_BAR; }
    }
    PG8_WAIT_V(0);
    if constexpr (!ALIGN_EPI) { if (wr == 0) PG8_BAR; }
    PG8_BAR;
#undef PG8_SA
#undef PG8_SB
#undef PG8_STAGE
#undef PG8_LDA
#undef PG8_LDB
#undef PG8_MMA
#undef PG8_WAIT_V
#undef PG8_WAIT_L
#undef PG8_BAR
#undef PG8_SCHED
}
}
using pg8::Unit;
typedef f32x4 Acc[2][2][4][2];

__device__ __forceinline__ void rope4(f32x4& v0, f32x4& v1, const float* rp, int i0) {
    const f32x4 c = *(const f32x4*)(rp + i0), s = *(const f32x4*)(rp + 16 + i0);
    const f32x4 a = v0, b = v1;
    v0[0] = a[0] * c[0] - a[1] * s[0]; v0[1] = a[1] * c[0] + a[0] * s[0];
    v0[2] = a[2] * c[1] - a[3] * s[1]; v0[3] = a[3] * c[1] + a[2] * s[1];
    v1[0] = b[0] * c[2] - b[1] * s[2]; v1[1] = b[1] * c[2] + b[0] * s[2];
    v1[2] = b[2] * c[3] - b[3] * s[3]; v1[3] = b[3] * c[3] + b[2] * s[3];
}
__device__ __forceinline__ float gelu_tanh(float y) { const float z = 0.7978845608028654f * (y + 0.044715f * y * y * y); return y * fsigmoid(2.0f * z); }

struct EpiProj {
    static constexpr bool PERM = true, DUAL = false;
    bf16_t *QA, *KVA, *KR, *LX, *LY, *GATES; float *SSQ, *SSKV; const float* rope;
    __device__ __forceinline__ void operator()(const Acc& acc, const Unit& u, int wr, int wc, int fr, int fq) const {
        const int pn = u.pn, rowt = u.pm * 256 + wr * 64 + fr, cw = wc * 32 + 8 * fq;
        if (pn >= 2) {
            bf16_t* base; int ld, mode;
            if (pn >= 6) { base = GATES + (pn - 6) * 256; ld = 2048; mode = 2; } else if (pn >= 4) { base = LY + (pn - 4) * 256; ld = 512; mode = 1; } else { base = LX + (pn - 2) * 256; ld = 512; mode = 0; }
#pragma unroll
            for (int ai = 0; ai < 2; ++ai)
#pragma unroll
                for (int m = 0; m < 4; ++m) { const unsigned row = rowt + ai * 128 + m * 16;
#pragma unroll
                    for (int bj = 0; bj < 2; ++bj) { f32x4 v0 = acc[ai][bj][m][0], v1 = acc[ai][bj][m][1];
                        if (mode == 2) {
#pragma unroll
                            for (int e = 0; e < 4; ++e) { v0[e] = fsigmoid(v0[e]); v1[e] = fsigmoid(v1[e]); } }
                        else if (mode == 1) {
#pragma unroll
                            for (int e = 0; e < 4; ++e) { v0[e] = gelu_tanh(v0[e]); v1[e] = gelu_tanh(v1[e]); } }
                        *(u32x4*)(base + row * ld + bj * 128 + cw) = pack8(v0, v1); } }
        } else if (pn == 0) {
#pragma unroll
            for (int ai = 0; ai < 2; ++ai)
#pragma unroll
                for (int m = 0; m < 4; ++m) { const unsigned row = rowt + ai * 128 + m * 16; float ss = 0.f;
#pragma unroll
                    for (int bj = 0; bj < 2; ++bj) { const f32x4 v0 = acc[ai][bj][m][0], v1 = acc[ai][bj][m][1];
                        ss += (v0[0] * v0[0] + v0[1] * v0[1]) + (v0[2] * v0[2] + v0[3] * v0[3]) + (v1[0] * v1[0] + v1[1] * v1[1]) + (v1[2] * v1[2] + v1[3] * v1[3]);
                        *(u32x4*)(QA + row * 256 + bj * 128 + cw) = pack8(v0, v1); }
                    ss += __shfl_xor(ss, 16); ss += __shfl_xor(ss, 32);
                    if (fq == 0) atomicAdd(SSQ + row, ss); }
        } else {
#pragma unroll
            for (int ai = 0; ai < 2; ++ai)
#pragma unroll
                for (int m = 0; m < 4; ++m) { const unsigned row = rowt + ai * 128 + m * 16;
                    { const f32x4 v0 = acc[ai][0][m][0], v1 = acc[ai][0][m][1];
                      float ss = (v0[0] * v0[0] + v0[1] * v0[1]) + (v0[2] * v0[2] + v0[3] * v0[3]) + (v1[0] * v1[0] + v1[1] * v1[1]) + (v1[2] * v1[2] + v1[3] * v1[3]);
                      *(u32x4*)(KVA + row * 128 + cw) = pack8(v0, v1);
                      ss += __shfl_xor(ss, 16); ss += __shfl_xor(ss, 32);
                      if (fq == 0) atomicAdd(SSKV + row, ss); }
                    if (wc == 0) { f32x4 v0 = acc[ai][1][m][0], v1 = acc[ai][1][m][1];
                      rope4(v0, v1, rope + (row & (SEQ - 1)) * 32, 4 * fq);
                      *(u32x4*)(KR + row * 32 + 8 * fq) = pack8(v0, v1); } }
        }
    }
};

constexpr float QSCALE = 0.10206207261596577f * 1.4426950408889634f;
struct EpiQ {
    static constexpr bool PERM = true, DUAL = false;
    bf16_t* Q; const float* SSQ; const float* rope;
    __device__ __forceinline__ void operator()(const Acc& acc, const Unit& u, int wr, int wc, int fr, int fq) const {
        const int rowt = u.pm * 256 + wr * 64 + fr;
        const int c00 = u.pn * 256 + wc * 32 + 8 * fq, c01 = c00 + 128, d0 = c00 % 96, d1 = c01 % 96;
#pragma unroll
        for (int am = 0; am < 4; ++am) { const int ai = am >> 1, mb = (am & 1) * 2;
            f32x4 cs[2][2][2]; float ss[2];
#pragma unroll
            for (int mm = 0; mm < 2; ++mm) ss[mm] = SSQ[(unsigned)(rowt + ai * 128 + (mb + mm) * 16)];
#pragma unroll
            for (int mm = 0; mm < 2; ++mm) { const unsigned pos = (unsigned)(rowt + ai * 128 + (mb + mm) * 16) & (SEQ - 1);
#pragma unroll
                for (int bj = 0; bj < 2; ++bj) { const int d = bj ? d1 : d0; if (d >= 64) { const float* rp = rope + (pos * 32 + ((d - 64) >> 1)); cs[mm][bj][0] = *(const f32x4*)rp; cs[mm][bj][1] = *(const f32x4*)(rp + 16); }
                    else { cs[mm][bj][0] = (f32x4){1.f, 1.f, 1.f, 1.f}; cs[mm][bj][1] = (f32x4){0.f, 0.f, 0.f, 0.f}; } } }
#pragma unroll
            for (int mm = 0; mm < 2; ++mm) { const int m = mb + mm; const unsigned row = rowt + ai * 128 + m * 16; const float rstd = rsqrtf(ss[mm] * (1.0f / 256.0f) + EPS) * QSCALE;
#pragma unroll
                for (int bj = 0; bj < 2; ++bj) { const int c0 = bj ? c01 : c00;
                    const f32x4 a = acc[ai][bj][m][0] * rstd, b = acc[ai][bj][m][1] * rstd, c = cs[mm][bj][0], sn = cs[mm][bj][1]; f32x4 v0, v1;
                    v0[0] = a[0] * c[0] - a[1] * sn[0]; v0[1] = a[1] * c[0] + a[0] * sn[0]; v0[2] = a[2] * c[1] - a[3] * sn[1]; v0[3] = a[3] * c[1] + a[2] * sn[1];
                    v1[0] = b[0] * c[2] - b[1] * sn[2]; v1[1] = b[1] * c[2] + b[0] * sn[2]; v1[2] = b[2] * c[3] - b[3] * sn[3]; v1[3] = b[3] * c[3] + b[2] * sn[3];
                    if ((bj ? d1 : d0) < 64) { v0 = a; v1 = b; }
                    *(u32x4*)(Q + (row * 768 + c0)) = pack8(v0, v1); } }
            asm volatile("" ::: "memory"); }
    }
};

struct EpiKV {
    static constexpr bool PERM = true, DUAL = false;
    bf16_t *KN, *V; const float* SSKV;
    __device__ __forceinline__ void operator()(const Acc& acc, const Unit& u, int wr, int wc, int fr, int fq) const {
        const int rowt = u.pm * 256 + wr * 64 + fr; bf16_t* base = (u.pn < 2 ? KN : V) + (u.pn & 1) * 256; const unsigned cw = wc * 32 + 8 * fq;
        float ss[8];
#pragma unroll
        for (int i = 0; i < 8; ++i) ss[i] = SSKV[(unsigned)(rowt + (i >> 2) * 128 + (i & 3) * 16)];
#pragma unroll
        for (int ai = 0; ai < 2; ++ai)
#pragma unroll
            for (int m = 0; m < 4; ++m) { const unsigned row = rowt + ai * 128 + m * 16; const float rstd = rsqrtf(ss[ai * 4 + m] * (1.0f / 128.0f) + EPS);
#pragma unroll
                for (int bj = 0; bj < 2; ++bj) *(u32x4*)(base + (row * 512 + bj * 128 + cw)) = pack8(acc[ai][bj][m][0] * rstd, acc[ai][bj][m][1] * rstd); }
    }
};

__device__ __forceinline__ unsigned pack_h2(float lo, float hi) { const __half2 h = __floats2half2_rn(lo, hi); return *(const unsigned*)&h; }
struct EpiGates {
    static constexpr bool PERM = true, DUAL = false;
    const bf16_t* XC; unsigned* AU; const float *br, *bi, *sp8;
    __device__ __forceinline__ void operator()(const Acc& acc, const Unit& u, int wr, int wc, int fr, int fq) const {
        const int blk = u.pn >> 1, dir = u.pn & 1, rowt = u.pm * 256 + wr * 64 + fr, j0 = wc * 32 + 8 * fq, ch = blk * 128 + j0;
        const float* pbr = br + (dir * 4 + blk) * 128; const float* pbi = bi + (dir * 4 + blk) * 128; const float* psp = sp8 + dir * 512 + blk * 128;
        u32x4 xw[8];
#pragma unroll
        for (int i = 0; i < 8; ++i) xw[i] = *(const u32x4*)(XC + (unsigned)((rowt + (i >> 2) * 128 + (i & 3) * 16) * 512 + ch));
        f32x4 cbr[2], cbi[2], csp[2];
#pragma unroll
        for (int h = 0; h < 2; ++h) { cbr[h] = *(const f32x4*)(pbr + (unsigned)(j0 + 4 * h)); cbi[h] = *(const f32x4*)(pbi + (unsigned)(j0 + 4 * h)); csp[h] = *(const f32x4*)(psp + (unsigned)(j0 + 4 * h)); }
        unsigned* dst = AU + (size_t)dir * T * 512;
#pragma unroll
        for (int ai = 0; ai < 2; ++ai)
#pragma unroll
            for (int m = 0; m < 4; ++m) { const unsigned row = rowt + ai * 128 + m * 16;
                f32x4 x0, x1; unpack8(xw[ai * 4 + m], x0, x1);
                u32x4 o0, o1;
#pragma unroll
                for (int h = 0; h < 2; ++h) { const f32x4 ar = acc[ai][0][m][h] + cbr[h], aiq = acc[ai][1][m][h] + cbi[h], sp = csp[h], xx = h ? x1 : x0; u32x4 o;
#pragma unroll
                    for (int e = 0; e < 4; ++e) { const float rr = fsigmoid(ar[e]), ii = fsigmoid(aiq[e]); const float la = -rr * sp[e], y = 2.0f * la;
                        float m2 = -y * (1.0f + y * (0.5f + y * (0.16666667f + y * (0.041666668f + y * 0.0083333338f))));
                        if (__builtin_expect(__any(y < -0.25f), 0)) m2 = (y < -0.25f) ? 1.0f - __builtin_amdgcn_exp2f(y * LOG2E) : m2;
                        const float uu = ii * xx[e] * __builtin_amdgcn_sqrtf(m2); o[e] = pack_h2(la * LOG2E, uu); }
                    if (h) o1 = o; else o0 = o; }
                *(u32x4*)(dst + (row * 512 + ch)) = o0; *(u32x4*)(dst + (row * 512 + ch + 4)) = o1; }
    }
};

struct EpiMerge {
    static constexpr bool PERM = true, DUAL = true;
    const bf16_t* GATES; bf16_t* MERGED;
    __device__ __forceinline__ void operator()(Acc& acc, const Unit& u, int wr, int wc, int fr, int fq) const {
        const int rowt = u.pm * 256 + wr * 64 + fr, c0 = u.pn * 256 + wc * 32 + 8 * fq;
#pragma unroll
        for (int ai = 0; ai < 2; ++ai) {
            u32x4 gw_[4][2], hw_[4][2];
#pragma unroll
            for (int m = 0; m < 4; ++m)
#pragma unroll
                for (int bj = 0; bj < 2; ++bj) { const unsigned o = (unsigned)((rowt + ai * 128 + m * 16) * 2048 + c0 + bj * 128);
                    gw_[m][bj] = *(const u32x4*)(GATES + (o + 1024)); if (u.sel == 0) hw_[m][bj] = *(const u32x4*)(GATES + o); else hw_[m][bj] = gw_[m][bj]; }
#pragma unroll
            for (int m = 0; m < 4; ++m) { const unsigned row = rowt + ai * 128 + m * 16;
#pragma unroll
                for (int bj = 0; bj < 2; ++bj) { f32x4 r0, r1, a0, a1; unpack8(gw_[m][bj], r0, r1); unpack8(hw_[m][bj], a0, a1);
                    if (u.sel == 0) {
#pragma unroll
                        for (int e = 0; e < 4; ++e) { acc[ai][bj][m][0][e] *= a0[e] * __builtin_amdgcn_rcpf(r0[e]); acc[ai][bj][m][1][e] *= a1[e] * __builtin_amdgcn_rcpf(r1[e]); } }
                    else { *(u32x4*)(MERGED + (row * 1024 + c0 + bj * 128)) = pack8(acc[ai][bj][m][0] * r0, acc[ai][bj][m][1] * r1); } } }
            asm volatile("" ::: "memory"); }
    }
};

struct EpiOut {
    static constexpr bool PERM = true, DUAL = false;
    const float* X; bf16_t* X1B; float* SS2;
    __device__ __forceinline__ void operator()(const Acc& acc, const Unit& u, int wr, int wc, int fr, int fq) const {
        const int rowt = u.pm * 256 + wr * 64 + fr, c0 = u.pn * 256 + wc * 32 + 8 * fq;
#pragma unroll
        for (int ai = 0; ai < 2; ++ai) {
            f32x4 xv[4][2][2];
#pragma unroll
            for (int m = 0; m < 4; ++m)
#pragma unroll
                for (int bj = 0; bj < 2; ++bj) { const unsigned o = (rowt + ai * 128 + m * 16) * 1024 + c0 + bj * 128; xv[m][bj][0] = __builtin_nontemporal_load((const f32x4*)(X + o)); xv[m][bj][1] = __builtin_nontemporal_load((const f32x4*)(X + (o + 4))); }
#pragma unroll
            for (int m = 0; m < 4; ++m) { const unsigned row = rowt + ai * 128 + m * 16; float ss = 0.f;
#pragma unroll
                for (int bj = 0; bj < 2; ++bj) { const unsigned o = row * 1024 + c0 + bj * 128;
                    const f32x4 v0 = acc[ai][bj][m][0] + xv[m][bj][0], v1 = acc[ai][bj][m][1] + xv[m][bj][1];
                    ss += (v0[0] * v0[0] + v0[1] * v0[1]) + (v0[2] * v0[2] + v0[3] * v0[3]) + (v1[0] * v1[0] + v1[1] * v1[1]) + (v1[2] * v1[2] + v1[3] * v1[3]);
                    *(u32x4*)(X1B + o) = pack8(v0, v1); }
                ss += __shfl_xor(ss, 16); ss += __shfl_xor(ss, 32);
                if (fq == 0) atomicAdd(SS2 + row, ss); }
            asm volatile("" ::: "memory"); }
    }
};

struct EpiFfn {
    static constexpr bool PERM = true, DUAL = false;
    bf16_t* HID; const float* SS2;
    __device__ __forceinline__ void operator()(const Acc& acc, const Unit& u, int wr, int wc, int fr, int fq) const {
        const int rowt = u.pm * 256 + wr * 64 + fr, c0 = u.pn * 128 + wc * 32 + 8 * fq;
        float ss[8];
#pragma unroll
        for (int i = 0; i < 8; ++i) ss[i] = SS2[(unsigned)(rowt + (i >> 2) * 128 + (i & 3) * 16)];
#pragma unroll
        for (int ai = 0; ai < 2; ++ai)
#pragma unroll
            for (int m = 0; m < 4; ++m) { const unsigned row = rowt + ai * 128 + m * 16; const float rstd = rsqrtf(ss[ai * 4 + m] * (1.0f / 1024.0f) + EPS);
                f32x4 h0, h1;
#pragma unroll
                for (int e = 0; e < 4; ++e) { const float g0 = acc[ai][0][m][0][e] * rstd, g1 = acc[ai][0][m][1][e] * rstd;
                    h0[e] = g0 * fsigmoid(g0) * (acc[ai][1][m][0][e] * rstd); h1[e] = g1 * fsigmoid(g1) * (acc[ai][1][m][1][e] * rstd); }
                *(u32x4*)(HID + (row * DFF + c0)) = pack8(h0, h1); }
    }
};

struct EpiDown {
    static constexpr bool PERM = true, DUAL = false;
    bf16_t* X1B; float* SS3;
    __device__ __forceinline__ void operator()(const Acc& acc, const Unit& u, int wr, int wc, int fr, int fq) const {
        const int rowt = u.pm * 256 + wr * 64 + fr, c0 = u.pn * 256 + wc * 32 + 8 * fq;
        u32x4 xv[8][2];
#pragma unroll
        for (int i = 0; i < 8; ++i)
#pragma unroll
            for (int bj = 0; bj < 2; ++bj) xv[i][bj] = *(const u32x4*)(X1B + (unsigned)((rowt + (i >> 2) * 128 + (i & 3) * 16) * 1024 + c0 + bj * 128));
#pragma unroll
        for (int ai = 0; ai < 2; ++ai)
#pragma unroll
            for (int m = 0; m < 4; ++m) { const unsigned row = rowt + ai * 128 + m * 16; float ss = 0.f;
#pragma unroll
                for (int bj = 0; bj < 2; ++bj) { const unsigned o = row * 1024 + c0 + bj * 128; f32x4 p0, p1; unpack8(xv[ai * 4 + m][bj], p0, p1);
                    const f32x4 v0 = acc[ai][bj][m][0] + p0, v1 = acc[ai][bj][m][1] + p1;
                    ss += (v0[0] * v0[0] + v0[1] * v0[1]) + (v0[2] * v0[2] + v0[3] * v0[3]) + (v1[0] * v1[0] + v1[1] * v1[1]) + (v1[2] * v1[2] + v1[3] * v1[3]);
                    *(u32x4*)(X1B + o) = pack8(v0, v1); }
                ss += __shfl_xor(ss, 16); ss += __shfl_xor(ss, 32);
                if (fq == 0) atomicAdd(SS3 + row, ss); }
    }
};

namespace att {
constexpr int NW = 8, QBLK = 32, KVBLK = 64;
constexpr float SCALE = 0.10206207261596577f;
constexpr float THR = 8.f;
constexpr int SHM_V = 16384, SHM_K = 16384;
#define KSWZ(row, colB) ((row) * 256 + ((colB) ^ (((row) & 7) << 4)))
#define SBAR() __builtin_amdgcn_sched_barrier(0)
__device__ __forceinline__ int crow(int r, int hi) { return (r & 3) + 8 * (r >> 2) + 4 * hi; }
template <bool FIRST> __device__ __forceinline__ void partialSM(f32x16& p0, f32x16& p1, float& mref, f32x16& negm, float& alpha) {
  constexpr float THRL = THR * 1.4426950408889634f;
  float pmax = p0[0];
#pragma unroll
  for (int r = 1; r < 16; ++r) pmax = fmaxf(pmax, p0[r]);
#pragma unroll
  for (int r = 0; r < 16; ++r) pmax = fmaxf(pmax, p1[r]);
  { auto rr = __builtin_amdgcn_permlane32_swap(__float_as_uint(pmax), __float_as_uint(pmax), false, false);
    pmax = fmaxf(__uint_as_float(rr[0]), __uint_as_float(rr[1])); }
  if (!FIRST && __builtin_expect(__all(pmax <= THRL), 1)) { alpha = 1.f; }
  else { const float dl = FIRST ? pmax : fmaxf(pmax, 0.f); mref += dl; alpha = FIRST ? 1.f : __builtin_amdgcn_exp2f(-dl);
#pragma unroll
    for (int r = 0; r < 16; ++r) { p0[r] -= dl; p1[r] -= dl; }
    const float nm = -mref;
#pragma unroll
    for (int r = 0; r < 16; ++r) negm[r] = nm; }
#pragma unroll
  for (int r = 0; r < 16; ++r) p0[r] = __builtin_amdgcn_exp2f(p0[r]);
}
__device__ __forceinline__ void finishSM(f32x16& p0, f32x16& p1, float alpha, float& l_reg, bf16x8& pa0, bf16x8& pa1, bf16x8& pa2, bf16x8& pa3) {
#pragma unroll
  for (int r = 0; r < 16; ++r) p1[r] = __builtin_amdgcn_exp2f(p1[r]);
  float ps = 0;
#pragma unroll
  for (int r = 0; r < 16; ++r) ps += p0[r];
#pragma unroll
  for (int r = 0; r < 16; ++r) ps += p1[r];
  { auto rr = __builtin_amdgcn_permlane32_swap(__float_as_uint(ps), __float_as_uint(ps), false, false);
    ps = __uint_as_float(rr[0]) + __uint_as_float(rr[1]); }
  l_reg = l_reg * alpha + ps;
#define PK4(P, BASE, OUT) do { u32x4 w = {cvt_pk_bf16(P[BASE + 0], P[BASE + 1]), cvt_pk_bf16(P[BASE + 2], P[BASE + 3]), cvt_pk_bf16(P[BASE + 4], P[BASE + 5]), cvt_pk_bf16(P[BASE + 6], P[BASE + 7])}; \
    OUT = *reinterpret_cast<bf16x8*>(&w); } while (0)
  PK4(p0, 0, pa0); PK4(p0, 8, pa1); PK4(p1, 0, pa2); PK4(p1, 8, pa3);
#undef PK4
}
__device__ __forceinline__ void qkt(f32x16& p0, f32x16& p1, const char* Ks, const bf16x8* qr, const f32x16& negm, int r32, int hi) {
  p0 = negm; p1 = negm;
#pragma unroll
  for (int d0 = 0; d0 < 6; ++d0) { int cb = (d0 * 16 + hi * 8) * 2;
    bf16x8 b0 = *reinterpret_cast<const bf16x8*>(Ks + KSWZ(r32, cb));
    bf16x8 b1 = *reinterpret_cast<const bf16x8*>(Ks + KSWZ(32 + r32, cb));
    p0 = __builtin_amdgcn_mfma_f32_32x32x16_bf16(b0, qr[d0], p0, 0, 0, 0);
    p1 = __builtin_amdgcn_mfma_f32_32x32x16_bf16(b1, qr[d0], p1, 0, 0, 0); }
}
__device__ __forceinline__ int v_st(int k, int c) { const int kk = k; return ((kk >> 3) * 4 + (c >> 5)) * 512 + ((kk & 7) * 32 + (c & 31)) * 2; }
__device__ __forceinline__ int v_rd_base(int lane) { return ((lane & 3) << 3) | (((lane >> 2) & 3) << 6) | (((lane >> 4) & 1) << 5) | (((lane >> 5) & 1) << 8); }
constexpr int v_rd_off(int d0, int ks, int half) { return d0 * 512 + ks * 4096 + half * 2048; }
typedef short v4i16_t __attribute__((ext_vector_type(4)));
typedef LAS const char* lds_cptr;
__device__ __forceinline__ s16x4 vtr(lds_cptr p) { return __builtin_bit_cast(s16x4, __builtin_amdgcn_ds_read_tr16_b64_v4i16((LAS v4i16_t*)p)); }
template <int D0> __device__ __forceinline__ void pv_one(f32x16& od, lds_cptr vp, bf16x8 pa0, bf16x8 pa1, bf16x8 pa2, bf16x8 pa3) {
  const s16x4 l0 = vtr(vp + v_rd_off(D0, 0, 0)), h0 = vtr(vp + v_rd_off(D0, 0, 1)), l1 = vtr(vp + v_rd_off(D0, 1, 0)), h1 = vtr(vp + v_rd_off(D0, 1, 1));
  const s16x4 l2 = vtr(vp + v_rd_off(D0, 2, 0)), h2 = vtr(vp + v_rd_off(D0, 2, 1)), l3 = vtr(vp + v_rd_off(D0, 3, 0)), h3 = vtr(vp + v_rd_off(D0, 3, 1));
#define PK(L, H) (bf16x8){L[0], L[1], L[2], L[3], H[0], H[1], H[2], H[3]}
  od = __builtin_amdgcn_mfma_f32_32x32x16_bf16(pa0, PK(l0, h0), od, 0, 0, 0);
  od = __builtin_amdgcn_mfma_f32_32x32x16_bf16(pa1, PK(l1, h1), od, 0, 0, 0);
  od = __builtin_amdgcn_mfma_f32_32x32x16_bf16(pa2, PK(l2, h2), od, 0, 0, 0);
  od = __builtin_amdgcn_mfma_f32_32x32x16_bf16(pa3, PK(l3, h3), od, 0, 0, 0);
#undef PK
}
__device__ __forceinline__ void pv_d0(f32x16* o, lds_cptr vp, bf16x8 pa0, bf16x8 pa1, bf16x8 pa2, bf16x8 pa3) {
  pv_one<0>(o[0], vp, pa0, pa1, pa2, pa3); pv_one<1>(o[1], vp, pa0, pa1, pa2, pa3);
}
__device__ __forceinline__ void attn_unit(const bf16_t* __restrict__ Qb, const bf16_t* __restrict__ KNh, const bf16_t* __restrict__ KRb, const bf16_t* __restrict__ Vh, bf16_t* __restrict__ Ob, char* lds) {
  const int tid = threadIdx.x, wid = tid >> 6, lane = tid & 63, r32 = lane & 31, hi = lane >> 5;
  char* V_lds = lds; char* K_lds = lds + 2 * SHM_V;
  float* ws = (float*)(lds + 2 * SHM_V + 2 * SHM_K) + wid * 64; float* li_l = ws; float* al_l = ws + 32;
  float mref = 0.f, l_reg = 0; f32x16 negm = {}; f32x16 o[2] = {}; bf16x8 qr[6];
  const bf16_t* Qw = Qb + (long)(wid * QBLK + r32) * 768 + hi * 8;
#pragma unroll
  for (int d0 = 0; d0 < 6; ++d0) qr[d0] = *reinterpret_cast<const bf16x8*>(Qw + d0 * 16);
  const int sr = tid >> 3, sc = (tid & 7) * 8, vst = v_st(sr, sc), kst = KSWZ(sr, sc * 2), krst = KSWZ(sr, 128 + (tid & 7) * 8);
  const lds_cptr vb0 = (lds_cptr)(LAS char*)lds + v_rd_base(lane);
  struct { bf16x8 vs, ks; s16x4 kr; } sr_[2];
  const unsigned lo_kv = (unsigned)(sr * 512 + sc), lo_kr = (unsigned)(sr * 32 + (tid & 7) * 4);
#define SLOAD(i, k0) do { const bf16_t* vt_ = Vh + (size_t)(k0) * 512; const bf16_t* kt_ = KNh + (size_t)(k0) * 512; const bf16_t* rt_ = KRb + (size_t)(k0) * 32; \
    sr_[i].vs = *reinterpret_cast<const bf16x8*>(vt_ + lo_kv); sr_[i].ks = *reinterpret_cast<const bf16x8*>(kt_ + lo_kv); sr_[i].kr = *reinterpret_cast<const s16x4*>(rt_ + lo_kr); } while (0)
#define SWRITE(b, i) do { *(bf16x8*)(V_lds + (b) * SHM_V + vst) = sr_[i].vs; *(bf16x8*)(K_lds + (b) * SHM_K + kst) = sr_[i].ks; *(s16x4*)(K_lds + (b) * SHM_K + krst) = sr_[i].kr; } while (0)
#define SWAIT() asm volatile("s_waitcnt vmcnt(3)" ::: "memory")
#define RESC(a) do { if (__any((a) < 1.f)) { if (hi == 0) al_l[r32] = (a); asm volatile("s_waitcnt lgkmcnt(0)" ::: "memory"); \
    _Pragma("unroll") for (int d = 0; d < 2; ++d) _Pragma("unroll") for (int r = 0; r < 16; ++r) o[d][r] *= al_l[crow(r, hi)]; } } while (0)
  f32x16 pA0, pA1, pB0, pB1; float alA, alB; bf16x8 pa0, pa1, pa2, pa3; constexpr int NT = SEQ / KVBLK;
  constexpr int SE = 0, SO = 1;
  SLOAD(SE, 0); asm volatile("s_waitcnt vmcnt(0)" ::: "memory"); SWRITE(0, SE); __syncthreads();
  qkt(pA0, pA1, K_lds, qr, negm, r32, hi); partialSM<true>(pA0, pA1, mref, negm, alA);
  SLOAD(SO, KVBLK); SLOAD(SE, 2 * KVBLK);
  SWAIT(); SWRITE(1, SO); __syncthreads();
  for (int j = 1; j + 1 < NT; j += 2) {
    SBAR(); qkt(pB0, pB1, K_lds + SHM_K, qr, negm, r32, hi);
    finishSM(pA0, pA1, alA, l_reg, pa0, pa1, pa2, pa3); SBAR();
    SLOAD(SO, (j + 2) * KVBLK); SBAR();
    pv_d0(o, vb0, pa0, pa1, pa2, pa3); partialSM<false>(pB0, pB1, mref, negm, alB);
    __syncthreads(); SWAIT(); SWRITE(0, SE);
    RESC(alB); __syncthreads();
    SBAR(); qkt(pA0, pA1, K_lds, qr, negm, r32, hi);
    finishSM(pB0, pB1, alB, l_reg, pa0, pa1, pa2, pa3); SBAR();
    if (j + 3 < NT) SLOAD(SE, (j + 3) * KVBLK); SBAR();
    pv_d0(o, vb0 + SHM_V, pa0, pa1, pa2, pa3); partialSM<false>(pA0, pA1, mref, negm, alA);
    __syncthreads(); SWAIT(); SWRITE(1, SO);
    RESC(alA); __syncthreads();
  }
  SBAR(); qkt(pB0, pB1, K_lds + SHM_K, qr, negm, r32, hi);
  finishSM(pA0, pA1, alA, l_reg, pa0, pa1, pa2, pa3); SBAR();
  pv_d0(o, vb0, pa0, pa1, pa2, pa3); partialSM<false>(pB0, pB1, mref, negm, alB);
  __syncthreads(); RESC(alB);
  finishSM(pB0, pB1, alB, l_reg, pa0, pa1, pa2, pa3); SBAR();
  pv_d0(o, vb0 + SHM_V, pa0, pa1, pa2, pa3);
  if (hi == 0) li_l[r32] = l_reg; asm volatile("s_waitcnt lgkmcnt(0)" ::: "memory");
  float rli[16];
#pragma unroll
  for (int r = 0; r < 16; ++r) rli[r] = __builtin_amdgcn_rcpf(li_l[crow(r, hi)]);
  bf16_t* Ow = Ob + (long)(wid * QBLK) * 512;
#pragma unroll
  for (int r = 0; r < 16; ++r) { int orow = crow(r, hi);
#pragma unroll
    for (int d0 = 0; d0 < 2; ++d0) Ow[(long)orow * 512 + d0 * 32 + r32] = (bf16_t)(cvt_pk_bf16(o[d0][r] * rli[r], 0.f) & 0xffffu); }
  __syncthreads();
#undef SLOAD
#undef SWRITE
#undef SWAIT
#undef RESC
}
#undef KSWZ
#undef SBAR
}

__device__ __forceinline__ void h2f(unsigned w, float& lo, float& hi) { const __half2 h = *(const __half2*)&w; const float2 f = __half22float2(h); lo = f.x; hi = f.y; }
__device__ __forceinline__ void scan_item(int b, int cgp, unsigned* AU, const bf16_t* LY, bf16_t* REC, float* sc) {
    const int tid = threadIdx.x, wid = tid >> 6, lane = tid & 63, c = cgp * 64 + lane;
    const unsigned r0 = (unsigned)b * SEQ + wid * 256;
    unsigned* au0 = AU + c; unsigned* au1 = AU + (size_t)T * 512 + c; const bf16_t* ly = LY + c; bf16_t* rec = REC + c;
#define SC_STEP(W, H) do { float la_, u_; h2f(W, la_, u_); H = __builtin_amdgcn_exp2f(la_) * H + u_; } while (0)
    { float hf = 0.f, hb = 0.f, slf = 0.f, slb = 0.f; unsigned fa[16], ba[16], fb[16], bb[16];
#pragma unroll
      for (int k = 0; k < 16; ++k) { fa[k] = au0[(r0 + k) * 512]; ba[k] = au1[(r0 + 255 - k) * 512]; }
#pragma unroll 1
      for (int blk = 0; blk < 16; blk += 2) {
#pragma unroll
          for (int k = 0; k < 16; ++k) { fb[k] = au0[(r0 + (blk + 1) * 16 + k) * 512]; bb[k] = au1[(r0 + 255 - ((blk + 1) * 16 + k)) * 512]; }
#pragma unroll
          for (int k = 0; k < 16; ++k) { float la, u; h2f(fa[k], la, u); hf = __builtin_amdgcn_exp2f(la) * hf + u; slf += la; h2f(ba[k], la, u); hb = __builtin_amdgcn_exp2f(la) * hb + u; slb += la; }
          if (blk + 2 < 16) {
#pragma unroll
              for (int k = 0; k < 16; ++k) { fa[k] = au0[(r0 + (blk + 2) * 16 + k) * 512]; ba[k] = au1[(r0 + 255 - ((blk + 2) * 16 + k)) * 512]; } }
#pragma unroll
          for (int k = 0; k < 16; ++k) { float la, u; h2f(fb[k], la, u); hf = __builtin_amdgcn_exp2f(la) * hf + u; slf += la; h2f(bb[k], la, u); hb = __builtin_amdgcn_exp2f(la) * hb + u; slb += la; }
      }
      sc[wid * 64 + lane] = __builtin_amdgcn_exp2f(slf); sc[1024 + wid * 64 + lane] = hf;
      sc[(8 + wid) * 64 + lane] = __builtin_amdgcn_exp2f(slb); sc[1024 + (8 + wid) * 64 + lane] = hb; }
    __syncthreads();
    float cin0 = 0.f, cin1 = 0.f;
    for (int k = 0; k < wid; ++k) cin0 = sc[k * 64 + lane] * cin0 + sc[1024 + k * 64 + lane];
    for (int k = 7; k > wid; --k) cin1 = sc[(8 + k) * 64 + lane] * cin1 + sc[1024 + (8 + k) * 64 + lane];
    { float h = cin0; unsigned wa[16], wb[16];
#pragma unroll
      for (int k = 0; k < 16; ++k) wa[k] = au0[(r0 + k) * 512];
#pragma unroll 1
      for (int blk = 0; blk < 16; blk += 2) {
#pragma unroll
          for (int k = 0; k < 16; ++k) wb[k] = au0[(r0 + (blk + 1) * 16 + k) * 512];
#pragma unroll
          for (int k = 0; k < 16; ++k) { SC_STEP(wa[k], h); rec[(r0 + blk * 16 + k) * 512] = (bf16_t)(cvt_pk_bf16(h, 0.f) & 0xffffu); }
          if (blk + 2 < 16) {
#pragma unroll
              for (int k = 0; k < 16; ++k) wa[k] = au0[(r0 + (blk + 2) * 16 + k) * 512]; }
#pragma unroll
          for (int k = 0; k < 16; ++k) { SC_STEP(wb[k], h); rec[(r0 + (blk + 1) * 16 + k) * 512] = (bf16_t)(cvt_pk_bf16(h, 0.f) & 0xffffu); }
      } }
    { float h = cin1; unsigned wa[16], wb[16]; bf16_t fa[16], fb[16], ya[16], yb[16];
#pragma unroll
      for (int k = 0; k < 16; ++k) { const unsigned row = r0 + 255 - k; wa[k] = au1[row * 512]; fa[k] = rec[row * 512]; ya[k] = ly[row * 512]; }
#pragma unroll 1
      for (int blk = 0; blk < 16; blk += 2) {
#pragma unroll
          for (int k = 0; k < 16; ++k) { const unsigned row = r0 + 255 - ((blk + 1) * 16 + k); wb[k] = au1[row * 512]; fb[k] = rec[row * 512]; yb[k] = ly[row * 512]; }
#pragma unroll
          for (int k = 0; k < 16; ++k) { const unsigned row = r0 + 255 - (blk * 16 + k); SC_STEP(wa[k], h);
              const float tot = (h + __uint_as_float((unsigned)fa[k] << 16)) * __uint_as_float((unsigned)ya[k] << 16); rec[row * 512] = (bf16_t)(cvt_pk_bf16(tot, 0.f) & 0xffffu); }
          if (blk + 2 < 16) {
#pragma unroll
              for (int k = 0; k < 16; ++k) { const unsigned row = r0 + 255 - ((blk + 2) * 16 + k); wa[k] = au1[row * 512]; fa[k] = rec[row * 512]; ya[k] = ly[row * 512]; } }
#pragma unroll
          for (int k = 0; k < 16; ++k) { const unsigned row = r0 + 255 - ((blk + 1) * 16 + k); SC_STEP(wb[k], h);
              const float tot = (h + __uint_as_float((unsigned)fb[k] << 16)) * __uint_as_float((unsigned)yb[k] << 16); rec[row * 512] = (bf16_t)(cvt_pk_bf16(tot, 0.f) & 0xffffu); }
      } }
#undef SC_STEP
    __syncthreads();
}

template <class F> __device__ __forceinline__ void xpose(bf16_t* Bt, int N, int K, F f, int gw, int NGW, int lane) {
    const int nN = N / 64, total = nN * (K / 8);
    for (int item = gw; item < total; item += NGW) { const int ng = item % nN, kc = item / nN, n = ng * 64 + lane, k0 = kc * 8;
        float v[8];
#pragma unroll
        for (int e = 0; e < 8; ++e) v[e] = f(n, k0 + e);
        u32x4 w; w.x = cvt_pk_bf16(v[0], v[1]); w.y = cvt_pk_bf16(v[2], v[3]); w.z = cvt_pk_bf16(v[4], v[5]); w.w = cvt_pk_bf16(v[6], v[7]);
        *(u32x4*)(Bt + (size_t)n * K + k0) = w; }
}


template <class F> __device__ __forceinline__ void xpose_one(bf16_t* Bt, int N, int K, F f, int item, int lane) {
    const int nN = N / 64, n = (item % nN) * 64 + lane, k0 = (item / nN) * 8;
    float v[8];
#pragma unroll
    for (int e = 0; e < 8; ++e) v[e] = f(n, k0 + e);
    u32x4 w; w.x = cvt_pk_bf16(v[0], v[1]); w.y = cvt_pk_bf16(v[2], v[3]); w.z = cvt_pk_bf16(v[4], v[5]); w.w = cvt_pk_bf16(v[6], v[7]);
    *(u32x4*)(Bt + (size_t)n * K + k0) = w;
}

#define XB_TMO      128
#define XB_XCNT(j)  (256  + 64 * (j))
#define XB_XSUB(j)  (1280 + 64 * (j))
#define XB_XGEN(j)  (2304 + 64 * (j))
#define XB_TOP      3328
#define XB_TOPGEN   3392
#define XCD_BAR_WORDS 3456
#define XB_SPIN_CAP (1u << 18)
__device__ __forceinline__ unsigned xb_ld(unsigned* p)              { return __hip_atomic_load(p, __ATOMIC_RELAXED, __HIP_MEMORY_SCOPE_AGENT); }
__device__ __forceinline__ unsigned xb_add(unsigned* p, unsigned v) { return __hip_atomic_fetch_add(p, v, __ATOMIC_RELAXED, __HIP_MEMORY_SCOPE_AGENT); }
__device__ __forceinline__ unsigned xb_xcc_id() { return (unsigned)__builtin_amdgcn_s_getreg((3 << 11) | 20) & 0xFu; }
#define XB_SPIN(cond, bar) do { unsigned _sp = 0; while (cond) { __builtin_amdgcn_s_sleep(1); \
    if ((++_sp & 255u) == 0u) { if (xb_ld(&(bar)[XB_TMO])) break; if (_sp > XB_SPIN_CAP) { atomicAdd(&(bar)[XB_TMO], 1u); break; } } } } while (0)
struct XcdBarrier { unsigned* bar; unsigned x; volatile LAS unsigned* st; };
__device__ __forceinline__ XcdBarrier xcd_barrier_post(unsigned* bar, volatile LAS unsigned* st) {
    XcdBarrier b; b.bar = bar; b.x = xb_xcc_id(); b.st = st;
    if (threadIdx.x == 0) (void)xb_add(&bar[XB_XCNT(b.x)], 1u);
    return b;
}
__device__ __forceinline__ void xcd_barrier_complete(unsigned* bar, unsigned x, unsigned& nloc, unsigned& nx) {
    const unsigned G = gridDim.x * gridDim.y * gridDim.z;
    unsigned sum, cnt, mine, sp = 0u;
    for (;;) {
        sum = 0u; cnt = 0u; mine = 0u;
#pragma unroll
        for (unsigned j = 0; j < 16; ++j) { const unsigned c = xb_ld(&bar[XB_XCNT(j)]); sum += c; cnt += (c > 0u) ? 1u : 0u; mine = (j == x) ? c : mine; }
        if (sum == G) break;
        __builtin_amdgcn_s_sleep(1);
        if ((++sp & 255u) == 0u) { if (xb_ld(&bar[XB_TMO])) break; if (sp > XB_SPIN_CAP) { atomicAdd(&bar[XB_TMO], 1u); break; } }
    }
    nloc = mine > 0u ? mine : 1u; nx = cnt > 0u ? cnt : 1u;
}
__device__ __forceinline__ void xcd_barrier(const XcdBarrier& b) {
    asm volatile("s_waitcnt vmcnt(0)" ::: "memory");
    __syncthreads();
    if (threadIdx.x == 0) {
        unsigned* bar = b.bar;
        __builtin_amdgcn_s_waitcnt(0);
        unsigned nloc = b.st[0], nx = b.st[1];
        if (nloc == 0u) { xcd_barrier_complete(bar, b.x, nloc, nx); b.st[0] = nloc; b.st[1] = nx; }
        const unsigned old = xb_add(&bar[XB_XSUB(b.x)], 1u);
        const unsigned gen = old / nloc;
        if (old + 1u == (gen + 1u) * nloc) {
            __builtin_amdgcn_fence(__ATOMIC_RELEASE, "agent");
            asm volatile("s_waitcnt vmcnt(0)" ::: "memory");
            const unsigned og = xb_add(&bar[XB_TOP], 1u);
            const unsigned tg = og / nx;
            if (og + 1u == (tg + 1u) * nx) xb_add(&bar[XB_TOPGEN], 1u);
            else XB_SPIN(xb_ld(&bar[XB_TOPGEN]) == tg, bar);
            __builtin_amdgcn_fence(__ATOMIC_ACQUIRE, "agent");
            xb_add(&bar[XB_XGEN(b.x)], 1u);
            asm volatile("s_waitcnt vmcnt(0)" ::: "memory");
        } else {
            XB_SPIN(xb_ld(&bar[XB_XGEN(b.x)]) == gen, bar);
            __builtin_amdgcn_fence(__ATOMIC_ACQUIRE, "agent");
            asm volatile("s_waitcnt vmcnt(0)" ::: "memory");
        }
    }
    __syncthreads();
}

constexpr size_t MiB = 1u << 20;
constexpr size_t WS_SS = 0;
constexpr size_t WS_ROPE = 1 * MiB;
constexpr size_t WS_SP8 = WS_ROPE + 256 * 1024;
constexpr size_t WS_BAR = 1 * MiB + 512 * 1024;
constexpr size_t WS_WIN = 2 * MiB;
constexpr size_t WS_WQB = 9 * MiB;
constexpr size_t WS_WKVB = WS_WQB + 512 * 1024;
constexpr size_t WS_WG = 10 * MiB;
constexpr size_t WS_WOA = 11 * MiB;
constexpr size_t WS_WOL = 12 * MiB;
constexpr size_t WS_WOUT = 13 * MiB;
constexpr size_t WS_WGU = 15 * MiB;
constexpr size_t WS_WD = 26 * MiB;
constexpr size_t WS_A = 40 * MiB;
constexpr size_t WS_GATES = 168 * MiB;
constexpr size_t WS_LY = 424 * MiB;
constexpr size_t WS_LX = 488 * MiB;
constexpr size_t WS_QA = 552 * MiB;
constexpr size_t WS_KVA = 584 * MiB;
constexpr size_t WS_KN = 616 * MiB;
constexpr size_t WS_V = 680 * MiB;
constexpr size_t WS_KR = 744 * MiB;
constexpr size_t WS_XC = 748 * MiB;
constexpr size_t WS_X1B = 616 * MiB;
constexpr size_t WS_HID = 168 * MiB;
constexpr size_t WS_END = 812 * MiB;

struct Args { const float* in[22]; float* out; unsigned char* ws; int ph_lo, ph_hi; };

__global__ void __launch_bounds__(512, 2) mega_fwd(Args args) {
    extern __shared__ __attribute__((aligned(16))) unsigned char lds_raw[];
    LAS unsigned char* lds = (LAS unsigned char*)lds_raw;
    const int tid = threadIdx.x;
#define PHASE_IDS const int lane = threadIdx.x & 63, wave = __builtin_amdgcn_readfirstlane(threadIdx.x >> 6), gw = bid * 8 + wave, NGW = G * 8, gtid = bid * 512 + (int)threadIdx.x, NTH = G * 512; (void)lane; (void)gw; (void)NGW; (void)gtid; (void)NTH
    const int G = gridDim.x, bid = blockIdx.x;
    unsigned char* ws = args.ws;
    float* SSQ = (float*)(ws + WS_SS); float* SSKV = SSQ + T; float* SS2 = SSKV + T; float* SS3 = SS2 + T;
    float* ROPE = (float*)(ws + WS_ROPE); float* SP8 = (float*)(ws + WS_SP8);
    bf16_t* WIN = (bf16_t*)(ws + WS_WIN); bf16_t* WQB = (bf16_t*)(ws + WS_WQB); bf16_t* WKVB = (bf16_t*)(ws + WS_WKVB); bf16_t* WG = (bf16_t*)(ws + WS_WG);
    bf16_t* WOA = (bf16_t*)(ws + WS_WOA); bf16_t* WOL = (bf16_t*)(ws + WS_WOL); bf16_t* WOUT = (bf16_t*)(ws + WS_WOUT); bf16_t* WGU = (bf16_t*)(ws + WS_WGU); bf16_t* WD = (bf16_t*)(ws + WS_WD);
    bf16_t* XN = (bf16_t*)(ws + WS_A); bf16_t* Qb = (bf16_t*)(ws + WS_A); bf16_t* MERGED = (bf16_t*)(ws + WS_A);
    bf16_t* GATES = (bf16_t*)(ws + WS_GATES); bf16_t* LY = (bf16_t*)(ws + WS_LY); bf16_t* LX = (bf16_t*)(ws + WS_LX); bf16_t* ATT = (bf16_t*)(ws + WS_LX);
    bf16_t* QA = (bf16_t*)(ws + WS_QA); bf16_t* KVA = (bf16_t*)(ws + WS_KVA); bf16_t* REC = (bf16_t*)(ws + WS_QA);
    bf16_t* KN = (bf16_t*)(ws + WS_KN); bf16_t* Vb = (bf16_t*)(ws + WS_V); bf16_t* KR = (bf16_t*)(ws + WS_KR); bf16_t* XC = (bf16_t*)(ws + WS_XC);
    bf16_t* X1B = (bf16_t*)(ws + WS_X1B); bf16_t* HID = (bf16_t*)(ws + WS_HID);
    unsigned* AU = (unsigned*)args.out;
    const int lo = args.ph_lo, hi = args.ph_hi;
    volatile LAS unsigned* xst = (volatile LAS unsigned*)(lds + 140032);
    if (tid < 2) xst[tid] = 0u;
    __syncthreads();
    XcdBarrier xbar; xbar.bar = (unsigned*)(ws + WS_BAR); xbar.x = 0; xbar.st = xst;
    if (hi - lo > 1) xbar = xcd_barrier_post((unsigned*)(ws + WS_BAR), xst);
#define IN(k) (((PHASE_MASK >> (k)) & 1) && lo <= (k) && (k) < hi)
#if PROBE_MASK
    unsigned long long pr_acc = 0, pr_t0 = __builtin_amdgcn_s_memrealtime();
#define SEAM(k) do { if (IN(k) && IN((k) + 1)) { if ((k) == 0) cg::this_grid().sync(); else xcd_barrier(xbar); } { const unsigned long long t1_ = __builtin_amdgcn_s_memrealtime(); if ((PROBE_MASK >> (k)) & 1) pr_acc += t1_ - pr_t0; pr_t0 = t1_; } } while (0)
#else
#define SEAM(k) do { if (IN(k) && IN((k) + 1)) { if ((k) == 0) cg::this_grid().sync(); else xcd_barrier(xbar); } } while (0)
#endif

    if (IN(0)) { PHASE_IDS;
        for (int i = gtid; i < 4 * T; i += NTH) SSQ[i] = 0.f;
        for (int i = gtid; i < SEQ * 16; i += NTH) { const int pos = i >> 4, fi = i & 15; const float inv = 1.0f / powf(10000.0f, (float)fi * (1.0f / 16.0f)); const float ang = (float)pos * inv;
            float s, c; sincosf(ang, &s, &c); ROPE[pos * 32 + fi] = c; ROPE[pos * 32 + 16 + fi] = s; }
        for (int i = gtid; i < 1024; i += NTH) { const float lam = args.in[14][i]; SP8[i] = 8.0f * log1pf(expf(-lam)); }
        {
          const float* w_in = args.in[2]; const float* w_qb = args.in[4]; const float* g_q = args.in[3]; const float* w_kvb = args.in[6]; const float* g_kv = args.in[5];
          const float* wr_ = args.in[10]; const float* wi_ = args.in[12]; const float* w_oa = args.in[7]; const float* w_ol = args.in[15]; const float* w_o = args.in[16];
          const float* wg_ = args.in[18]; const float* wu_ = args.in[19]; const float* g2 = args.in[17]; const float* w_d = args.in[20];
          constexpr int I0 = (DIN_PAD / 64) * (1024 / 8), I1 = (768 / 64) * (256 / 8), I2 = (1024 / 64) * (128 / 8), I3 = (2048 / 64) * (128 / 8), I4 = (1024 / 64) * (512 / 8), I5 = I4,
                        I6 = (1024 / 64) * (1024 / 8), I7 = (2 * DFF / 64) * (1024 / 8), I8 = (1024 / 64) * (DFF / 8), ITOT = I0 + I1 + I2 + I3 + I4 + I5 + I6 + I7 + I8;
          auto do_item = [&](int gi) { int r = gi;
              if (r < I0) { xpose_one(WIN, DIN_PAD, 1024, [=](int n, int k) -> float { int src;
                  if (n < 384) src = n; else if (n < 416) { const int j = n - 384; src = 384 + (j & 1) * 16 + (j >> 1); } else if (n < 512) src = -1;
                  else if (n < 1024) src = 416 + (n - 512); else if (n < 1536) src = 928 + (n - 1024); else src = 1440 + (n - 1536);
                  return src < 0 ? 0.f : w_in[(size_t)k * DIN_SRC + src]; }, r, lane); return; } r -= I0;
              if (r < I1) { xpose_one(WQB, 768, 256, [=](int n, int k) -> float { const int h = n / 96, dp = n % 96; int d = dp; if (dp >= 64) { const int j = dp - 64; d = 64 + (j & 1) * 16 + (j >> 1); }
                  return w_qb[(size_t)k * 768 + h * 96 + d] * g_q[k]; }, r, lane); return; } r -= I1;
              if (r < I2) { xpose_one(WKVB, 1024, 128, [=](int n, int k) -> float { const int nn = n & 511, h = nn >> 6, d = nn & 63; return w_kvb[(size_t)k * 1024 + h * 128 + (n >> 9) * 64 + d] * g_kv[k]; }, r, lane); return; } r -= I2;
              if (r < I3) { xpose_one(WG, 2048, 128, [=](int n, int k) -> float { const int g = n >> 8, bj = (n >> 7) & 1, j = n & 127, blk = g >> 1, dir = g & 1;
                  return (bj ? wi_ : wr_)[((size_t)(dir * 4 + blk) * 128 + k) * 128 + j]; }, r, lane); return; } r -= I3;
              if (r < I4) { xpose_one(WOA, 1024, 512, [=](int n, int k) -> float { return w_oa[(size_t)k * 1024 + n]; }, r, lane); return; } r -= I4;
              if (r < I5) { xpose_one(WOL, 1024, 512, [=](int n, int k) -> float { return w_ol[(size_t)k * 1024 + n]; }, r, lane); return; } r -= I5;
              if (r < I6) { xpose_one(WOUT, 1024, 1024, [=](int n, int k) -> float { return w_o[(size_t)k * 1024 + n]; }, r, lane); return; } r -= I6;
              if (r < I7) { xpose_one(WGU, 2 * DFF, 1024, [=](int n, int k) -> float { const int pn = n >> 8, bj = (n >> 7) & 1, j = n & 127; return (bj ? wu_ : wg_)[(size_t)k * DFF + pn * 128 + j] * g2[k]; }, r, lane); return; } r -= I7;
              xpose_one(WD, 1024, DFF, [=](int n, int k) -> float { return w_d[(size_t)k * 1024 + n]; }, r, lane); };
          const float* x = args.in[0]; const float* g1 = args.in[1];
          f32x4 gv[4];
#pragma unroll
          for (int j = 0; j < 4; ++j) gv[j] = *((const f32x4*)g1 + lane + 64 * j);
          int gi = gw;
          for (int m = gw; m < T; m += 2 * NGW) { const int m2 = m + NGW; const bool two = m2 < T; const int mb = two ? m2 : m;
              const f32x4* xr = (const f32x4*)(x + (size_t)m * DM) + lane; const f32x4* xr2 = (const f32x4*)(x + (size_t)mb * DM) + lane; f32x4 v[4], v2[4]; float s = 0.f, s2 = 0.f;
#pragma unroll
              for (int j = 0; j < 4; ++j) { v[j] = __builtin_nontemporal_load(xr + 64 * j); v2[j] = __builtin_nontemporal_load(xr2 + 64 * j); }
              if (gi < ITOT) { do_item(gi); gi += NGW; }
#pragma unroll
              for (int j = 0; j < 4; ++j) { s += (v[j].x * v[j].x + v[j].y * v[j].y) + (v[j].z * v[j].z + v[j].w * v[j].w); s2 += (v2[j].x * v2[j].x + v2[j].y * v2[j].y) + (v2[j].z * v2[j].z + v2[j].w * v2[j].w); }
              const float rstd = rsqrtf(wave_sum(s) * (1.0f / DM) + EPS), rstd2 = rsqrtf(wave_sum(s2) * (1.0f / DM) + EPS);
              u32x2* o8 = (u32x2*)(XN + (size_t)m * DM) + lane; u32x2* o82 = (u32x2*)(XN + (size_t)mb * DM) + lane;
#pragma unroll
              for (int j = 0; j < 4; ++j) { const f32x4 y = v[j] * rstd * gv[j]; u32x2 w2; w2.x = cvt_pk_bf16(y.x, y.y); w2.y = cvt_pk_bf16(y.z, y.w); o8[64 * j] = w2; }
              if (two) {
#pragma unroll
                  for (int j = 0; j < 4; ++j) { const f32x4 y = v2[j] * rstd2 * gv[j]; u32x2 w2; w2.x = cvt_pk_bf16(y.x, y.y); w2.y = cvt_pk_bf16(y.z, y.w); o82[64 * j] = w2; } } }
          for (; gi < ITOT; gi += NGW) do_item(gi);
        }
    }
    SEAM(0);
    if (IN(1)) {
        pg8::Gemm g{XN, XN, WIN, WIN, 1024, 1024, 1024, 0, 0}; pg8::StaticOrder S; S.init(T, DIN_PAD, G, bid);
        EpiProj E{QA, KVA, KR, LX, LY, GATES, SSQ, SSKV, ROPE};
        pg8::gemm_phase<EpiProj, pg8::StaticOrder, true>(lds, g, S, E);
    }
    SEAM(1);
    if (IN(2)) { PHASE_IDS;
        if (P2SUB & 1) { const float* cw = args.in[8]; const float* cb = args.in[9]; const int c8 = (gtid & 63) * 8;
          float w[4][8], bias[8];
#pragma unroll
          for (int e = 0; e < 8; ++e) { bias[e] = cb[c8 + e];
#pragma unroll
              for (int j = 0; j < 4; ++j) w[j][e] = cw[j * 512 + c8 + e]; }
          const int rstride = NTH >> 6;
          for (int row = gtid >> 6; row < T; row += 2 * rstride) { const int rowb = (row + rstride < T) ? row + rstride : row;
              u32x4 xa[4], xb[4];
#pragma unroll
              for (int j = 0; j < 4; ++j) { const int ta = (row & (SEQ - 1)) - 2 + j, tb = (rowb & (SEQ - 1)) - 2 + j;
                  xa[j] = (ta >= 0 && ta < SEQ) ? *(const u32x4*)(LX + (size_t)(row - 2 + j) * 512 + c8) : (u32x4){0u, 0u, 0u, 0u};
                  xb[j] = (tb >= 0 && tb < SEQ) ? *(const u32x4*)(LX + (size_t)(rowb - 2 + j) * 512 + c8) : (u32x4){0u, 0u, 0u, 0u}; }
              float a[8], bq[8];
#pragma unroll
              for (int e = 0; e < 8; ++e) { a[e] = bias[e]; bq[e] = bias[e]; }
#pragma unroll
              for (int j = 0; j < 4; ++j) { f32x4 x0, x1, y0, y1; unpack8(xa[j], x0, x1); unpack8(xb[j], y0, y1);
#pragma unroll
                  for (int e = 0; e < 4; ++e) { a[e] += w[j][e] * x0[e]; a[4 + e] += w[j][4 + e] * x1[e]; bq[e] += w[j][e] * y0[e]; bq[4 + e] += w[j][4 + e] * y1[e]; } }
              u32x4 o; o.x = cvt_pk_bf16(a[0], a[1]); o.y = cvt_pk_bf16(a[2], a[3]); o.z = cvt_pk_bf16(a[4], a[5]); o.w = cvt_pk_bf16(a[6], a[7]);
              *(u32x4*)(XC + (size_t)row * 512 + c8) = o;
              if (rowb != row) { u32x4 o2; o2.x = cvt_pk_bf16(bq[0], bq[1]); o2.y = cvt_pk_bf16(bq[2], bq[3]); o2.z = cvt_pk_bf16(bq[4], bq[5]); o2.w = cvt_pk_bf16(bq[6], bq[7]);
                  *(u32x4*)(XC + (size_t)rowb * 512 + c8) = o2; } } }
        if (P2SUB & 2) { pg8::Gemm g{QA, QA, WQB, WQB, 256, 256, 256, 0, 0}; pg8::StaticOrder S; S.init(T, 768, G, bid); EpiQ E{Qb, SSQ, ROPE};
          pg8::gemm_phase<EpiQ, pg8::StaticOrder, true>(lds, g, S, E); }
        if (P2SUB & 4) { pg8::Gemm g{KVA, KVA, WKVB, WKVB, 128, 128, 128, 0, 0}; pg8::StaticOrder S; S.init(T, 1024, G, bid); EpiKV E{KN, Vb, SSKV};
          pg8::gemm_phase<EpiKV, pg8::StaticOrder, true>(lds, g, S, E); }
    }
    SEAM(2);
    if (IN(3)) {
        pg8::Gemm g{XC, XC, WG, WG, 512, 128, 128, 1, 128}; pg8::StaticOrder S; S.init(T, 2048, G, bid);
        EpiGates E{XC, AU, args.in[11], args.in[13], SP8};
        pg8::gemm_phase<EpiGates, pg8::StaticOrder, true>(lds, g, S, E);
    }
    SEAM(3);
    if (IN(4)) {
        __syncthreads();
        for (int it = bid; it < NBATCH * 8; it += G) scan_item(it >> 3, it & 7, AU, LY, REC, (float*)lds_raw);
        const int vcu = (G % 8 == 0) ? (bid % 8) * (G / 8) + bid / 8 : bid;
        for (int un = vcu; un < NBATCH * 8 * 8; un += G) { const int bh = un >> 3, qb = un & 7, b = bh >> 3, h = bh & 7; const size_t rb = (size_t)b * SEQ;
            att::attn_unit(Qb + (rb + qb * 256) * 768 + h * 96, KN + rb * 512 + h * 64, KR + rb * 32, Vb + rb * 512 + h * 64, ATT + (rb + qb * 256) * 512 + h * 64, (char*)lds_raw); }
    }
    SEAM(4);
    if (IN(5)) {
        pg8::Gemm g{ATT, REC, WOA, WOL, 512, 512, 512, 0, 0}; pg8::DualOrder S; S.S.init(T, 1024, G, bid);
        EpiMerge E{GATES, MERGED};
        pg8::gemm_phase<EpiMerge, pg8::DualOrder, true>(lds, g, S, E);
    }
    SEAM(5);
    if (IN(6)) {
        pg8::Gemm g{MERGED, MERGED, WOUT, WOUT, 1024, 1024, 1024, 0, 0}; pg8::StaticOrder S; S.init(T, 1024, G, bid);
        EpiOut E{args.in[0], X1B, SS2};
        pg8::gemm_phase<EpiOut, pg8::StaticOrder, true>(lds, g, S, E);
    }
    SEAM(6);
    if (IN(7)) {
        pg8::Gemm g{X1B, X1B, WGU, WGU, 1024, 1024, 1024, 0, 0}; pg8::StaticOrder S; S.init(T, 2 * DFF, G, bid);
        EpiFfn E{HID, SS2};
        pg8::gemm_phase<EpiFfn, pg8::StaticOrder, true>(lds, g, S, E);
    }
    SEAM(7);
    if (IN(8)) {
        pg8::Gemm g{HID, HID, WD, WD, DFF, DFF, DFF, 0, 0}; pg8::StaticOrder S; S.init(T, 1024, G, bid);
        EpiDown E{X1B, SS3};
        pg8::gemm_phase<EpiDown, pg8::StaticOrder, true>(lds, g, S, E);
    }
    SEAM(8);
    if (IN(9)) { PHASE_IDS;
        const float* gf = args.in[21]; f32x4 gv[4];
#pragma unroll
        for (int j = 0; j < 4; ++j) gv[j] = *((const f32x4*)gf + lane + 64 * j);
        for (int m = gw; m < T; m += NGW) { f32x4* xr = (f32x4*)(args.out + (size_t)m * DM) + lane; const u32x2* br_ = (const u32x2*)(X1B + (size_t)m * DM) + lane; const float rstd = rsqrtf(SS3[m] * (1.0f / DM) + EPS);
            u32x2 w2[4];
#pragma unroll
            for (int j = 0; j < 4; ++j) w2[j] = __builtin_nontemporal_load(br_ + 64 * j);
#pragma unroll
            for (int j = 0; j < 4; ++j) { const f32x4 v = (f32x4){bf_lo(w2[j].x), bf_hi(w2[j].x), bf_lo(w2[j].y), bf_hi(w2[j].y)}; __builtin_nontemporal_store(v * rstd * gv[j], xr + 64 * j); } }
    }
#if PROBE_MASK
    SEAM(9);
    if (bid == 0 && tid == 0) { const unsigned long long t0_ = __builtin_amdgcn_s_memrealtime(); while (__builtin_amdgcn_s_memrealtime() - t0_ < pr_acc) __builtin_amdgcn_s_sleep(8); }
#endif
#undef IN
#undef SEAM
}

constexpr int LDS_BYTES = 147456;
constexpr int N_PHASES = 10;
extern "C" void kernel_launch(void* const* d_in, const int* in_sizes, int n_in, void* d_out, int out_size, void* d_ws, size_t ws_size, hipStream_t stream) {
    static int grid = 0;
    if (grid == 0) {
        if (n_in != 22 || out_size != T * DM || ws_size < WS_END) { fprintf(stderr, "kernel_launch: unexpected shapes n_in %d out %d ws %zu\n", n_in, out_size, ws_size); grid = -1; return; }
        int dev = 0, cus = 0, per_cu = 0;
        hipGetDevice(&dev); hipDeviceGetAttribute(&cus, hipDeviceAttributeMultiprocessorCount, dev);
        if (hipFuncSetAttribute((const void*)mega_fwd, hipFuncAttributeMaxDynamicSharedMemorySize, LDS_BYTES) != hipSuccess) { fprintf(stderr, "kernel_launch: hipFuncSetAttribute failed\n"); grid = -1; return; }
        if (hipOccupancyMaxActiveBlocksPerMultiprocessor(&per_cu, (const void*)mega_fwd, 512, LDS_BYTES) != hipSuccess || per_cu < 1) { fprintf(stderr, "kernel_launch: occupancy query gives %d\n", per_cu); per_cu = 1; }
        (void)hipGetLastError();
        grid = cus * (per_cu > 1 ? 1 : per_cu);
        if (grid > 256) grid = 256;
    }
    if (grid < 0) return;
    Args a{};
    for (int i = 0; i < 22; ++i) a.in[i] = (const float*)d_in[i];
    a.out = (float*)d_out; a.ws = (unsigned char*)d_ws;
#if MK_SINGLE
    if (hipMemsetAsync((char*)d_ws + WS_BAR, 0, 16384, stream) != hipSuccess) { fprintf(stderr, "kernel_launch: memset failed\n"); return; }
    a.ph_lo = 0; a.ph_hi = N_PHASES;
    void* kargs[] = {&a};
    hipError_t e = hipLaunchCooperativeKernel((const void*)mega_fwd, dim3(grid), dim3(512), kargs, LDS_BYTES, stream);
    if (e != hipSuccess) fprintf(stderr, "cooperative launch failed: %s (grid %d)\n", hipGetErrorString(e), grid);
#else
    for (int p = 0; p < N_PHASES; ++p) { a.ph_lo = p; a.ph_hi = p + 1; hipLaunchKernelGGL(mega_fwd, dim3(grid), dim3(512), LDS_BYTES, stream, a); }
#endif
}
```

```cpp
#include <hip/hip_runtime.h>
#include <hip/hip_cooperative_groups.h>
#include <hip/hip_bf16.h>
#include <hip/hip_fp16.h>
#include <cstdio>
#include <cstdint>
namespace cg = cooperative_groups;

#ifndef PHASE_MASK
#define PHASE_MASK 0x3ff
#endif
#ifndef P2SUB
#define P2SUB 7
#endif
#ifndef PROBE_MASK
#define PROBE_MASK 0
#endif
#ifndef MK_SINGLE
#define MK_SINGLE 1
#endif

constexpr int T = 65536, DM = 1024, SEQ = 2048, NBATCH = 32;
constexpr int DIN_SRC = 3488, DIN_PAD = 3584, DFF = 2816;
constexpr float EPS = 1e-6f;
constexpr float LOG2E = 1.4426950408889634f;

typedef unsigned short bf16_t;
typedef short bf16x8 __attribute__((ext_vector_type(8)));
typedef short s16x4 __attribute__((ext_vector_type(4)));
typedef float f32x4 __attribute__((ext_vector_type(4)));
typedef float f32x2 __attribute__((ext_vector_type(2)));
typedef float f32x16 __attribute__((ext_vector_type(16)));
typedef unsigned u32x4 __attribute__((ext_vector_type(4)));
typedef unsigned u32x2 __attribute__((ext_vector_type(2)));
#define LAS __attribute__((address_space(3)))

__device__ __forceinline__ unsigned cvt_pk_bf16(float lo, float hi) { unsigned r; asm volatile("v_cvt_pk_bf16_f32 %0, %1, %2" : "=v"(r) : "v"(lo), "v"(hi)); return r; }
__device__ __forceinline__ float bf_lo(unsigned w) { return __uint_as_float(w << 16); }
__device__ __forceinline__ float bf_hi(unsigned w) { return __uint_as_float(w & 0xffff0000u); }
__device__ __forceinline__ float fsigmoid(float x) { return __builtin_amdgcn_rcpf(1.0f + __builtin_amdgcn_exp2f(-x * LOG2E)); }
__device__ __forceinline__ u32x4 pack8(f32x4 a, f32x4 b) { u32x4 w; w.x = cvt_pk_bf16(a[0], a[1]); w.y = cvt_pk_bf16(a[2], a[3]); w.z = cvt_pk_bf16(b[0], b[1]); w.w = cvt_pk_bf16(b[2], b[3]); return w; }
__device__ __forceinline__ void unpack8(u32x4 w, f32x4& a, f32x4& b) { a = (f32x4){bf_lo(w.x), bf_hi(w.x), bf_lo(w.y), bf_hi(w.y)}; b = (f32x4){bf_lo(w.z), bf_hi(w.z), bf_lo(w.w), bf_hi(w.w)}; }
__device__ __forceinline__ float wave_sum(float v) {
#pragma unroll
    for (int o = 1; o < 64; o <<= 1) v += __shfl_xor(v, o);
    return v;
}

namespace pg8 {
constexpr int BM = 256, BK = 64, HALF = 128, HTB = HALF * BK * 2, STAGE_BYTES = 8 * HTB, NXCD = 8, WGM = 8;
__host__ __device__ __forceinline__ int lds_byte(int r, int c) { const int st = (r >> 4) * 2 + (c >> 5), rr = r & 15, cc = c & 31, ob = rr * 64 + cc * 2; return st * 1024 + (ob ^ (((ob >> 9) & 1) << 5)); }
__host__ __device__ __forceinline__ void stage_rc(int b, int& R, int& C) { const int st = b / 1024, sb = b % 1024, swz = sb ^ (((sb >> 9) & 1) << 5); R = (st >> 1) * 16 + swz / 64; C = (st & 1) * 32 + (swz % 64) / 2; }
__host__ __device__ __forceinline__ int perm32(int rho) { const int n = rho >> 4, i = rho & 15; return 8 * (i >> 2) + 4 * n + (i & 3); }

struct Unit { int pm, pn, sel; };
struct Gemm {
    const bf16_t *A0, *A1, *B0, *B1; int lda, ldb, K; int a_grp_shift, a_grp_cols;
    __device__ __forceinline__ const char* a_ptr(const Unit& u) const { return (const char*)(u.sel ? A1 : A0) + ((size_t)u.pm * BM * lda + (size_t)(u.pn >> a_grp_shift) * a_grp_cols) * 2; }
    __device__ __forceinline__ const char* b_ptr(const Unit& u) const { return (const char*)(u.sel ? B1 : B0) + (size_t)u.pn * BM * ldb * 2; }
};

struct StaticOrder {
    int nM, nN, nwg, G, c;
    __device__ void init(int M, int N, int G_, int c_) { nM = M / BM; nN = N / BM; nwg = nM * nN; G = G_; c = c_; }
    __device__ bool next(int i, Unit& u) const {
        const long L = (long)i * G + c; if (L >= nwg) return false;
        int wgid = (int)L; { const int q = nwg / NXCD, r = nwg % NXCD, xcd = wgid % NXCD, off = wgid / NXCD; wgid = (xcd < r ? xcd * (q + 1) : r * (q + 1) + (xcd - r) * q) + off; }
        const int nig = WGM * nN, gid = wgid / nig, fm = gid * WGM, gsz = (nM - fm) < WGM ? (nM - fm) : WGM;
        u.pm = fm + ((wgid % nig) % gsz); u.pn = (wgid % nig) / gsz; u.sel = 0; return true;
    }
};
struct DualOrder {
    StaticOrder S;
    __device__ bool next(int i, Unit& u) const { if (!S.next(i >> 1, u)) return false; u.sel = i & 1; return true; }
};

template <class Epi, class Sched, bool ALIGN_EPI>
__device__ __forceinline__ void gemm_phase(LAS unsigned char* lds, const Gemm g, const Sched& S, const Epi& E) {
    int tid = threadIdx.x; asm volatile("" : "+v"(tid) :: "memory");
    const int wid = __builtin_amdgcn_readfirstlane(tid >> 6), lane = tid & 63, wr = wid >> 2, wc = wid & 3, fr = lane & 15, fq = lane >> 4;
    int lda_ = g.lda, ldb_ = g.ldb, K = g.K; asm volatile("" : "+s"(lda_), "+s"(ldb_), "+s"(K) :: "memory");
    const int nt = K / BK;
    unsigned voffA[2], voffB[2];
#pragma unroll
    for (int i = 0; i < 2; ++i) { int R, C; stage_rc(tid * 16 + i * 8192, R, C); const int Rb = Epi::PERM ? ((R & ~31) + perm32(R & 31)) : R;
        voffA[i] = (unsigned)(R * lda_ + C) * 2u; voffB[i] = (unsigned)(Rb * ldb_ + C) * 2u; }
    const size_t kstep = (size_t)(BK * 2);
    const size_t hstepA = (size_t)HALF * lda_ * 2, hstepB = (size_t)HALF * ldb_ * 2;
    const unsigned ldsw = (unsigned)wid * 1024u;
    const int aoff = lds_byte(wr * 64 + fr, fq * 8), boff = lds_byte(wc * 32 + fr, fq * 8);
#define PG8_SA(b, h) (((b) * 2 + (h)) * HTB)
#define PG8_SB(b, h) ((4 + (b) * 2 + (h)) * HTB)
#define PG8_STAGE(bufoff, gbase, voff) do { _Pragma("unroll") for (int _i = 0; _i < 2; ++_i) \
        __builtin_amdgcn_global_load_lds((const unsigned*)((const char*)(gbase) + (voff)[_i]), (LAS unsigned*)(lds + (bufoff) + ldsw + _i * 8192), 16, 0, 0); } while (0)
#define PG8_LDA(dst, b, h) do { _Pragma("unroll") for (int m = 0; m < 4; ++m) _Pragma("unroll") for (int k = 0; k < 2; ++k) dst[m][k] = *(const LAS bf16x8*)(lds + PG8_SA(b, h) + aoff + m * 2048 + k * 1024); } while (0)
#define PG8_LDB(dst, b, h) do { _Pragma("unroll") for (int n = 0; n < 2; ++n) _Pragma("unroll") for (int k = 0; k < 2; ++k) dst[n][k] = *(const LAS bf16x8*)(lds + PG8_SB(b, h) + boff + n * 2048 + k * 1024); } while (0)
#define PG8_MMA(ai, bj, At, Bt) do { __builtin_amdgcn_s_setprio(1); _Pragma("unroll") for (int m = 0; m < 4; ++m) _Pragma("unroll") for (int n = 0; n < 2; ++n) _Pragma("unroll") for (int k = 0; k < 2; ++k) \
        acc[ai][bj][m][n] = __builtin_amdgcn_mfma_f32_16x16x32_bf16(Bt[n][k], At[m][k], acc[ai][bj][m][n], 0, 0, 0); __builtin_amdgcn_s_setprio(0); } while (0)
#define PG8_WAIT_V(n) asm volatile("s_waitcnt vmcnt(" #n ")" ::: "memory")
#define PG8_WAIT_L(n) asm volatile("s_waitcnt lgkmcnt(" #n ")" ::: "memory")
#define PG8_BAR __builtin_amdgcn_s_barrier()
#define PG8_SCHED __builtin_amdgcn_sched_barrier(0)
    Unit cur, nxt; int ui = 0;
    if (!S.next(0, cur)) return;
    f32x4 acc[2][2][4][2];
#pragma unroll
    for (int a = 0; a < 2; ++a)
#pragma unroll
        for (int b = 0; b < 2; ++b)
#pragma unroll
            for (int m = 0; m < 4; ++m)
#pragma unroll
                for (int n = 0; n < 2; ++n) acc[a][b][m][n] = (f32x4){0.f, 0.f, 0.f, 0.f};
    bf16x8 At[4][2], B0[2][2], B1[2][2];
    const char* cA = g.a_ptr(cur); const char* cB = g.b_ptr(cur);
    PG8_STAGE(PG8_SB(0, 0), cB, voffB); PG8_STAGE(PG8_SB(0, 1), cB + hstepB, voffB); PG8_STAGE(PG8_SA(0, 0), cA, voffA); PG8_STAGE(PG8_SA(0, 1), cA + hstepA, voffA);
    if (wr == 1) PG8_BAR;
    PG8_WAIT_V(2); PG8_BAR;
    PG8_STAGE(PG8_SB(1, 0), cB + kstep, voffB); PG8_STAGE(PG8_SA(1, 0), cA + kstep, voffA); PG8_STAGE(PG8_SB(1, 1), cB + hstepB + kstep, voffB);
    PG8_WAIT_V(6); PG8_BAR;
    for (;;) {
        const bool has_next = S.next(ui + 1, nxt);
        const char* nA = has_next ? g.a_ptr(nxt) : cA; const char* nB = has_next ? g.b_ptr(nxt) : cB;
        for (int t = 0; t < nt; t += 2) {
            const bool last = (t == nt - 2);
            const char* a1 = cA + (size_t)(t + 1) * kstep;
            const char* a2 = last ? nA : cA + (size_t)(t + 2) * kstep; const char* b2 = last ? nB : cB + (size_t)(t + 2) * kstep;
            const char* a3 = a2 + kstep; const char* b3 = b2 + kstep;
            PG8_LDB(B0, 0, 0); PG8_LDB(B1, 0, 1); PG8_SCHED; PG8_LDA(At, 0, 0); PG8_STAGE(PG8_SA(1, 1), a1 + hstepA, voffA);
            PG8_WAIT_V(8); PG8_WAIT_L(0); PG8_BAR; PG8_MMA(0, 0, At, B0); PG8_MMA(0, 1, At, B1); PG8_BAR; PG8_SCHED;
            PG8_LDA(At, 0, 1); PG8_STAGE(PG8_SB(0, 0), b2, voffB); PG8_STAGE(PG8_SB(0, 1), b2 + hstepB, voffB); PG8_STAGE(PG8_SA(0, 0), a2, voffA);
            PG8_WAIT_V(8); PG8_WAIT_L(0); PG8_BAR; PG8_MMA(1, 0, At, B0); PG8_MMA(1, 1, At, B1); PG8_BAR; PG8_SCHED;
            PG8_LDB(B0, 1, 0); PG8_LDB(B1, 1, 1); PG8_SCHED; PG8_LDA(At, 1, 0); PG8_STAGE(PG8_SA(0, 1), a2 + hstepA, voffA);
            PG8_WAIT_V(8); PG8_WAIT_L(0); PG8_BAR; PG8_MMA(0, 0, At, B0); PG8_MMA(0, 1, At, B1); PG8_BAR; PG8_SCHED;
            PG8_LDA(At, 1, 1); PG8_STAGE(PG8_SB(1, 0), b3, voffB); PG8_STAGE(PG8_SB(1, 1), b3 + hstepB, voffB); PG8_STAGE(PG8_SA(1, 0), a3, voffA);
            PG8_WAIT_V(8); PG8_WAIT_L(0); PG8_BAR; PG8_MMA(1, 0, At, B0); PG8_MMA(1, 1, At, B1); PG8_BAR; PG8_SCHED;
        }
        if constexpr (ALIGN_EPI) { if (wr == 0) PG8_BAR; }
        PG8_SCHED; E(acc, cur, wr, wc, fr, fq); PG8_SCHED;
        if (!has_next) break;
        bool keep_ = false; if constexpr (Epi::DUAL) keep_ = (cur.sel == 0);
        if (!keep_)
#pragma unroll
        for (int a = 0; a < 2; ++a)
#pragma unroll
            for (int b = 0; b < 2; ++b)
#pragma unroll
                for (int m = 0; m < 4; ++m)
#pragma unroll
                    for (int n = 0; n < 2; ++n) acc[a][b][m][n] = (f32x4){0.f, 0.f, 0.f, 0.f};
        cur = nxt; cA = nA; cB = nB; ++ui;
        if constexpr (ALIGN_EPI) { if (wr == 1) PG8_BAR; }
    }
    PG8_WAIT_V(0);
    if constexpr (!ALIGN_EPI) { if (wr == 0) PG8_BAR; }
    PG8_BAR;
#undef PG8_SA
#undef PG8_SB
#undef PG8_STAGE
#undef PG8_LDA
#undef PG8_LDB
#undef PG8_MMA
#undef PG8_WAIT_V
#undef PG8_WAIT_L
#undef PG8_BAR
#undef PG8_SCHED
}
}
using pg8::Unit;
typedef f32x4 Acc[2][2][4][2];


#ifndef ST_AUX
#define ST_AUX 2
#endif
#define ST16(BASE, OFF, VAL) __builtin_amdgcn_raw_buffer_store_b128((VAL), __builtin_amdgcn_make_buffer_rsrc((void*)(BASE), (short)0, 0x7ffffff0, 0x00020000), (int)((unsigned)(OFF) * (unsigned)sizeof(*(BASE))), 0, ST_AUX)
__device__ __forceinline__ void rope4(f32x4& v0, f32x4& v1, const float* rp, int i0) {
    const f32x4 c = *(const f32x4*)(rp + i0), s = *(const f32x4*)(rp + 16 + i0);
    const f32x4 a = v0, b = v1;
    v0[0] = a[0] * c[0] - a[1] * s[0]; v0[1] = a[1] * c[0] + a[0] * s[0];
    v0[2] = a[2] * c[1] - a[3] * s[1]; v0[3] = a[3] * c[1] + a[2] * s[1];
    v1[0] = b[0] * c[2] - b[1] * s[2]; v1[1] = b[1] * c[2] + b[0] * s[2];
    v1[2] = b[2] * c[3] - b[3] * s[3]; v1[3] = b[3] * c[3] + b[2] * s[3];
}
__device__ __forceinline__ float gelu_tanh(float y) { const float z = 0.7978845608028654f * (y + 0.044715f * y * y * y); return y * fsigmoid(2.0f * z); }

struct EpiProj {
    static constexpr bool PERM = true, DUAL = false;
    bf16_t *QA, *KVA, *KR, *LX, *LY, *GATES; float *SSQ, *SSKV; const float* rope;
    __device__ __forceinline__ void operator()(const Acc& acc, const Unit& u, int wr, int wc, int fr, int fq) const {
        const int pn = u.pn, rowt = u.pm * 256 + wr * 64 + fr, cw = wc * 32 + 8 * fq;
        if (pn >= 2) {
            bf16_t* base; int ld, mode;
            if (pn >= 6) { base = GATES + (pn - 6) * 256; ld = 2048; mode = 2; } else if (pn >= 4) { base = LY + (pn - 4) * 256; ld = 512; mode = 1; } else { base = LX + (pn - 2) * 256; ld = 512; mode = 0; }
#pragma unroll
            for (int ai = 0; ai < 2; ++ai)
#pragma unroll
                for (int m = 0; m < 4; ++m) { const unsigned row = rowt + ai * 128 + m * 16;
#pragma unroll
                    for (int bj = 0; bj < 2; ++bj) { f32x4 v0 = acc[ai][bj][m][0], v1 = acc[ai][bj][m][1];
                        if (mode == 2) {
#pragma unroll
                            for (int e = 0; e < 4; ++e) { v0[e] = fsigmoid(v0[e]); v1[e] = fsigmoid(v1[e]); } }
                        else if (mode == 1) {
#pragma unroll
                            for (int e = 0; e < 4; ++e) { v0[e] = gelu_tanh(v0[e]); v1[e] = gelu_tanh(v1[e]); } }
                        ST16(base, row * ld + bj * 128 + cw, pack8(v0, v1)); } }
        } else if (pn == 0) {
#pragma unroll
            for (int ai = 0; ai < 2; ++ai)
#pragma unroll
                for (int m = 0; m < 4; ++m) { const unsigned row = rowt + ai * 128 + m * 16; float ss = 0.f;
#pragma unroll
                    for (int bj = 0; bj < 2; ++bj) { const f32x4 v0 = acc[ai][bj][m][0], v1 = acc[ai][bj][m][1];
                        ss += (v0[0] * v0[0] + v0[1] * v0[1]) + (v0[2] * v0[2] + v0[3] * v0[3]) + (v1[0] * v1[0] + v1[1] * v1[1]) + (v1[2] * v1[2] + v1[3] * v1[3]);
                        ST16(QA, row * 256 + bj * 128 + cw, pack8(v0, v1)); }
                    ss += __shfl_xor(ss, 16); ss += __shfl_xor(ss, 32);
                    if (fq == 0) atomicAdd(SSQ + row, ss); }
        } else {
#pragma unroll
            for (int ai = 0; ai < 2; ++ai)
#pragma unroll
                for (int m = 0; m < 4; ++m) { const unsigned row = rowt + ai * 128 + m * 16;
                    { const f32x4 v0 = acc[ai][0][m][0], v1 = acc[ai][0][m][1];
                      float ss = (v0[0] * v0[0] + v0[1] * v0[1]) + (v0[2] * v0[2] + v0[3] * v0[3]) + (v1[0] * v1[0] + v1[1] * v1[1]) + (v1[2] * v1[2] + v1[3] * v1[3]);
                      ST16(KVA, row * 128 + cw, pack8(v0, v1));
                      ss += __shfl_xor(ss, 16); ss += __shfl_xor(ss, 32);
                      if (fq == 0) atomicAdd(SSKV + row, ss); }
                    if (wc == 0) { f32x4 v0 = acc[ai][1][m][0], v1 = acc[ai][1][m][1];
                      rope4(v0, v1, rope + (row & (SEQ - 1)) * 32, 4 * fq);
                      ST16(KR, row * 32 + 8 * fq, pack8(v0, v1)); } }
        }
    }
};

constexpr float QSCALE = 0.10206207261596577f * 1.4426950408889634f;
struct EpiQ {
    static constexpr bool PERM = true, DUAL = false;
    bf16_t* Q; const float* SSQ; const float* rope;
    __device__ __forceinline__ void operator()(const Acc& acc, const Unit& u, int wr, int wc, int fr, int fq) const {
        const int rowt = u.pm * 256 + wr * 64 + fr;
        const int c00 = u.pn * 256 + wc * 32 + 8 * fq, c01 = c00 + 128, d0 = c00 % 96, d1 = c01 % 96;
#pragma unroll
        for (int am = 0; am < 4; ++am) { const int ai = am >> 1, mb = (am & 1) * 2;
            f32x4 cs[2][2][2]; float ss[2];
#pragma unroll
            for (int mm = 0; mm < 2; ++mm) ss[mm] = SSQ[(unsigned)(rowt + ai * 128 + (mb + mm) * 16)];
#pragma unroll
            for (int mm = 0; mm < 2; ++mm) { const unsigned pos = (unsigned)(rowt + ai * 128 + (mb + mm) * 16) & (SEQ - 1);
#pragma unroll
                for (int bj = 0; bj < 2; ++bj) { const int d = bj ? d1 : d0; if (d >= 64) { const float* rp = rope + (pos * 32 + ((d - 64) >> 1)); cs[mm][bj][0] = *(const f32x4*)rp; cs[mm][bj][1] = *(const f32x4*)(rp + 16); }
                    else { cs[mm][bj][0] = (f32x4){1.f, 1.f, 1.f, 1.f}; cs[mm][bj][1] = (f32x4){0.f, 0.f, 0.f, 0.f}; } } }
#pragma unroll
            for (int mm = 0; mm < 2; ++mm) { const int m = mb + mm; const unsigned row = rowt + ai * 128 + m * 16; const float rstd = rsqrtf(ss[mm] * (1.0f / 256.0f) + EPS) * QSCALE;
#pragma unroll
                for (int bj = 0; bj < 2; ++bj) { const int c0 = bj ? c01 : c00;
                    const f32x4 a = acc[ai][bj][m][0] * rstd, b = acc[ai][bj][m][1] * rstd, c = cs[mm][bj][0], sn = cs[mm][bj][1]; f32x4 v0, v1;
                    v0[0] = a[0] * c[0] - a[1] * sn[0]; v0[1] = a[1] * c[0] + a[0] * sn[0]; v0[2] = a[2] * c[1] - a[3] * sn[1]; v0[3] = a[3] * c[1] + a[2] * sn[1];
                    v1[0] = b[0] * c[2] - b[1] * sn[2]; v1[1] = b[1] * c[2] + b[0] * sn[2]; v1[2] = b[2] * c[3] - b[3] * sn[3]; v1[3] = b[3] * c[3] + b[2] * sn[3];
                    if ((bj ? d1 : d0) < 64) { v0 = a; v1 = b; }
                    ST16(Q, (row * 768 + c0), pack8(v0, v1)); } }
            asm volatile("" ::: "memory"); }
    }
};

struct EpiKV {
    static constexpr bool PERM = true, DUAL = false;
    bf16_t *KN, *V; const float* SSKV;
    __device__ __forceinline__ void operator()(const Acc& acc, const Unit& u, int wr, int wc, int fr, int fq) const {
        const int rowt = u.pm * 256 + wr * 64 + fr; bf16_t* base = (u.pn < 2 ? KN : V) + (u.pn & 1) * 256; const unsigned cw = wc * 32 + 8 * fq;
        float ss[8];
#pragma unroll
        for (int i = 0; i < 8; ++i) ss[i] = SSKV[(unsigned)(rowt + (i >> 2) * 128 + (i & 3) * 16)];
#pragma unroll
        for (int ai = 0; ai < 2; ++ai)
#pragma unroll
            for (int m = 0; m < 4; ++m) { const unsigned row = rowt + ai * 128 + m * 16; const float rstd = rsqrtf(ss[ai * 4 + m] * (1.0f / 128.0f) + EPS);
#pragma unroll
                for (int bj = 0; bj < 2; ++bj) ST16(base, (row * 512 + bj * 128 + cw), pack8(acc[ai][bj][m][0] * rstd, acc[ai][bj][m][1] * rstd)); }
    }
};

__device__ __forceinline__ unsigned pack_h2(float lo, float hi) { const __half2 h = __floats2half2_rn(lo, hi); return *(const unsigned*)&h; }
struct EpiGates {
    static constexpr bool PERM = true, DUAL = false;
    const bf16_t* XC; unsigned* AU; const float *br, *bi, *sp8;
    __device__ __forceinline__ void operator()(const Acc& acc, const Unit& u, int wr, int wc, int fr, int fq) const {
        const int blk = u.pn >> 1, dir = u.pn & 1, rowt = u.pm * 256 + wr * 64 + fr, j0 = wc * 32 + 8 * fq, ch = blk * 128 + j0;
        const float* pbr = br + (dir * 4 + blk) * 128; const float* pbi = bi + (dir * 4 + blk) * 128; const float* psp = sp8 + dir * 512 + blk * 128;
        u32x4 xw[8];
#pragma unroll
        for (int i = 0; i < 8; ++i) xw[i] = *(const u32x4*)(XC + (unsigned)((rowt + (i >> 2) * 128 + (i & 3) * 16) * 512 + ch));
        f32x4 cbr[2], cbi[2], csp[2];
#pragma unroll
        for (int h = 0; h < 2; ++h) { cbr[h] = *(const f32x4*)(pbr + (unsigned)(j0 + 4 * h)); cbi[h] = *(const f32x4*)(pbi + (unsigned)(j0 + 4 * h)); csp[h] = *(const f32x4*)(psp + (unsigned)(j0 + 4 * h)); }
        unsigned* dst = AU + (size_t)dir * T * 512;
#pragma unroll
        for (int ai = 0; ai < 2; ++ai)
#pragma unroll
            for (int m = 0; m < 4; ++m) { const unsigned row = rowt + ai * 128 + m * 16;
                f32x4 x0, x1; unpack8(xw[ai * 4 + m], x0, x1);
                u32x4 o0, o1;
#pragma unroll
                for (int h = 0; h < 2; ++h) { const f32x4 ar = acc[ai][0][m][h] + cbr[h], aiq = acc[ai][1][m][h] + cbi[h], sp = csp[h], xx = h ? x1 : x0; u32x4 o;
#pragma unroll
                    for (int e = 0; e < 4; ++e) { const float rr = fsigmoid(ar[e]), ii = fsigmoid(aiq[e]); const float la = -rr * sp[e], y = 2.0f * la;
                        float m2 = -y * (1.0f + y * (0.5f + y * (0.16666667f + y * (0.041666668f + y * 0.0083333338f))));
                        if (__builtin_expect(__any(y < -0.25f), 0)) m2 = (y < -0.25f) ? 1.0f - __builtin_amdgcn_exp2f(y * LOG2E) : m2;
                        const float uu = ii * xx[e] * __builtin_amdgcn_sqrtf(m2); o[e] = pack_h2(la * LOG2E, uu); }
                    if (h) o1 = o; else o0 = o; }
                ST16(dst, (row * 512 + ch), o0); ST16(dst, (row * 512 + ch + 4), o1); }
    }
};

struct EpiMerge {
    static constexpr bool PERM = true, DUAL = true;
    const bf16_t* GATES; bf16_t* MERGED;
    __device__ __forceinline__ void operator()(Acc& acc, const Unit& u, int wr, int wc, int fr, int fq) const {
        const int rowt = u.pm * 256 + wr * 64 + fr, c0 = u.pn * 256 + wc * 32 + 8 * fq;
#pragma unroll
        for (int ai = 0; ai < 2; ++ai) {
            u32x4 gw_[4][2], hw_[4][2];
#pragma unroll
            for (int m = 0; m < 4; ++m)
#pragma unroll
                for (int bj = 0; bj < 2; ++bj) { const unsigned o = (unsigned)((rowt + ai * 128 + m * 16) * 2048 + c0 + bj * 128);
                    gw_[m][bj] = *(const u32x4*)(GATES + (o + 1024)); if (u.sel == 0) hw_[m][bj] = *(const u32x4*)(GATES + o); else hw_[m][bj] = gw_[m][bj]; }
#pragma unroll
            for (int m = 0; m < 4; ++m) { const unsigned row = rowt + ai * 128 + m * 16;
#pragma unroll
                for (int bj = 0; bj < 2; ++bj) { f32x4 r0, r1, a0, a1; unpack8(gw_[m][bj], r0, r1); unpack8(hw_[m][bj], a0, a1);
                    if (u.sel == 0) {
#pragma unroll
                        for (int e = 0; e < 4; ++e) { acc[ai][bj][m][0][e] *= a0[e] * __builtin_amdgcn_rcpf(r0[e]); acc[ai][bj][m][1][e] *= a1[e] * __builtin_amdgcn_rcpf(r1[e]); } }
                    else { ST16(MERGED, (row * 1024 + c0 + bj * 128), pack8(acc[ai][bj][m][0] * r0, acc[ai][bj][m][1] * r1)); } } }
            asm volatile("" ::: "memory"); }
    }
};

struct EpiOut {
    static constexpr bool PERM = true, DUAL = false;
    const float* X; bf16_t* X1B; float* SS2;
    __device__ __forceinline__ void operator()(const Acc& acc, const Unit& u, int wr, int wc, int fr, int fq) const {
        const int rowt = u.pm * 256 + wr * 64 + fr, c0 = u.pn * 256 + wc * 32 + 8 * fq;
#pragma unroll
        for (int ai = 0; ai < 2; ++ai) {
            f32x4 xv[4][2][2];
#pragma unroll
            for (int m = 0; m < 4; ++m)
#pragma unroll
                for (int bj = 0; bj < 2; ++bj) { const unsigned o = (rowt + ai * 128 + m * 16) * 1024 + c0 + bj * 128; xv[m][bj][0] = __builtin_nontemporal_load((const f32x4*)(X + o)); xv[m][bj][1] = __builtin_nontemporal_load((const f32x4*)(X + (o + 4))); }
#pragma unroll
            for (int m = 0; m < 4; ++m) { const unsigned row = rowt + ai * 128 + m * 16; float ss = 0.f;
#pragma unroll
                for (int bj = 0; bj < 2; ++bj) { const unsigned o = row * 1024 + c0 + bj * 128;
                    const f32x4 v0 = acc[ai][bj][m][0] + xv[m][bj][0], v1 = acc[ai][bj][m][1] + xv[m][bj][1];
                    ss += (v0[0] * v0[0] + v0[1] * v0[1]) + (v0[2] * v0[2] + v0[3] * v0[3]) + (v1[0] * v1[0] + v1[1] * v1[1]) + (v1[2] * v1[2] + v1[3] * v1[3]);
                    ST16(X1B, o, pack8(v0, v1)); }
                ss += __shfl_xor(ss, 16); ss += __shfl_xor(ss, 32);
                if (fq == 0) atomicAdd(SS2 + row, ss); }
            asm volatile("" ::: "memory"); }
    }
};

struct EpiFfn {
    static constexpr bool PERM = true, DUAL = false;
    bf16_t* HID; const float* SS2;
    __device__ __forceinline__ void operator()(const Acc& acc, const Unit& u, int wr, int wc, int fr, int fq) const {
        const int rowt = u.pm * 256 + wr * 64 + fr, c0 = u.pn * 128 + wc * 32 + 8 * fq;
        float ss[8];
#pragma unroll
        for (int i = 0; i < 8; ++i) ss[i] = SS2[(unsigned)(rowt + (i >> 2) * 128 + (i & 3) * 16)];
#pragma unroll
        for (int ai = 0; ai < 2; ++ai)
#pragma unroll
            for (int m = 0; m < 4; ++m) { const unsigned row = rowt + ai * 128 + m * 16; const float rstd = rsqrtf(ss[ai * 4 + m] * (1.0f / 1024.0f) + EPS);
                f32x4 h0, h1;
#pragma unroll
                for (int e = 0; e < 4; ++e) { const float g0 = acc[ai][0][m][0][e] * rstd, g1 = acc[ai][0][m][1][e] * rstd;
                    h0[e] = g0 * fsigmoid(g0) * (acc[ai][1][m][0][e] * rstd); h1[e] = g1 * fsigmoid(g1) * (acc[ai][1][m][1][e] * rstd); }
                ST16(HID, (row * DFF + c0), pack8(h0, h1)); }
    }
};

struct EpiDown {
    static constexpr bool PERM = true, DUAL = false;
    bf16_t* X1B; float* SS3;
    __device__ __forceinline__ void operator()(const Acc& acc, const Unit& u, int wr, int wc, int fr, int fq) const {
        const int rowt = u.pm * 256 + wr * 64 + fr, c0 = u.pn * 256 + wc * 32 + 8 * fq;
        u32x4 xv[8][2];
#pragma unroll
        for (int i = 0; i < 8; ++i)
#pragma unroll
            for (int bj = 0; bj < 2; ++bj) xv[i][bj] = *(const u32x4*)(X1B + (unsigned)((rowt + (i >> 2) * 128 + (i & 3) * 16) * 1024 + c0 + bj * 128));
#pragma unroll
        for (int ai = 0; ai < 2; ++ai)
#pragma unroll
            for (int m = 0; m < 4; ++m) { const unsigned row = rowt + ai * 128 + m * 16; float ss = 0.f;
#pragma unroll
                for (int bj = 0; bj < 2; ++bj) { const unsigned o = row * 1024 + c0 + bj * 128; f32x4 p0, p1; unpack8(xv[ai * 4 + m][bj], p0, p1);
                    const f32x4 v0 = acc[ai][bj][m][0] + p0, v1 = acc[ai][bj][m][1] + p1;
                    ss += (v0[0] * v0[0] + v0[1] * v0[1]) + (v0[2] * v0[2] + v0[3] * v0[3]) + (v1[0] * v1[0] + v1[1] * v1[1]) + (v1[2] * v1[2] + v1[3] * v1[3]);
                    ST16(X1B, o, pack8(v0, v1)); }
                ss += __shfl_xor(ss, 16); ss += __shfl_xor(ss, 32);
                if (fq == 0) atomicAdd(SS3 + row, ss); }
    }
};

namespace att {
constexpr int NW = 8, QBLK = 32, KVBLK = 64;
constexpr float SCALE = 0.10206207261596577f;
constexpr float THR = 8.f;
constexpr int SHM_V = 16384, SHM_K = 16384;
#define KSWZ(row, colB) ((row) * 256 + ((colB) ^ (((row) & 7) << 4)))
#define SBAR() __builtin_amdgcn_sched_barrier(0)
__device__ __forceinline__ int crow(int r, int hi) { return (r & 3) + 8 * (r >> 2) + 4 * hi; }
template <bool FIRST> __device__ __forceinline__ void partialSM(f32x16& p0, f32x16& p1, float& mref, f32x16& negm, float& alpha) {
  constexpr float THRL = THR * 1.4426950408889634f;
  float pmax = p0[0];
#pragma unroll
  for (int r = 1; r < 16; ++r) pmax = fmaxf(pmax, p0[r]);
#pragma unroll
  for (int r = 0; r < 16; ++r) pmax = fmaxf(pmax, p1[r]);
  { auto rr = __builtin_amdgcn_permlane32_swap(__float_as_uint(pmax), __float_as_uint(pmax), false, false);
    pmax = fmaxf(__uint_as_float(rr[0]), __uint_as_float(rr[1])); }
  if (!FIRST && __builtin_expect(__all(pmax <= THRL), 1)) { alpha = 1.f; }
  else { const float dl = FIRST ? pmax : fmaxf(pmax, 0.f); mref += dl; alpha = FIRST ? 1.f : __builtin_amdgcn_exp2f(-dl);
#pragma unroll
    for (int r = 0; r < 16; ++r) { p0[r] -= dl; p1[r] -= dl; }
    const float nm = -mref;
#pragma unroll
    for (int r = 0; r < 16; ++r) negm[r] = nm; }
#pragma unroll
  for (int r = 0; r < 16; ++r) p0[r] = __builtin_amdgcn_exp2f(p0[r]);
}
__device__ __forceinline__ void finishSM(f32x16& p0, f32x16& p1, float alpha, float& l_reg, bf16x8& pa0, bf16x8& pa1, bf16x8& pa2, bf16x8& pa3) {
#pragma unroll
  for (int r = 0; r < 16; ++r) p1[r] = __builtin_amdgcn_exp2f(p1[r]);
  float ps = 0;
#pragma unroll
  for (int r = 0; r < 16; ++r) ps += p0[r];
#pragma unroll
  for (int r = 0; r < 16; ++r) ps += p1[r];
  { auto rr = __builtin_amdgcn_permlane32_swap(__float_as_uint(ps), __float_as_uint(ps), false, false);
    ps = __uint_as_float(rr[0]) + __uint_as_float(rr[1]); }
  l_reg = l_reg * alpha + ps;
#define PK4(P, BASE, OUT) do { u32x4 w = {cvt_pk_bf16(P[BASE + 0], P[BASE + 1]), cvt_pk_bf16(P[BASE + 2], P[BASE + 3]), cvt_pk_bf16(P[BASE + 4], P[BASE + 5]), cvt_pk_bf16(P[BASE + 6], P[BASE + 7])}; \
    OUT = *reinterpret_cast<bf16x8*>(&w); } while (0)
  PK4(p0, 0, pa0); PK4(p0, 8, pa1); PK4(p1, 0, pa2); PK4(p1, 8, pa3);
#undef PK4
}
__device__ __forceinline__ void qkt(f32x16& p0, f32x16& p1, const char* Ks, const bf16x8* qr, const f32x16& negm, int r32, int hi) {
  p0 = negm; p1 = negm;
#pragma unroll
  for (int d0 = 0; d0 < 6; ++d0) { int cb = (d0 * 16 + hi * 8) * 2;
    bf16x8 b0 = *reinterpret_cast<const bf16x8*>(Ks + KSWZ(r32, cb));
    bf16x8 b1 = *reinterpret_cast<const bf16x8*>(Ks + KSWZ(32 + r32, cb));
    p0 = __builtin_amdgcn_mfma_f32_32x32x16_bf16(b0, qr[d0], p0, 0, 0, 0);
    p1 = __builtin_amdgcn_mfma_f32_32x32x16_bf16(b1, qr[d0], p1, 0, 0, 0); }
}
__device__ __forceinline__ int v_st(int k, int c) { const int kk = k; return ((kk >> 3) * 4 + (c >> 5)) * 512 + ((kk & 7) * 32 + (c & 31)) * 2; }
__device__ __forceinline__ int v_rd_base(int lane) { return ((lane & 3) << 3) | (((lane >> 2) & 3) << 6) | (((lane >> 4) & 1) << 5) | (((lane >> 5) & 1) << 8); }
constexpr int v_rd_off(int d0, int ks, int half) { return d0 * 512 + ks * 4096 + half * 2048; }
typedef short v4i16_t __attribute__((ext_vector_type(4)));
typedef LAS const char* lds_cptr;
__device__ __forceinline__ s16x4 vtr(lds_cptr p) { return __builtin_bit_cast(s16x4, __builtin_amdgcn_ds_read_tr16_b64_v4i16((LAS v4i16_t*)p)); }
template <int D0> __device__ __forceinline__ void pv_one(f32x16& od, lds_cptr vp, bf16x8 pa0, bf16x8 pa1, bf16x8 pa2, bf16x8 pa3) {
  const s16x4 l0 = vtr(vp + v_rd_off(D0, 0, 0)), h0 = vtr(vp + v_rd_off(D0, 0, 1)), l1 = vtr(vp + v_rd_off(D0, 1, 0)), h1 = vtr(vp + v_rd_off(D0, 1, 1));
  const s16x4 l2 = vtr(vp + v_rd_off(D0, 2, 0)), h2 = vtr(vp + v_rd_off(D0, 2, 1)), l3 = vtr(vp + v_rd_off(D0, 3, 0)), h3 = vtr(vp + v_rd_off(D0, 3, 1));
#define PK(L, H) (bf16x8){L[0], L[1], L[2], L[3], H[0], H[1], H[2], H[3]}
  od = __builtin_amdgcn_mfma_f32_32x32x16_bf16(pa0, PK(l0, h0), od, 0, 0, 0);
  od = __builtin_amdgcn_mfma_f32_32x32x16_bf16(pa1, PK(l1, h1), od, 0, 0, 0);
  od = __builtin_amdgcn_mfma_f32_32x32x16_bf16(pa2, PK(l2, h2), od, 0, 0, 0);
  od = __builtin_amdgcn_mfma_f32_32x32x16_bf16(pa3, PK(l3, h3), od, 0, 0, 0);
#undef PK
}
__device__ __forceinline__ void pv_d0(f32x16* o, lds_cptr vp, bf16x8 pa0, bf16x8 pa1, bf16x8 pa2, bf16x8 pa3) {
  pv_one<0>(o[0], vp, pa0, pa1, pa2, pa3); pv_one<1>(o[1], vp, pa0, pa1, pa2, pa3);
}
__device__ __forceinline__ void attn_unit(const bf16_t* __restrict__ Qb, const bf16_t* __restrict__ KNh, const bf16_t* __restrict__ KRb, const bf16_t* __restrict__ Vh, bf16_t* __restrict__ Ob, char* lds) {
  const int tid = threadIdx.x, wid = tid >> 6, lane = tid & 63, r32 = lane & 31, hi = lane >> 5;
  char* V_lds = lds; char* K_lds = lds + 2 * SHM_V;
  float* ws = (float*)(lds + 2 * SHM_V + 2 * SHM_K) + wid * 64; float* li_l = ws; float* al_l = ws + 32;
  float mref = 0.f, l_reg = 0; f32x16 negm = {}; f32x16 o[2] = {}; bf16x8 qr[6];
  const bf16_t* Qw = Qb + (long)(wid * QBLK + r32) * 768 + hi * 8;
#pragma unroll
  for (int d0 = 0; d0 < 6; ++d0) qr[d0] = *reinterpret_cast<const bf16x8*>(Qw + d0 * 16);
  const int sr = tid >> 3, sc = (tid & 7) * 8, vst = v_st(sr, sc), kst = KSWZ(sr, sc * 2), krst = KSWZ(sr, 128 + (tid & 7) * 8);
  const lds_cptr vb0 = (lds_cptr)(LAS char*)lds + v_rd_base(lane);
  struct { bf16x8 vs, ks; s16x4 kr; } sr_[2];
  const unsigned lo_kv = (unsigned)(sr * 512 + sc), lo_kr = (unsigned)(sr * 32 + (tid & 7) * 4);
#define SLOAD(i, k0) do { const bf16_t* vt_ = Vh + (size_t)(k0) * 512; const bf16_t* kt_ = KNh + (size_t)(k0) * 512; const bf16_t* rt_ = KRb + (size_t)(k0) * 32; \
    sr_[i].vs = *reinterpret_cast<const bf16x8*>(vt_ + lo_kv); sr_[i].ks = *reinterpret_cast<const bf16x8*>(kt_ + lo_kv); sr_[i].kr = *reinterpret_cast<const s16x4*>(rt_ + lo_kr); } while (0)
#define SWRITE(b, i) do { *(bf16x8*)(V_lds + (b) * SHM_V + vst) = sr_[i].vs; *(bf16x8*)(K_lds + (b) * SHM_K + kst) = sr_[i].ks; *(s16x4*)(K_lds + (b) * SHM_K + krst) = sr_[i].kr; } while (0)
#define SWAIT() asm volatile("s_waitcnt vmcnt(3)" ::: "memory")
#define RESC(a) do { if (__any((a) < 1.f)) { if (hi == 0) al_l[r32] = (a); asm volatile("s_waitcnt lgkmcnt(0)" ::: "memory"); \
    _Pragma("unroll") for (int d = 0; d < 2; ++d) _Pragma("unroll") for (int r = 0; r < 16; ++r) o[d][r] *= al_l[crow(r, hi)]; } } while (0)
  f32x16 pA0, pA1, pB0, pB1; float alA, alB; bf16x8 pa0, pa1, pa2, pa3; constexpr int NT = SEQ / KVBLK;
  constexpr int SE = 0, SO = 1;
  SLOAD(SE, 0); asm volatile("s_waitcnt vmcnt(0)" ::: "memory"); SWRITE(0, SE); __syncthreads();
  qkt(pA0, pA1, K_lds, qr, negm, r32, hi); partialSM<true>(pA0, pA1, mref, negm, alA);
  SLOAD(SO, KVBLK); SLOAD(SE, 2 * KVBLK);
  SWAIT(); SWRITE(1, SO); __syncthreads();
  for (int j = 1; j + 1 < NT; j += 2) {
    SBAR(); qkt(pB0, pB1, K_lds + SHM_K, qr, negm, r32, hi);
    finishSM(pA0, pA1, alA, l_reg, pa0, pa1, pa2, pa3); SBAR();
    SLOAD(SO, (j + 2) * KVBLK); SBAR();
    pv_d0(o, vb0, pa0, pa1, pa2, pa3); partialSM<false>(pB0, pB1, mref, negm, alB);
    __syncthreads(); SWAIT(); SWRITE(0, SE);
    RESC(alB); __syncthreads();
    SBAR(); qkt(pA0, pA1, K_lds, qr, negm, r32, hi);
    finishSM(pB0, pB1, alB, l_reg, pa0, pa1, pa2, pa3); SBAR();
    if (j + 3 < NT) SLOAD(SE, (j + 3) * KVBLK); SBAR();
    pv_d0(o, vb0 + SHM_V, pa0, pa1, pa2, pa3); partialSM<false>(pA0, pA1, mref, negm, alA);
    __syncthreads(); SWAIT(); SWRITE(1, SO);
    RESC(alA); __syncthreads();
  }
  SBAR(); qkt(pB0, pB1, K_lds + SHM_K, qr, negm, r32, hi);
  finishSM(pA0, pA1, alA, l_reg, pa0, pa1, pa2, pa3); SBAR();
  pv_d0(o, vb0, pa0, pa1, pa2, pa3); partialSM<false>(pB0, pB1, mref, negm, alB);
  __syncthreads(); RESC(alB);
  finishSM(pB0, pB1, alB, l_reg, pa0, pa1, pa2, pa3); SBAR();
  pv_d0(o, vb0 + SHM_V, pa0, pa1, pa2, pa3);
  if (hi == 0) li_l[r32] = l_reg; asm volatile("s_waitcnt lgkmcnt(0)" ::: "memory");
  float rli[16];
#pragma unroll
  for (int r = 0; r < 16; ++r) rli[r] = __builtin_amdgcn_rcpf(li_l[crow(r, hi)]);
  bf16_t* Ow = Ob + (long)(wid * QBLK) * 512;
#pragma unroll
  for (int r = 0; r < 16; ++r) { int orow = crow(r, hi);
#pragma unroll
    for (int d0 = 0; d0 < 2; ++d0) Ow[(long)orow * 512 + d0 * 32 + r32] = (bf16_t)(cvt_pk_bf16(o[d0][r] * rli[r], 0.f) & 0xffffu); }
  __syncthreads();
#undef SLOAD
#undef SWRITE
#undef SWAIT
#undef RESC
}
#undef KSWZ
#undef SBAR
}

__device__ __forceinline__ void h2f(unsigned w, float& lo, float& hi) { const __half2 h = *(const __half2*)&w; const float2 f = __half22float2(h); lo = f.x; hi = f.y; }
__device__ __forceinline__ void scan_item(int b, int cgp, unsigned* AU, const bf16_t* LY, bf16_t* REC, float* sc) {
    const int tid = threadIdx.x, wid = tid >> 6, lane = tid & 63, c = cgp * 64 + lane;
    const unsigned r0 = (unsigned)b * SEQ + wid * 256;
    unsigned* au0 = AU + c; unsigned* au1 = AU + (size_t)T * 512 + c; const bf16_t* ly = LY + c; bf16_t* rec = REC + c;
#define SC_STEP(W, H) do { float la_, u_; h2f(W, la_, u_); H = __builtin_amdgcn_exp2f(la_) * H + u_; } while (0)
    { float hf = 0.f, hb = 0.f, slf = 0.f, slb = 0.f; unsigned fa[16], ba[16], fb[16], bb[16];
#pragma unroll
      for (int k = 0; k < 16; ++k) { fa[k] = au0[(r0 + k) * 512]; ba[k] = au1[(r0 + 255 - k) * 512]; }
#pragma unroll 1
      for (int blk = 0; blk < 16; blk += 2) {
#pragma unroll
          for (int k = 0; k < 16; ++k) { fb[k] = au0[(r0 + (blk + 1) * 16 + k) * 512]; bb[k] = au1[(r0 + 255 - ((blk + 1) * 16 + k)) * 512]; }
#pragma unroll
          for (int k = 0; k < 16; ++k) { float la, u; h2f(fa[k], la, u); hf = __builtin_amdgcn_exp2f(la) * hf + u; slf += la; h2f(ba[k], la, u); hb = __builtin_amdgcn_exp2f(la) * hb + u; slb += la; }
          if (blk + 2 < 16) {
#pragma unroll
              for (int k = 0; k < 16; ++k) { fa[k] = au0[(r0 + (blk + 2) * 16 + k) * 512]; ba[k] = au1[(r0 + 255 - ((blk + 2) * 16 + k)) * 512]; } }
#pragma unroll
          for (int k = 0; k < 16; ++k) { float la, u; h2f(fb[k], la, u); hf = __builtin_amdgcn_exp2f(la) * hf + u; slf += la; h2f(bb[k], la, u); hb = __builtin_amdgcn_exp2f(la) * hb + u; slb += la; }
      }
      sc[wid * 64 + lane] = __builtin_amdgcn_exp2f(slf); sc[1024 + wid * 64 + lane] = hf;
      sc[(8 + wid) * 64 + lane] = __builtin_amdgcn_exp2f(slb); sc[1024 + (8 + wid) * 64 + lane] = hb; }
    __syncthreads();
    float cin0 = 0.f, cin1 = 0.f;
    for (int k = 0; k < wid; ++k) cin0 = sc[k * 64 + lane] * cin0 + sc[1024 + k * 64 + lane];
    for (int k = 7; k > wid; --k) cin1 = sc[(8 + k) * 64 + lane] * cin1 + sc[1024 + (8 + k) * 64 + lane];
    { float h = cin0; unsigned wa[16], wb[16];
#pragma unroll
      for (int k = 0; k < 16; ++k) wa[k] = au0[(r0 + k) * 512];
#pragma unroll 1
      for (int blk = 0; blk < 16; blk += 2) {
#pragma unroll
          for (int k = 0; k < 16; ++k) wb[k] = au0[(r0 + (blk + 1) * 16 + k) * 512];
#pragma unroll
          for (int k = 0; k < 16; ++k) { SC_STEP(wa[k], h); rec[(r0 + blk * 16 + k) * 512] = (bf16_t)(cvt_pk_bf16(h, 0.f) & 0xffffu); }
          if (blk + 2 < 16) {
#pragma unroll
              for (int k = 0; k < 16; ++k) wa[k] = au0[(r0 + (blk + 2) * 16 + k) * 512]; }
#pragma unroll
          for (int k = 0; k < 16; ++k) { SC_STEP(wb[k], h); rec[(r0 + (blk + 1) * 16 + k) * 512] = (bf16_t)(cvt_pk_bf16(h, 0.f) & 0xffffu); }
      } }
    { float h = cin1; unsigned wa[16], wb[16]; bf16_t fa[16], fb[16], ya[16], yb[16];
#pragma unroll
      for (int k = 0; k < 16; ++k) { const unsigned row = r0 + 255 - k; wa[k] = au1[row * 512]; fa[k] = rec[row * 512]; ya[k] = ly[row * 512]; }
#pragma unroll 1
      for (int blk = 0; blk < 16; blk += 2) {
#pragma unroll
          for (int k = 0; k < 16; ++k) { const unsigned row = r0 + 255 - ((blk + 1) * 16 + k); wb[k] = au1[row * 512]; fb[k] = rec[row * 512]; yb[k] = ly[row * 512]; }
#pragma unroll
          for (int k = 0; k < 16; ++k) { const unsigned row = r0 + 255 - (blk * 16 + k); SC_STEP(wa[k], h);
              const float tot = (h + __uint_as_float((unsigned)fa[k] << 16)) * __uint_as_float((unsigned)ya[k] << 16); rec[row * 512] = (bf16_t)(cvt_pk_bf16(tot, 0.f) & 0xffffu); }
          if (blk + 2 < 16) {
#pragma unroll
              for (int k = 0; k < 16; ++k) { const unsigned row = r0 + 255 - ((blk + 2) * 16 + k); wa[k] = au1[row * 512]; fa[k] = rec[row * 512]; ya[k] = ly[row * 512]; } }
#pragma unroll
          for (int k = 0; k < 16; ++k) { const unsigned row = r0 + 255 - ((blk + 1) * 16 + k); SC_STEP(wb[k], h);
              const float tot = (h + __uint_as_float((unsigned)fb[k] << 16)) * __uint_as_float((unsigned)yb[k] << 16); rec[row * 512] = (bf16_t)(cvt_pk_bf16(tot, 0.f) & 0xffffu); }
      } }
#undef SC_STEP
    __syncthreads();
}

template <class F> __device__ __forceinline__ void xpose(bf16_t* Bt, int N, int K, F f, int gw, int NGW, int lane) {
    const int nN = N / 64, total = nN * (K / 8);
    for (int item = gw; item < total; item += NGW) { const int ng = item % nN, kc = item / nN, n = ng * 64 + lane, k0 = kc * 8;
        float v[8];
#pragma unroll
        for (int e = 0; e < 8; ++e) v[e] = f(n, k0 + e);
        u32x4 w; w.x = cvt_pk_bf16(v[0], v[1]); w.y = cvt_pk_bf16(v[2], v[3]); w.z = cvt_pk_bf16(v[4], v[5]); w.w = cvt_pk_bf16(v[6], v[7]);
        *(u32x4*)(Bt + (size_t)n * K + k0) = w; }
}


template <class F> __device__ __forceinline__ void xpose_one(bf16_t* Bt, int N, int K, F f, int item, int lane) {
    const int nN = N / 64, n = (item % nN) * 64 + lane, k0 = (item / nN) * 8;
    float v[8];
#pragma unroll
    for (int e = 0; e < 8; ++e) v[e] = f(n, k0 + e);
    u32x4 w; w.x = cvt_pk_bf16(v[0], v[1]); w.y = cvt_pk_bf16(v[2], v[3]); w.z = cvt_pk_bf16(v[4], v[5]); w.w = cvt_pk_bf16(v[6], v[7]);
    *(u32x4*)(Bt + (size_t)n * K + k0) = w;
}

#define XB_TMO      128
#define XB_XCNT(j)  (256  + 64 * (j))
#define XB_XSUB(j)  (1280 + 64 * (j))
#define XB_XGEN(j)  (2304 + 64 * (j))
#define XB_TOP      3328
#define XB_TOPGEN   3392
#define XCD_BAR_WORDS 3456
#define XB_SPIN_CAP (1u << 18)
__device__ __forceinline__ unsigned xb_ld(unsigned* p)              { return __hip_atomic_load(p, __ATOMIC_RELAXED, __HIP_MEMORY_SCOPE_AGENT); }
__device__ __forceinline__ unsigned xb_add(unsigned* p, unsigned v) { return __hip_atomic_fetch_add(p, v, __ATOMIC_RELAXED, __HIP_MEMORY_SCOPE_AGENT); }
__device__ __forceinline__ unsigned xb_xcc_id() { return (unsigned)__builtin_amdgcn_s_getreg((3 << 11) | 20) & 0xFu; }
#define XB_SPIN(cond, bar) do { unsigned _sp = 0; while (cond) { __builtin_amdgcn_s_sleep(1); \
    if ((++_sp & 255u) == 0u) { if (xb_ld(&(bar)[XB_TMO])) break; if (_sp > XB_SPIN_CAP) { atomicAdd(&(bar)[XB_TMO], 1u); break; } } } } while (0)
struct XcdBarrier { unsigned* bar; unsigned x; volatile LAS unsigned* st; };
__device__ __forceinline__ XcdBarrier xcd_barrier_post(unsigned* bar, volatile LAS unsigned* st) {
    XcdBarrier b; b.bar = bar; b.x = xb_xcc_id(); b.st = st;
    if (threadIdx.x == 0) (void)xb_add(&bar[XB_XCNT(b.x)], 1u);
    return b;
}
__device__ __forceinline__ void xcd_barrier_complete(unsigned* bar, unsigned x, unsigned& nloc, unsigned& nx) {
    const unsigned G = gridDim.x * gridDim.y * gridDim.z;
    unsigned sum, cnt, mine, sp = 0u;
    for (;;) {
        sum = 0u; cnt = 0u; mine = 0u;
#pragma unroll
        for (unsigned j = 0; j < 16; ++j) { const unsigned c = xb_ld(&bar[XB_XCNT(j)]); sum += c; cnt += (c > 0u) ? 1u : 0u; mine = (j == x) ? c : mine; }
        if (sum == G) break;
        __builtin_amdgcn_s_sleep(1);
        if ((++sp & 255u) == 0u) { if (xb_ld(&bar[XB_TMO])) break; if (sp > XB_SPIN_CAP) { atomicAdd(&bar[XB_TMO], 1u); break; } }
    }
    nloc = mine > 0u ? mine : 1u; nx = cnt > 0u ? cnt : 1u;
}
__device__ __forceinline__ void xcd_barrier(const XcdBarrier& b) {
    asm volatile("s_waitcnt vmcnt(0)" ::: "memory");
    __syncthreads();
    if (threadIdx.x == 0) {
        unsigned* bar = b.bar;
        __builtin_amdgcn_s_waitcnt(0);
        unsigned nloc = b.st[0], nx = b.st[1];
        if (nloc == 0u) { xcd_barrier_complete(bar, b.x, nloc, nx); b.st[0] = nloc; b.st[1] = nx; }
        const unsigned old = xb_add(&bar[XB_XSUB(b.x)], 1u);
        const unsigned gen = old / nloc;
        if (old + 1u == (gen + 1u) * nloc) {
            __builtin_amdgcn_fence(__ATOMIC_RELEASE, "agent");
            asm volatile("s_waitcnt vmcnt(0)" ::: "memory");
            const unsigned og = xb_add(&bar[XB_TOP], 1u);
            const unsigned tg = og / nx;
            if (og + 1u == (tg + 1u) * nx) xb_add(&bar[XB_TOPGEN], 1u);
            else XB_SPIN(xb_ld(&bar[XB_TOPGEN]) == tg, bar);
            __builtin_amdgcn_fence(__ATOMIC_ACQUIRE, "agent");
            xb_add(&bar[XB_XGEN(b.x)], 1u);
            asm volatile("s_waitcnt vmcnt(0)" ::: "memory");
        } else {
            XB_SPIN(xb_ld(&bar[XB_XGEN(b.x)]) == gen, bar);
            __builtin_amdgcn_fence(__ATOMIC_ACQUIRE, "agent");
            asm volatile("s_waitcnt vmcnt(0)" ::: "memory");
        }
    }
    __syncthreads();
}

constexpr size_t MiB = 1u << 20;
constexpr size_t WS_SS = 0;
constexpr size_t WS_ROPE = 1 * MiB;
constexpr size_t WS_SP8 = WS_ROPE + 256 * 1024;
constexpr size_t WS_BAR = 1 * MiB + 512 * 1024;
constexpr size_t WS_WIN = 2 * MiB;
constexpr size_t WS_WQB = 9 * MiB;
constexpr size_t WS_WKVB = WS_WQB + 512 * 1024;
constexpr size_t WS_WG = 10 * MiB;
constexpr size_t WS_WOA = 11 * MiB;
constexpr size_t WS_WOL = 12 * MiB;
constexpr size_t WS_WOUT = 13 * MiB;
constexpr size_t WS_WGU = 15 * MiB;
constexpr size_t WS_WD = 26 * MiB;
constexpr size_t WS_A = 40 * MiB;
constexpr size_t WS_GATES = 168 * MiB;
constexpr size_t WS_LY = 424 * MiB;
constexpr size_t WS_LX = 488 * MiB;
constexpr size_t WS_QA = 552 * MiB;
constexpr size_t WS_KVA = 584 * MiB;
constexpr size_t WS_KN = 616 * MiB;
constexpr size_t WS_V = 680 * MiB;
constexpr size_t WS_KR = 744 * MiB;
constexpr size_t WS_XC = 748 * MiB;
constexpr size_t WS_X1B = 616 * MiB;
constexpr size_t WS_HID = 168 * MiB;
constexpr size_t WS_END = 812 * MiB;

struct Args { const float* in[22]; float* out; unsigned char* ws; int ph_lo, ph_hi; };

__global__ void __launch_bounds__(512, 2) mega_fwd(Args args) {
    extern __shared__ __attribute__((aligned(16))) unsigned char lds_raw[];
    LAS unsigned char* lds = (LAS unsigned char*)lds_raw;
    const int tid = threadIdx.x;
#define PHASE_IDS const int lane = threadIdx.x & 63, wave = __builtin_amdgcn_readfirstlane(threadIdx.x >> 6), gw = bid * 8 + wave, NGW = G * 8, gtid = bid * 512 + (int)threadIdx.x, NTH = G * 512; (void)lane; (void)gw; (void)NGW; (void)gtid; (void)NTH
    const int G = gridDim.x, bid = blockIdx.x;
    unsigned char* ws = args.ws;
    float* SSQ = (float*)(ws + WS_SS); float* SSKV = SSQ + T; float* SS2 = SSKV + T; float* SS3 = SS2 + T;
    float* ROPE = (float*)(ws + WS_ROPE); float* SP8 = (float*)(ws + WS_SP8);
    bf16_t* WIN = (bf16_t*)(ws + WS_WIN); bf16_t* WQB = (bf16_t*)(ws + WS_WQB); bf16_t* WKVB = (bf16_t*)(ws + WS_WKVB); bf16_t* WG = (bf16_t*)(ws + WS_WG);
    bf16_t* WOA = (bf16_t*)(ws + WS_WOA); bf16_t* WOL = (bf16_t*)(ws + WS_WOL); bf16_t* WOUT = (bf16_t*)(ws + WS_WOUT); bf16_t* WGU = (bf16_t*)(ws + WS_WGU); bf16_t* WD = (bf16_t*)(ws + WS_WD);
    bf16_t* XN = (bf16_t*)(ws + WS_A); bf16_t* Qb = (bf16_t*)(ws + WS_A); bf16_t* MERGED = (bf16_t*)(ws + WS_A);
    bf16_t* GATES = (bf16_t*)(ws + WS_GATES); bf16_t* LY = (bf16_t*)(ws + WS_LY); bf16_t* LX = (bf16_t*)(ws + WS_LX); bf16_t* ATT = (bf16_t*)(ws + WS_LX);
    bf16_t* QA = (bf16_t*)(ws + WS_QA); bf16_t* KVA = (bf16_t*)(ws + WS_KVA); bf16_t* REC = (bf16_t*)(ws + WS_QA);
    bf16_t* KN = (bf16_t*)(ws + WS_KN); bf16_t* Vb = (bf16_t*)(ws + WS_V); bf16_t* KR = (bf16_t*)(ws + WS_KR); bf16_t* XC = (bf16_t*)(ws + WS_XC);
    bf16_t* X1B = (bf16_t*)(ws + WS_X1B); bf16_t* HID = (bf16_t*)(ws + WS_HID);
    unsigned* AU = (unsigned*)args.out;
    const int lo = args.ph_lo, hi = args.ph_hi;
    volatile LAS unsigned* xst = (volatile LAS unsigned*)(lds + 140032);
    if (tid < 2) xst[tid] = 0u;
    __syncthreads();
    XcdBarrier xbar; xbar.bar = (unsigned*)(ws + WS_BAR); xbar.x = 0; xbar.st = xst;
    if (hi - lo > 1) xbar = xcd_barrier_post((unsigned*)(ws + WS_BAR), xst);
#define IN(k) (((PHASE_MASK >> (k)) & 1) && lo <= (k) && (k) < hi)
#if PROBE_MASK
    unsigned long long pr_acc = 0, pr_t0 = __builtin_amdgcn_s_memrealtime();
#define SEAM(k) do { if (IN(k) && IN((k) + 1)) { if ((k) == 0) cg::this_grid().sync(); else xcd_barrier(xbar); } { const unsigned long long t1_ = __builtin_amdgcn_s_memrealtime(); if ((PROBE_MASK >> (k)) & 1) pr_acc += t1_ - pr_t0; pr_t0 = t1_; } } while (0)
#else
#define SEAM(k) do { if (IN(k) && IN((k) + 1)) { if ((k) == 0) cg::this_grid().sync(); else xcd_barrier(xbar); } } while (0)
#endif

    if (IN(0)) { PHASE_IDS;
        for (int i = gtid; i < 4 * T; i += NTH) SSQ[i] = 0.f;
        for (int i = gtid; i < SEQ * 16; i += NTH) { const int pos = i >> 4, fi = i & 15; const float inv = 1.0f / powf(10000.0f, (float)fi * (1.0f / 16.0f)); const float ang = (float)pos * inv;
            float s, c; sincosf(ang, &s, &c); ROPE[pos * 32 + fi] = c; ROPE[pos * 32 + 16 + fi] = s; }
        for (int i = gtid; i < 1024; i += NTH) { const float lam = args.in[14][i]; SP8[i] = 8.0f * log1pf(expf(-lam)); }
        {
          const float* w_in = args.in[2]; const float* w_qb = args.in[4]; const float* g_q = args.in[3]; const float* w_kvb = args.in[6]; const float* g_kv = args.in[5];
          const float* wr_ = args.in[10]; const float* wi_ = args.in[12]; const float* w_oa = args.in[7]; const float* w_ol = args.in[15]; const float* w_o = args.in[16];
          const float* wg_ = args.in[18]; const float* wu_ = args.in[19]; const float* g2 = args.in[17]; const float* w_d = args.in[20];
          constexpr int I0 = (DIN_PAD / 64) * (1024 / 8), I1 = (768 / 64) * (256 / 8), I2 = (1024 / 64) * (128 / 8), I3 = (2048 / 64) * (128 / 8), I4 = (1024 / 64) * (512 / 8), I5 = I4,
                        I6 = (1024 / 64) * (1024 / 8), I7 = (2 * DFF / 64) * (1024 / 8), I8 = (1024 / 64) * (DFF / 8), ITOT = I0 + I1 + I2 + I3 + I4 + I5 + I6 + I7 + I8;
          auto do_item = [&](int gi) { int r = gi;
              if (r < I0) { xpose_one(WIN, DIN_PAD, 1024, [=](int n, int k) -> float { int src;
                  if (n < 384) src = n; else if (n < 416) { const int j = n - 384; src = 384 + (j & 1) * 16 + (j >> 1); } else if (n < 512) src = -1;
                  else if (n < 1024) src = 416 + (n - 512); else if (n < 1536) src = 928 + (n - 1024); else src = 1440 + (n - 1536);
                  return src < 0 ? 0.f : w_in[(size_t)k * DIN_SRC + src]; }, r, lane); return; } r -= I0;
              if (r < I1) { xpose_one(WQB, 768, 256, [=](int n, int k) -> float { const int h = n / 96, dp = n % 96; int d = dp; if (dp >= 64) { const int j = dp - 64; d = 64 + (j & 1) * 16 + (j >> 1); }
                  return w_qb[(size_t)k * 768 + h * 96 + d] * g_q[k]; }, r, lane); return; } r -= I1;
              if (r < I2) { xpose_one(WKVB, 1024, 128, [=](int n, int k) -> float { const int nn = n & 511, h = nn >> 6, d = nn & 63; return w_kvb[(size_t)k * 1024 + h * 128 + (n >> 9) * 64 + d] * g_kv[k]; }, r, lane); return; } r -= I2;
              if (r < I3) { xpose_one(WG, 2048, 128, [=](int n, int k) -> float { const int g = n >> 8, bj = (n >> 7) & 1, j = n & 127, blk = g >> 1, dir = g & 1;
                  return (bj ? wi_ : wr_)[((size_t)(dir * 4 + blk) * 128 + k) * 128 + j]; }, r, lane); return; } r -= I3;
              if (r < I4) { xpose_one(WOA, 1024, 512, [=](int n, int k) -> float { return w_oa[(size_t)k * 1024 + n]; }, r, lane); return; } r -= I4;
              if (r < I5) { xpose_one(WOL, 1024, 512, [=](int n, int k) -> float { return w_ol[(size_t)k * 1024 + n]; }, r, lane); return; } r -= I5;
              if (r < I6) { xpose_one(WOUT, 1024, 1024, [=](int n, int k) -> float { return w_o[(size_t)k * 1024 + n]; }, r, lane); return; } r -= I6;
              if (r < I7) { xpose_one(WGU, 2 * DFF, 1024, [=](int n, int k) -> float { const int pn = n >> 8, bj = (n >> 7) & 1, j = n & 127; return (bj ? wu_ : wg_)[(size_t)k * DFF + pn * 128 + j] * g2[k]; }, r, lane); return; } r -= I7;
              xpose_one(WD, 1024, DFF, [=](int n, int k) -> float { return w_d[(size_t)k * 1024 + n]; }, r, lane); };
          const float* x = args.in[0]; const float* g1 = args.in[1];
          f32x4 gv[4];
#pragma unroll
          for (int j = 0; j < 4; ++j) gv[j] = *((const f32x4*)g1 + lane + 64 * j);
          int gi = gw;
          for (int m = gw; m < T; m += 2 * NGW) { const int m2 = m + NGW; const bool two = m2 < T; const int mb = two ? m2 : m;
              const f32x4* xr = (const f32x4*)(x + (size_t)m * DM) + lane; const f32x4* xr2 = (const f32x4*)(x + (size_t)mb * DM) + lane; f32x4 v[4], v2[4]; float s = 0.f, s2 = 0.f;
#pragma unroll
              for (int j = 0; j < 4; ++j) { v[j] = __builtin_nontemporal_load(xr + 64 * j); v2[j] = __builtin_nontemporal_load(xr2 + 64 * j); }
              if (gi < ITOT) { do_item(gi); gi += NGW; }
#pragma unroll
              for (int j = 0; j < 4; ++j) { s += (v[j].x * v[j].x + v[j].y * v[j].y) + (v[j].z * v[j].z + v[j].w * v[j].w); s2 += (v2[j].x * v2[j].x + v2[j].y * v2[j].y) + (v2[j].z * v2[j].z + v2[j].w * v2[j].w); }
              const float rstd = rsqrtf(wave_sum(s) * (1.0f / DM) + EPS), rstd2 = rsqrtf(wave_sum(s2) * (1.0f / DM) + EPS);
              u32x2* o8 = (u32x2*)(XN + (size_t)m * DM) + lane; u32x2* o82 = (u32x2*)(XN + (size_t)mb * DM) + lane;
#pragma unroll
              for (int j = 0; j < 4; ++j) { const f32x4 y = v[j] * rstd * gv[j]; u32x2 w2; w2.x = cvt_pk_bf16(y.x, y.y); w2.y = cvt_pk_bf16(y.z, y.w); o8[64 * j] = w2; }
              if (two) {
#pragma unroll
                  for (int j = 0; j < 4; ++j) { const f32x4 y = v2[j] * rstd2 * gv[j]; u32x2 w2; w2.x = cvt_pk_bf16(y.x, y.y); w2.y = cvt_pk_bf16(y.z, y.w); o82[64 * j] = w2; } } }
          for (; gi < ITOT; gi += NGW) do_item(gi);
        }
    }
    SEAM(0);
    if (IN(1)) {
        pg8::Gemm g{XN, XN, WIN, WIN, 1024, 1024, 1024, 0, 0}; pg8::StaticOrder S; S.init(T, DIN_PAD, G, bid);
        EpiProj E{QA, KVA, KR, LX, LY, GATES, SSQ, SSKV, ROPE};
        pg8::gemm_phase<EpiProj, pg8::StaticOrder, true>(lds, g, S, E);
    }
    SEAM(1);
    if (IN(2)) { PHASE_IDS;
        if (P2SUB & 1) { const float* cw = args.in[8]; const float* cb = args.in[9]; const int c8 = (gtid & 63) * 8;
          float w[4][8], bias[8];
#pragma unroll
          for (int e = 0; e < 8; ++e) { bias[e] = cb[c8 + e];
#pragma unroll
              for (int j = 0; j < 4; ++j) w[j][e] = cw[j * 512 + c8 + e]; }
          const int rstride = NTH >> 6;
          for (int row = gtid >> 6; row < T; row += 2 * rstride) { const int rowb = (row + rstride < T) ? row + rstride : row;
              u32x4 xa[4], xb[4];
#pragma unroll
              for (int j = 0; j < 4; ++j) { const int ta = (row & (SEQ - 1)) - 2 + j, tb = (rowb & (SEQ - 1)) - 2 + j;
                  xa[j] = (ta >= 0 && ta < SEQ) ? *(const u32x4*)(LX + (size_t)(row - 2 + j) * 512 + c8) : (u32x4){0u, 0u, 0u, 0u};
                  xb[j] = (tb >= 0 && tb < SEQ) ? *(const u32x4*)(LX + (size_t)(rowb - 2 + j) * 512 + c8) : (u32x4){0u, 0u, 0u, 0u}; }
              float a[8], bq[8];
#pragma unroll
              for (int e = 0; e < 8; ++e) { a[e] = bias[e]; bq[e] = bias[e]; }
#pragma unroll
              for (int j = 0; j < 4; ++j) { f32x4 x0, x1, y0, y1; unpack8(xa[j], x0, x1); unpack8(xb[j], y0, y1);
#pragma unroll
                  for (int e = 0; e < 4; ++e) { a[e] += w[j][e] * x0[e]; a[4 + e] += w[j][4 + e] * x1[e]; bq[e] += w[j][e] * y0[e]; bq[4 + e] += w[j][4 + e] * y1[e]; } }
              u32x4 o; o.x = cvt_pk_bf16(a[0], a[1]); o.y = cvt_pk_bf16(a[2], a[3]); o.z = cvt_pk_bf16(a[4], a[5]); o.w = cvt_pk_bf16(a[6], a[7]);
              *(u32x4*)(XC + (size_t)row * 512 + c8) = o;
              if (rowb != row) { u32x4 o2; o2.x = cvt_pk_bf16(bq[0], bq[1]); o2.y = cvt_pk_bf16(bq[2], bq[3]); o2.z = cvt_pk_bf16(bq[4], bq[5]); o2.w = cvt_pk_bf16(bq[6], bq[7]);
                  *(u32x4*)(XC + (size_t)rowb * 512 + c8) = o2; } } }
        if (P2SUB & 2) { pg8::Gemm g{QA, QA, WQB, WQB, 256, 256, 256, 0, 0}; pg8::StaticOrder S; S.init(T, 768, G, bid); EpiQ E{Qb, SSQ, ROPE};
          pg8::gemm_phase<EpiQ, pg8::StaticOrder, true>(lds, g, S, E); }
        if (P2SUB & 4) { pg8::Gemm g{KVA, KVA, WKVB, WKVB, 128, 128, 128, 0, 0}; pg8::StaticOrder S; S.init(T, 1024, G, bid); EpiKV E{KN, Vb, SSKV};
          pg8::gemm_phase<EpiKV, pg8::StaticOrder, true>(lds, g, S, E); }
    }
    SEAM(2);
    if (IN(3)) {
        pg8::Gemm g{XC, XC, WG, WG, 512, 128, 128, 1, 128}; pg8::StaticOrder S; S.init(T, 2048, G, bid);
        EpiGates E{XC, AU, args.in[11], args.in[13], SP8};
        pg8::gemm_phase<EpiGates, pg8::StaticOrder, true>(lds, g, S, E);
    }
    SEAM(3);
    if (IN(4)) {
        __syncthreads();
        for (int it = bid; it < NBATCH * 8; it += G) scan_item(it >> 3, it & 7, AU, LY, REC, (float*)lds_raw);
        const int vcu = (G % 8 == 0) ? (bid % 8) * (G / 8) + bid / 8 : bid;
        for (int un = vcu; un < NBATCH * 8 * 8; un += G) { const int bh = un >> 3, qb = un & 7, b = bh >> 3, h = bh & 7; const size_t rb = (size_t)b * SEQ;
            att::attn_unit(Qb + (rb + qb * 256) * 768 + h * 96, KN + rb * 512 + h * 64, KR + rb * 32, Vb + rb * 512 + h * 64, ATT + (rb + qb * 256) * 512 + h * 64, (char*)lds_raw); }
    }
    SEAM(4);
    if (IN(5)) {
        pg8::Gemm g{ATT, REC, WOA, WOL, 512, 512, 512, 0, 0}; pg8::DualOrder S; S.S.init(T, 1024, G, bid);
        EpiMerge E{GATES, MERGED};
        pg8::gemm_phase<EpiMerge, pg8::DualOrder, true>(lds, g, S, E);
    }
    SEAM(5);
    if (IN(6)) {
        pg8::Gemm g{MERGED, MERGED, WOUT, WOUT, 1024, 1024, 1024, 0, 0}; pg8::StaticOrder S; S.init(T, 1024, G, bid);
        EpiOut E{args.in[0], X1B, SS2};
        pg8::gemm_phase<EpiOut, pg8::StaticOrder, true>(lds, g, S, E);
    }
    SEAM(6);
    if (IN(7)) {
        pg8::Gemm g{X1B, X1B, WGU, WGU, 1024, 1024, 1024, 0, 0}; pg8::StaticOrder S; S.init(T, 2 * DFF, G, bid);
        EpiFfn E{HID, SS2};
        pg8::gemm_phase<EpiFfn, pg8::StaticOrder, true>(lds, g, S, E);
    }
    SEAM(7);
    if (IN(8)) {
        pg8::Gemm g{HID, HID, WD, WD, DFF, DFF, DFF, 0, 0}; pg8::StaticOrder S; S.init(T, 1024, G, bid);
        EpiDown E{X1B, SS3};
        pg8::gemm_phase<EpiDown, pg8::StaticOrder, true>(lds, g, S, E);
    }
    SEAM(8);
    if (IN(9)) { PHASE_IDS;
        const float* gf = args.in[21]; f32x4 gv[4];
#pragma unroll
        for (int j = 0; j < 4; ++j) gv[j] = *((const f32x4*)gf + lane + 64 * j);
        for (int m = gw; m < T; m += NGW) { f32x4* xr = (f32x4*)(args.out + (size_t)m * DM) + lane; const u32x2* br_ = (const u32x2*)(X1B + (size_t)m * DM) + lane; const float rstd = rsqrtf(SS3[m] * (1.0f / DM) + EPS);
            u32x2 w2[4];
#pragma unroll
            for (int j = 0; j < 4; ++j) w2[j] = __builtin_nontemporal_load(br_ + 64 * j);
#pragma unroll
            for (int j = 0; j < 4; ++j) { const f32x4 v = (f32x4){bf_lo(w2[j].x), bf_hi(w2[j].x), bf_lo(w2[j].y), bf_hi(w2[j].y)}; __builtin_nontemporal_store(v * rstd * gv[j], xr + 64 * j); } }
    }
#if PROBE_MASK
    SEAM(9);
    if (bid == 0 && tid == 0) { const unsigned long long t0_ = __builtin_amdgcn_s_memrealtime(); while (__builtin_amdgcn_s_memrealtime() - t0_ < pr_acc) __builtin_amdgcn_s_sleep(8); }
#endif
#undef IN
#undef SEAM
}

constexpr int LDS_BYTES = 147456;
constexpr int N_PHASES = 10;
extern "C" void kernel_launch(void* const* d_in, const int* in_sizes, int n_in, void* d_out, int out_size, void* d_ws, size_t ws_size, hipStream_t stream) {
    static int grid = 0;
    if (grid == 0) {
        if (n_in != 22 || out_size != T * DM || ws_size < WS_END) { fprintf(stderr, "kernel_launch: unexpected shapes n_in %d out %d ws %zu\n", n_in, out_size, ws_size); grid = -1; return; }
        int dev = 0, cus = 0, per_cu = 0;
        hipGetDevice(&dev); hipDeviceGetAttribute(&cus, hipDeviceAttributeMultiprocessorCount, dev);
        if (hipFuncSetAttribute((const void*)mega_fwd, hipFuncAttributeMaxDynamicSharedMemorySize, LDS_BYTES) != hipSuccess) { fprintf(stderr, "kernel_launch: hipFuncSetAttribute failed\n"); grid = -1; return; }
        if (hipOccupancyMaxActiveBlocksPerMultiprocessor(&per_cu, (const void*)mega_fwd, 512, LDS_BYTES) != hipSuccess || per_cu < 1) { fprintf(stderr, "kernel_launch: occupancy query gives %d\n", per_cu); per_cu = 1; }
        (void)hipGetLastError();
        grid = cus * (per_cu > 1 ? 1 : per_cu);
        if (grid > 256) grid = 256;
    }
    if (grid < 0) return;
    Args a{};
    for (int i = 0; i < 22; ++i) a.in[i] = (const float*)d_in[i];
    a.out = (float*)d_out; a.ws = (unsigned char*)d_ws;
#if MK_SINGLE
    if (hipMemsetAsync((char*)d_ws + WS_BAR, 0, 16384, stream) != hipSuccess) { fprintf(stderr, "kernel_launch: memset failed\n"); return; }
    a.ph_lo = 0; a.ph_hi = N_PHASES;
    void* kargs[] = {&a};
    hipError_t e = hipLaunchCooperativeKernel((const void*)mega_fwd, dim3(grid), dim3(512), kargs, LDS_BYTES, stream);
    if (e != hipSuccess) fprintf(stderr, "cooperative launch failed: %s (grid %d)\n", hipGetErrorString(e), grid);
#else
    for (int p = 0; p < N_PHASES; ++p) { a.ph_lo = p; a.ph_hi = p + 1; hipLaunchKernelGGL(mega_fwd, dim3(grid), dim3(512), LDS_BYTES, stream, a); }
#endif
}
```

```cpp
#include <hip/hip_runtime.h>
#include <hip/hip_cooperative_groups.h>
#include <hip/hip_bf16.h>
#include <hip/hip_fp16.h>
#include <cstdio>
#include <cstdint>
namespace cg = cooperative_groups;

#ifndef PHASE_MASK
#define PHASE_MASK 0x3ff
#endif
#ifndef P2SUB
#define P2SUB 7
#endif
#ifndef PROBE_MASK
#define PROBE_MASK 0
#endif
#ifndef MK_SINGLE
#define MK_SINGLE 1
#endif

constexpr int T = 65536, DM = 1024, SEQ = 2048, NBATCH = 32;
constexpr int DIN_SRC = 3488, DIN_PAD = 3584, DFF = 2816;
constexpr float EPS = 1e-6f;
constexpr float LOG2E = 1.4426950408889634f;

typedef unsigned short bf16_t;
typedef short bf16x8 __attribute__((ext_vector_type(8)));
typedef short s16x4 __attribute__((ext_vector_type(4)));
typedef float f32x4 __attribute__((ext_vector_type(4)));
typedef float f32x2 __attribute__((ext_vector_type(2)));
typedef float f32x16 __attribute__((ext_vector_type(16)));
typedef unsigned u32x4 __attribute__((ext_vector_type(4)));
typedef unsigned u32x2 __attribute__((ext_vector_type(2)));
#define LAS __attribute__((address_space(3)))

__device__ __forceinline__ unsigned cvt_pk_bf16(float lo, float hi) { unsigned r; asm volatile("v_cvt_pk_bf16_f32 %0, %1, %2" : "=v"(r) : "v"(lo), "v"(hi)); return r; }
__device__ __forceinline__ float bf_lo(unsigned w) { return __uint_as_float(w << 16); }
__device__ __forceinline__ float bf_hi(unsigned w) { return __uint_as_float(w & 0xffff0000u); }
__device__ __forceinline__ float fsigmoid(float x) { return __builtin_amdgcn_rcpf(1.0f + __builtin_amdgcn_exp2f(-x * LOG2E)); }
__device__ __forceinline__ u32x4 pack8(f32x4 a, f32x4 b) { u32x4 w; w.x = cvt_pk_bf16(a[0], a[1]); w.y = cvt_pk_bf16(a[2], a[3]); w.z = cvt_pk_bf16(b[0], b[1]); w.w = cvt_pk_bf16(b[2], b[3]); return w; }
__device__ __forceinline__ void unpack8(u32x4 w, f32x4& a, f32x4& b) { a = (f32x4){bf_lo(w.x), bf_hi(w.x), bf_lo(w.y), bf_hi(w.y)}; b = (f32x4){bf_lo(w.z), bf_hi(w.z), bf_lo(w.w), bf_hi(w.w)}; }
__device__ __forceinline__ float wave_sum(float v) {
#pragma unroll
    for (int o = 1; o < 64; o <<= 1) v += __shfl_xor(v, o);
    return v;
}

namespace pg8 {
constexpr int BM = 256, BK = 64, HALF = 128, HTB = HALF * BK * 2, STAGE_BYTES = 8 * HTB, NXCD = 8, WGM = 8;
__host__ __device__ __forceinline__ int lds_byte(int r, int c) { const int st = (r >> 4) * 2 + (c >> 5), rr = r & 15, cc = c & 31, ob = rr * 64 + cc * 2; return st * 1024 + (ob ^ (((ob >> 9) & 1) << 5)); }
__host__ __device__ __forceinline__ void stage_rc(int b, int& R, int& C) { const int st = b / 1024, sb = b % 1024, swz = sb ^ (((sb >> 9) & 1) << 5); R = (st >> 1) * 16 + swz / 64; C = (st & 1) * 32 + (swz % 64) / 2; }
__host__ __device__ __forceinline__ int perm32(int rho) { const int n = rho >> 4, i = rho & 15; return 8 * (i >> 2) + 4 * n + (i & 3); }

struct Unit { int pm, pn, sel; };
struct Gemm {
    const bf16_t *A0, *A1, *B0, *B1; int lda, ldb, K; int a_grp_shift, a_grp_cols;
    __device__ __forceinline__ const char* a_ptr(const Unit& u) const { return (const char*)(u.sel ? A1 : A0) + ((size_t)u.pm * BM * lda + (size_t)(u.pn >> a_grp_shift) * a_grp_cols) * 2; }
    __device__ __forceinline__ const char* b_ptr(const Unit& u) const { return (const char*)(u.sel ? B1 : B0) + (size_t)u.pn * BM * ldb * 2; }
};

struct StaticOrder {
    int nM, nN, nwg, G, c;
    __device__ void init(int M, int N, int G_, int c_) { nM = M / BM; nN = N / BM; nwg = nM * nN; G = G_; c = c_; }
    __device__ bool next(int i, Unit& u) const {
        const long L = (long)i * G + c; if (L >= nwg) return false;
        int wgid = (int)L; { const int q = nwg / NXCD, r = nwg % NXCD, xcd = wgid % NXCD, off = wgid / NXCD; wgid = (xcd < r ? xcd * (q + 1) : r * (q + 1) + (xcd - r) * q) + off; }
        const int nig = WGM * nN, gid = wgid / nig, fm = gid * WGM, gsz = (nM - fm) < WGM ? (nM - fm) : WGM;
        u.pm = fm + ((wgid % nig) % gsz); u.pn = (wgid % nig) / gsz; u.sel = 0; return true;
    }
};
struct DualOrder {
    StaticOrder S;
    __device__ bool next(int i, Unit& u) const { if (!S.next(i >> 1, u)) return false; u.sel = i & 1; return true; }
};

template <class Epi, class Sched, bool ALIGN_EPI>
__device__ __forceinline__ void gemm_phase(LAS unsigned char* lds, const Gemm g, const Sched& S, const Epi& E) {
    int tid = threadIdx.x; asm volatile("" : "+v"(tid) :: "memory");
    const int wid = __builtin_amdgcn_readfirstlane(tid >> 6), lane = tid & 63, wr = wid >> 2, wc = wid & 3, fr = lane & 15, fq = lane >> 4;
    int lda_ = g.lda, ldb_ = g.ldb, K = g.K; asm volatile("" : "+s"(lda_), "+s"(ldb_), "+s"(K) :: "memory");
    const int nt = K / BK;
    unsigned voffA[2], voffB[2];
#pragma unroll
    for (int i = 0; i < 2; ++i) { int R, C; stage_rc(tid * 16 + i * 8192, R, C); const int Rb = Epi::PERM ? ((R & ~31) + perm32(R & 31)) : R;
        voffA[i] = (unsigned)(R * lda_ + C) * 2u; voffB[i] = (unsigned)(Rb * ldb_ + C) * 2u; }
    const size_t kstep = (size_t)(BK * 2);
    const size_t hstepA = (size_t)HALF * lda_ * 2, hstepB = (size_t)HALF * ldb_ * 2;
    const unsigned ldsw = (unsigned)wid * 1024u;
    const int aoff = lds_byte(wr * 64 + fr, fq * 8), boff = lds_byte(wc * 32 + fr, fq * 8);
#define PG8_SA(b, h) (((b) * 2 + (h)) * HTB)
#define PG8_SB(b, h) ((4 + (b) * 2 + (h)) * HTB)
#define PG8_STAGE(bufoff, gbase, voff) do { _Pragma("unroll") for (int _i = 0; _i < 2; ++_i) \
        __builtin_amdgcn_global_load_lds((const unsigned*)((const char*)(gbase) + (voff)[_i]), (LAS unsigned*)(lds + (bufoff) + ldsw + _i * 8192), 16, 0, 0); } while (0)
#define PG8_LDA(dst, b, h) do { _Pragma("unroll") for (int m = 0; m < 4; ++m) _Pragma("unroll") for (int k = 0; k < 2; ++k) dst[m][k] = *(const LAS bf16x8*)(lds + PG8_SA(b, h) + aoff + m * 2048 + k * 1024); } while (0)
#define PG8_LDB(dst, b, h) do { _Pragma("unroll") for (int n = 0; n < 2; ++n) _Pragma("unroll") for (int k = 0; k < 2; ++k) dst[n][k] = *(const LAS bf16x8*)(lds + PG8_SB(b, h) + boff + n * 2048 + k * 1024); } while (0)
#define PG8_MMA(ai, bj, At, Bt) do { __builtin_amdgcn_s_setprio(1); _Pragma("unroll") for (int m = 0; m < 4; ++m) _Pragma("unroll") for (int n = 0; n < 2; ++n) _Pragma("unroll") for (int k = 0; k < 2; ++k) \
        acc[ai][bj][m][n] = __builtin_amdgcn_mfma_f32_16x16x32_bf16(Bt[n][k], At[m][k], acc[ai][bj][m][n], 0, 0, 0); __builtin_amdgcn_s_setprio(0); } while (0)
#define PG8_WAIT_V(n) asm volatile("s_waitcnt vmcnt(" #n ")" ::: "memory")
#define PG8_WAIT_L(n) asm volatile("s_waitcnt lgkmcnt(" #n ")" ::: "memory")
#define PG8_BAR __builtin_amdgcn_s_barrier()
#define PG8_SCHED __builtin_amdgcn_sched_barrier(0)
    Unit cur, nxt; int ui = 0;
    if (!S.next(0, cur)) return;
    f32x4 acc[2][2][4][2];
#pragma unroll
    for (int a = 0; a < 2; ++a)
#pragma unroll
        for (int b = 0; b < 2; ++b)
#pragma unroll
            for (int m = 0; m < 4; ++m)
#pragma unroll
                for (int n = 0; n < 2; ++n) acc[a][b][m][n] = (f32x4){0.f, 0.f, 0.f, 0.f};
    bf16x8 At[4][2], B0[2][2], B1[2][2];
    const char* cA = g.a_ptr(cur); const char* cB = g.b_ptr(cur);
    PG8_STAGE(PG8_SB(0, 0), cB, voffB); PG8_STAGE(PG8_SB(0, 1), cB + hstepB, voffB); PG8_STAGE(PG8_SA(0, 0), cA, voffA); PG8_STAGE(PG8_SA(0, 1), cA + hstepA, voffA);
    if (wr == 1) PG8_BAR;
    PG8_WAIT_V(2); PG8_BAR;
    PG8_STAGE(PG8_SB(1, 0), cB + kstep, voffB); PG8_STAGE(PG8_SA(1, 0), cA + kstep, voffA); PG8_STAGE(PG8_SB(1, 1), cB + hstepB + kstep, voffB);
    PG8_WAIT_V(6); PG8_BAR;
    for (;;) {
        const bool has_next = S.next(ui + 1, nxt);
        const char* nA = has_next ? g.a_ptr(nxt) : cA; const char* nB = has_next ? g.b_ptr(nxt) : cB;
        for (int t = 0; t < nt; t += 2) {
            const bool last = (t == nt - 2);
            const char* a1 = cA + (size_t)(t + 1) * kstep;
            const char* a2 = last ? nA : cA + (size_t)(t + 2) * kstep; const char* b2 = last ? nB : cB + (size_t)(t + 2) * kstep;
            const char* a3 = a2 + kstep; const char* b3 = b2 + kstep;
            PG8_LDB(B0, 0, 0); PG8_LDB(B1, 0, 1); PG8_SCHED; PG8_LDA(At, 0, 0); PG8_STAGE(PG8_SA(1, 1), a1 + hstepA, voffA);
            PG8_WAIT_V(8); PG8_WAIT_L(0); PG8_BAR; PG8_MMA(0, 0, At, B0); PG8_MMA(0, 1, At, B1); PG8_BAR; PG8_SCHED;
            PG8_LDA(At, 0, 1); PG8_STAGE(PG8_SB(0, 0), b2, voffB); PG8_STAGE(PG8_SB(0, 1), b2 + hstepB, voffB); PG8_STAGE(PG8_SA(0, 0), a2, voffA);
            PG8_WAIT_V(8); PG8_WAIT_L(0); PG8_BAR; PG8_MMA(1, 0, At, B0); PG8_MMA(1, 1, At, B1); PG8_BAR; PG8_SCHED;
            PG8_LDB(B0, 1, 0); PG8_LDB(B1, 1, 1); PG8_SCHED; PG8_LDA(At, 1, 0); PG8_STAGE(PG8_SA(0, 1), a2 + hstepA, voffA);
            PG8_WAIT_V(8); PG8_WAIT_L(0); PG8_BAR; PG8_MMA(0, 0, At, B0); PG8_MMA(0, 1, At, B1); PG8_BAR; PG8_SCHED;
            PG8_LDA(At, 1, 1); PG8_STAGE(PG8_SB(1, 0), b3, voffB); PG8_STAGE(PG8_SB(1, 1), b3 + hstepB, voffB); PG8_STAGE(PG8_SA(1, 0), a3, voffA);
            PG8_WAIT_V(8); PG8_WAIT_L(0); PG8_BAR; PG8_MMA(1, 0, At, B0); PG8_MMA(1, 1, At, B1); PG8_BAR; PG8_SCHED;
        }
        if constexpr (ALIGN_EPI) { if (wr == 0) PG8_BAR; }
        PG8_SCHED; E(acc, cur, wr, wc, fr, fq); PG8_SCHED;
        if (!has_next) break;
        bool keep_ = false; if constexpr (Epi::DUAL) keep_ = (cur.sel == 0);
        if (!keep_)
#pragma unroll
        for (int a = 0; a < 2; ++a)
#pragma unroll
            for (int b = 0; b < 2; ++b)
#pragma unroll
                for (int m = 0; m < 4; ++m)
#pragma unroll
                    for (int n = 0; n < 2; ++n) acc[a][b][m][n] = (f32x4){0.f, 0.f, 0.f, 0.f};
        cur = nxt; cA = nA; cB = nB; ++ui;
        if constexpr (ALIGN_EPI) { if (wr == 1) PG8_BAR; }
    }
    PG8_WAIT_V(0);
    if constexpr (!ALIGN_EPI) { if (wr == 0) PG8_BAR; }
    PG8_BAR;
#undef PG8_SA
#undef PG8_SB
#undef PG8_STAGE
#undef PG8_LDA
#undef PG8_LDB
#undef PG8_MMA
#undef PG8_WAIT_V
#undef PG8_WAIT_L
#undef PG8_BAR
#undef PG8_SCHED
}
}
using pg8::Unit;
typedef f32x4 Acc[2][2][4][2];


#ifndef ST_AUX
#define ST_AUX 2
#endif
#define ST16(BASE, OFF, VAL) __builtin_amdgcn_raw_buffer_store_b128((VAL), __builtin_amdgcn_make_buffer_rsrc((void*)(BASE), (short)0, 0x7ffffff0, 0x00020000), (int)((unsigned)(OFF) * (unsigned)sizeof(*(BASE))), 0, ST_AUX)
__device__ __forceinline__ void rope4(f32x4& v0, f32x4& v1, const float* rp, int i0) {
    const f32x4 c = *(const f32x4*)(rp + i0), s = *(const f32x4*)(rp + 16 + i0);
    const f32x4 a = v0, b = v1;
    v0[0] = a[0] * c[0] - a[1] * s[0]; v0[1] = a[1] * c[0] + a[0] * s[0];
    v0[2] = a[2] * c[1] - a[3] * s[1]; v0[3] = a[3] * c[1] + a[2] * s[1];
    v1[0] = b[0] * c[2] - b[1] * s[2]; v1[1] = b[1] * c[2] + b[0] * s[2];
    v1[2] = b[2] * c[3] - b[3] * s[3]; v1[3] = b[3] * c[3] + b[2] * s[3];
}
__device__ __forceinline__ float gelu_tanh(float y) { const float z = 0.7978845608028654f * (y + 0.044715f * y * y * y); return y * fsigmoid(2.0f * z); }

struct EpiProj {
    static constexpr bool PERM = true, DUAL = false;
    bf16_t *QA, *KVA, *KR, *LX, *LY, *GATES; float *SSQ, *SSKV; const float* rope;
    __device__ __forceinline__ void operator()(const Acc& acc, const Unit& u, int wr, int wc, int fr, int fq) const {
        const int pn = u.pn, rowt = u.pm * 256 + wr * 64 + fr, cw = wc * 32 + 8 * fq;
        if (pn >= 2) {
            bf16_t* base; int ld, mode;
            if (pn >= 6) { base = GATES + (pn - 6) * 256; ld = 2048; mode = 2; } else if (pn >= 4) { base = LY + (pn - 4) * 256; ld = 512; mode = 1; } else { base = LX + (pn - 2) * 256; ld = 512; mode = 0; }
#pragma unroll
            for (int ai = 0; ai < 2; ++ai)
#pragma unroll
                for (int m = 0; m < 4; ++m) { const unsigned row = rowt + ai * 128 + m * 16;
#pragma unroll
                    for (int bj = 0; bj < 2; ++bj) { f32x4 v0 = acc[ai][bj][m][0], v1 = acc[ai][bj][m][1];
                        if (mode == 2) {
#pragma unroll
                            for (int e = 0; e < 4; ++e) { v0[e] = fsigmoid(v0[e]); v1[e] = fsigmoid(v1[e]); } }
                        else if (mode == 1) {
#pragma unroll
                            for (int e = 0; e < 4; ++e) { v0[e] = gelu_tanh(v0[e]); v1[e] = gelu_tanh(v1[e]); } }
                        ST16(base, row * ld + bj * 128 + cw, pack8(v0, v1)); } }
        } else if (pn == 0) {
#pragma unroll
            for (int ai = 0; ai < 2; ++ai)
#pragma unroll
                for (int m = 0; m < 4; ++m) { const unsigned row = rowt + ai * 128 + m * 16; float ss = 0.f;
#pragma unroll
                    for (int bj = 0; bj < 2; ++bj) { const f32x4 v0 = acc[ai][bj][m][0], v1 = acc[ai][bj][m][1];
                        ss += (v0[0] * v0[0] + v0[1] * v0[1]) + (v0[2] * v0[2] + v0[3] * v0[3]) + (v1[0] * v1[0] + v1[1] * v1[1]) + (v1[2] * v1[2] + v1[3] * v1[3]);
                        ST16(QA, row * 256 + bj * 128 + cw, pack8(v0, v1)); }
                    ss += __shfl_xor(ss, 16); ss += __shfl_xor(ss, 32);
                    if (fq == 0) atomicAdd(SSQ + row, ss); }
        } else {
#pragma unroll
            for (int ai = 0; ai < 2; ++ai)
#pragma unroll
                for (int m = 0; m < 4; ++m) { const unsigned row = rowt + ai * 128 + m * 16;
                    { const f32x4 v0 = acc[ai][0][m][0], v1 = acc[ai][0][m][1];
                      float ss = (v0[0] * v0[0] + v0[1] * v0[1]) + (v0[2] * v0[2] + v0[3] * v0[3]) + (v1[0] * v1[0] + v1[1] * v1[1]) + (v1[2] * v1[2] + v1[3] * v1[3]);
                      ST16(KVA, row * 128 + cw, pack8(v0, v1));
                      ss += __shfl_xor(ss, 16); ss += __shfl_xor(ss, 32);
                      if (fq == 0) atomicAdd(SSKV + row, ss); }
                    if (wc == 0) { f32x4 v0 = acc[ai][1][m][0], v1 = acc[ai][1][m][1];
                      rope4(v0, v1, rope + (row & (SEQ - 1)) * 32, 4 * fq);
                      ST16(KR, row * 32 + 8 * fq, pack8(v0, v1)); } }
        }
    }
};

constexpr float QSCALE = 0.10206207261596577f * 1.4426950408889634f;
struct EpiQ {
    static constexpr bool PERM = true, DUAL = false;
    bf16_t* Q; const float* SSQ; const float* rope;
    __device__ __forceinline__ void operator()(const Acc& acc, const Unit& u, int wr, int wc, int fr, int fq) const {
        const int rowt = u.pm * 256 + wr * 64 + fr;
        const int c00 = u.pn * 256 + wc * 32 + 8 * fq, c01 = c00 + 128, d0 = c00 % 96, d1 = c01 % 96;
#pragma unroll
        for (int am = 0; am < 4; ++am) { const int ai = am >> 1, mb = (am & 1) * 2;
            f32x4 cs[2][2][2]; float ss[2];
#pragma unroll
            for (int mm = 0; mm < 2; ++mm) ss[mm] = SSQ[(unsigned)(rowt + ai * 128 + (mb + mm) * 16)];
#pragma unroll
            for (int mm = 0; mm < 2; ++mm) { const unsigned pos = (unsigned)(rowt + ai * 128 + (mb + mm) * 16) & (SEQ - 1);
#pragma unroll
                for (int bj = 0; bj < 2; ++bj) { const int d = bj ? d1 : d0; if (d >= 64) { const float* rp = rope + (pos * 32 + ((d - 64) >> 1)); cs[mm][bj][0] = *(const f32x4*)rp; cs[mm][bj][1] = *(const f32x4*)(rp + 16); }
                    else { cs[mm][bj][0] = (f32x4){1.f, 1.f, 1.f, 1.f}; cs[mm][bj][1] = (f32x4){0.f, 0.f, 0.f, 0.f}; } } }
#pragma unroll
            for (int mm = 0; mm < 2; ++mm) { const int m = mb + mm; const unsigned row = rowt + ai * 128 + m * 16; const float rstd = rsqrtf(ss[mm] * (1.0f / 256.0f) + EPS) * QSCALE;
#pragma unroll
                for (int bj = 0; bj < 2; ++bj) { const int c0 = bj ? c01 : c00;
                    const f32x4 a = acc[ai][bj][m][0] * rstd, b = acc[ai][bj][m][1] * rstd, c = cs[mm][bj][0], sn = cs[mm][bj][1]; f32x4 v0, v1;
                    v0[0] = a[0] * c[0] - a[1] * sn[0]; v0[1] = a[1] * c[0] + a[0] * sn[0]; v0[2] = a[2] * c[1] - a[3] * sn[1]; v0[3] = a[3] * c[1] + a[2] * sn[1];
                    v1[0] = b[0] * c[2] - b[1] * sn[2]; v1[1] = b[1] * c[2] + b[0] * sn[2]; v1[2] = b[2] * c[3] - b[3] * sn[3]; v1[3] = b[3] * c[3] + b[2] * sn[3];
                    if ((bj ? d1 : d0) < 64) { v0 = a; v1 = b; }
                    ST16(Q, (row * 768 + c0), pack8(v0, v1)); } }
            asm volatile("" ::: "memory"); }
    }
};

struct EpiKV {
    static constexpr bool PERM = true, DUAL = false;
    bf16_t *KN, *V; const float* SSKV;
    __device__ __forceinline__ void operator()(const Acc& acc, const Unit& u, int wr, int wc, int fr, int fq) const {
        const int rowt = u.pm * 256 + wr * 64 + fr; bf16_t* base = (u.pn < 2 ? KN : V) + (u.pn & 1) * 256; const unsigned cw = wc * 32 + 8 * fq;
        float ss[8];
#pragma unroll
        for (int i = 0; i < 8; ++i) ss[i] = SSKV[(unsigned)(rowt + (i >> 2) * 128 + (i & 3) * 16)];
#pragma unroll
        for (int ai = 0; ai < 2; ++ai)
#pragma unroll
            for (int m = 0; m < 4; ++m) { const unsigned row = rowt + ai * 128 + m * 16; const float rstd = rsqrtf(ss[ai * 4 + m] * (1.0f / 128.0f) + EPS);
#pragma unroll
                for (int bj = 0; bj < 2; ++bj) ST16(base, (row * 512 + bj * 128 + cw), pack8(acc[ai][bj][m][0] * rstd, acc[ai][bj][m][1] * rstd)); }
    }
};

__device__ __forceinline__ unsigned pack_h2(float lo, float hi) { const __half2 h = __floats2half2_rn(lo, hi); return *(const unsigned*)&h; }
struct EpiGates {
    static constexpr bool PERM = true, DUAL = false;
    const bf16_t* XC; unsigned* AU; const float *br, *bi, *sp8;
    __device__ __forceinline__ void operator()(const Acc& acc, const Unit& u, int wr, int wc, int fr, int fq) const {
        const int blk = u.pn >> 1, dir = u.pn & 1, rowt = u.pm * 256 + wr * 64 + fr, j0 = wc * 32 + 8 * fq, ch = blk * 128 + j0;
        const float* pbr = br + (dir * 4 + blk) * 128; const float* pbi = bi + (dir * 4 + blk) * 128; const float* psp = sp8 + dir * 512 + blk * 128;
        u32x4 xw[8];
#pragma unroll
        for (int i = 0; i < 8; ++i) xw[i] = *(const u32x4*)(XC + (unsigned)((rowt + (i >> 2) * 128 + (i & 3) * 16) * 512 + ch));
        f32x4 cbr[2], cbi[2], csp[2];
#pragma unroll
        for (int h = 0; h < 2; ++h) { cbr[h] = *(const f32x4*)(pbr + (unsigned)(j0 + 4 * h)); cbi[h] = *(const f32x4*)(pbi + (unsigned)(j0 + 4 * h)); csp[h] = *(const f32x4*)(psp + (unsigned)(j0 + 4 * h)); }
        unsigned* dst = AU + (size_t)dir * T * 512;
#pragma unroll
        for (int ai = 0; ai < 2; ++ai)
#pragma unroll
            for (int m = 0; m < 4; ++m) { const unsigned row = rowt + ai * 128 + m * 16;
                f32x4 x0, x1; unpack8(xw[ai * 4 + m], x0, x1);
                u32x4 o0, o1;
#pragma unroll
                for (int h = 0; h < 2; ++h) { const f32x4 ar = acc[ai][0][m][h] + cbr[h], aiq = acc[ai][1][m][h] + cbi[h], sp = csp[h], xx = h ? x1 : x0; u32x4 o;
#pragma unroll
                    for (int e = 0; e < 4; ++e) { const float rr = fsigmoid(ar[e]), ii = fsigmoid(aiq[e]); const float la = -rr * sp[e], y = 2.0f * la;
                        float m2 = -y * (1.0f + y * (0.5f + y * (0.16666667f + y * (0.041666668f + y * 0.0083333338f))));
                        if (__builtin_expect(__any(y < -0.25f), 0)) m2 = (y < -0.25f) ? 1.0f - __builtin_amdgcn_exp2f(y * LOG2E) : m2;
                        const float uu = ii * xx[e] * __builtin_amdgcn_sqrtf(m2); o[e] = pack_h2(la * LOG2E, uu); }
                    if (h) o1 = o; else o0 = o; }
                ST16(dst, (row * 512 + ch), o0); ST16(dst, (row * 512 + ch + 4), o1); }
    }
};

struct EpiMerge {
    static constexpr bool PERM = true, DUAL = true;
    const bf16_t* GATES; bf16_t* MERGED;
    __device__ __forceinline__ void operator()(Acc& acc, const Unit& u, int wr, int wc, int fr, int fq) const {
        const int rowt = u.pm * 256 + wr * 64 + fr, c0 = u.pn * 256 + wc * 32 + 8 * fq;
#pragma unroll
        for (int ai = 0; ai < 2; ++ai) {
            u32x4 gw_[4][2], hw_[4][2];
#pragma unroll
            for (int m = 0; m < 4; ++m)
#pragma unroll
                for (int bj = 0; bj < 2; ++bj) { const unsigned o = (unsigned)((rowt + ai * 128 + m * 16) * 2048 + c0 + bj * 128);
                    gw_[m][bj] = *(const u32x4*)(GATES + (o + 1024)); if (u.sel == 0) hw_[m][bj] = *(const u32x4*)(GATES + o); else hw_[m][bj] = gw_[m][bj]; }
#pragma unroll
            for (int m = 0; m < 4; ++m) { const unsigned row = rowt + ai * 128 + m * 16;
#pragma unroll
                for (int bj = 0; bj < 2; ++bj) { f32x4 r0, r1, a0, a1; unpack8(gw_[m][bj], r0, r1); unpack8(hw_[m][bj], a0, a1);
                    if (u.sel == 0) {
#pragma unroll
                        for (int e = 0; e < 4; ++e) { acc[ai][bj][m][0][e] *= a0[e] * __builtin_amdgcn_rcpf(r0[e]); acc[ai][bj][m][1][e] *= a1[e] * __builtin_amdgcn_rcpf(r1[e]); } }
                    else { ST16(MERGED, (row * 1024 + c0 + bj * 128), pack8(acc[ai][bj][m][0] * r0, acc[ai][bj][m][1] * r1)); } } }
            asm volatile("" ::: "memory"); }
    }
};

struct EpiOut {
    static constexpr bool PERM = true, DUAL = false;
    const float* X; bf16_t* X1B; float* SS2;
    __device__ __forceinline__ void operator()(const Acc& acc, const Unit& u, int wr, int wc, int fr, int fq) const {
        const int rowt = u.pm * 256 + wr * 64 + fr, c0 = u.pn * 256 + wc * 32 + 8 * fq;
#pragma unroll
        for (int ai = 0; ai < 2; ++ai) {
            f32x4 xv[4][2][2];
#pragma unroll
            for (int m = 0; m < 4; ++m)
#pragma unroll
                for (int bj = 0; bj < 2; ++bj) { const unsigned o = (rowt + ai * 128 + m * 16) * 1024 + c0 + bj * 128; xv[m][bj][0] = __builtin_nontemporal_load((const f32x4*)(X + o)); xv[m][bj][1] = __builtin_nontemporal_load((const f32x4*)(X + (o + 4))); }
#pragma unroll
            for (int m = 0; m < 4; ++m) { const unsigned row = rowt + ai * 128 + m * 16; float ss = 0.f;
#pragma unroll
                for (int bj = 0; bj < 2; ++bj) { const unsigned o = row * 1024 + c0 + bj * 128;
                    const f32x4 v0 = acc[ai][bj][m][0] + xv[m][bj][0], v1 = acc[ai][bj][m][1] + xv[m][bj][1];
                    ss += (v0[0] * v0[0] + v0[1] * v0[1]) + (v0[2] * v0[2] + v0[3] * v0[3]) + (v1[0] * v1[0] + v1[1] * v1[1]) + (v1[2] * v1[2] + v1[3] * v1[3]);
                    ST16(X1B, o, pack8(v0, v1)); }
                ss += __shfl_xor(ss, 16); ss += __shfl_xor(ss, 32);
                if (fq == 0) atomicAdd(SS2 + row, ss); }
            asm volatile("" ::: "memory"); }
    }
};

struct EpiFfn {
    static constexpr bool PERM = true, DUAL = false;
    bf16_t* HID; const float* SS2;
    __device__ __forceinline__ void operator()(const Acc& acc, const Unit& u, int wr, int wc, int fr, int fq) const {
        const int rowt = u.pm * 256 + wr * 64 + fr, c0 = u.pn * 128 + wc * 32 + 8 * fq;
        float ss[8];
#pragma unroll
        for (int i = 0; i < 8; ++i) ss[i] = SS2[(unsigned)(rowt + (i >> 2) * 128 + (i & 3) * 16)];
#pragma unroll
        for (int ai = 0; ai < 2; ++ai)
#pragma unroll
            for (int m = 0; m < 4; ++m) { const unsigned row = rowt + ai * 128 + m * 16; const float rstd = rsqrtf(ss[ai * 4 + m] * (1.0f / 1024.0f) + EPS);
                f32x4 h0, h1;
#pragma unroll
                for (int e = 0; e < 4; ++e) { const float g0 = acc[ai][0][m][0][e] * rstd, g1 = acc[ai][0][m][1][e] * rstd;
                    h0[e] = g0 * fsigmoid(g0) * (acc[ai][1][m][0][e] * rstd); h1[e] = g1 * fsigmoid(g1) * (acc[ai][1][m][1][e] * rstd); }
                ST16(HID, (row * DFF + c0), pack8(h0, h1)); }
    }
};

struct EpiDown {
    static constexpr bool PERM = true, DUAL = false;
    bf16_t* X1B; float* SS3;
    __device__ __forceinline__ void operator()(const Acc& acc, const Unit& u, int wr, int wc, int fr, int fq) const {
        const int rowt = u.pm * 256 + wr * 64 + fr, c0 = u.pn * 256 + wc * 32 + 8 * fq;
        u32x4 xv[8][2];
#pragma unroll
        for (int i = 0; i < 8; ++i)
#pragma unroll
            for (int bj = 0; bj < 2; ++bj) xv[i][bj] = *(const u32x4*)(X1B + (unsigned)((rowt + (i >> 2) * 128 + (i & 3) * 16) * 1024 + c0 + bj * 128));
#pragma unroll
        for (int ai = 0; ai < 2; ++ai)
#pragma unroll
            for (int m = 0; m < 4; ++m) { const unsigned row = rowt + ai * 128 + m * 16; float ss = 0.f;
#pragma unroll
                for (int bj = 0; bj < 2; ++bj) { const unsigned o = row * 1024 + c0 + bj * 128; f32x4 p0, p1; unpack8(xv[ai * 4 + m][bj], p0, p1);
                    const f32x4 v0 = acc[ai][bj][m][0] + p0, v1 = acc[ai][bj][m][1] + p1;
                    ss += (v0[0] * v0[0] + v0[1] * v0[1]) + (v0[2] * v0[2] + v0[3] * v0[3]) + (v1[0] * v1[0] + v1[1] * v1[1]) + (v1[2] * v1[2] + v1[3] * v1[3]);
                    ST16(X1B, o, pack8(v0, v1)); }
                ss += __shfl_xor(ss, 16); ss += __shfl_xor(ss, 32);
                if (fq == 0) atomicAdd(SS3 + row, ss); }
    }
};

namespace att {
constexpr int NW = 8, QBLK = 32, KVBLK = 64;
constexpr float SCALE = 0.10206207261596577f;
constexpr float THR = 8.f;
constexpr int SHM_V = 16384, SHM_K = 16384;
#define KSWZ(row, colB) ((row) * 256 + ((colB) ^ (((row) & 7) << 4)))
#define SBAR() __builtin_amdgcn_sched_barrier(0)
__device__ __forceinline__ int crow(int r, int hi) { return (r & 3) + 8 * (r >> 2) + 4 * hi; }
template <bool FIRST> __device__ __forceinline__ void partialSM(f32x16& p0, f32x16& p1, float& mref, f32x16& negm, float& alpha) {
  constexpr float THRL = THR * 1.4426950408889634f;
  float pmax = p0[0];
#pragma unroll
  for (int r = 1; r < 16; ++r) pmax = fmaxf(pmax, p0[r]);
#pragma unroll
  for (int r = 0; r < 16; ++r) pmax = fmaxf(pmax, p1[r]);
  { auto rr = __builtin_amdgcn_permlane32_swap(__float_as_uint(pmax), __float_as_uint(pmax), false, false);
    pmax = fmaxf(__uint_as_float(rr[0]), __uint_as_float(rr[1])); }
  if (!FIRST && __builtin_expect(__all(pmax <= THRL), 1)) { alpha = 1.f; }
  else { const float dl = FIRST ? pmax : fmaxf(pmax, 0.f); mref += dl; alpha = FIRST ? 1.f : __builtin_amdgcn_exp2f(-dl);
#pragma unroll
    for (int r = 0; r < 16; ++r) { p0[r] -= dl; p1[r] -= dl; }
    const float nm = -mref;
#pragma unroll
    for (int r = 0; r < 16; ++r) negm[r] = nm; }
#pragma unroll
  for (int r = 0; r < 16; ++r) p0[r] = __builtin_amdgcn_exp2f(p0[r]);
}
__device__ __forceinline__ void finishSM(f32x16& p0, f32x16& p1, float alpha, float& l_reg, bf16x8& pa0, bf16x8& pa1, bf16x8& pa2, bf16x8& pa3) {
#pragma unroll
  for (int r = 0; r < 16; ++r) p1[r] = __builtin_amdgcn_exp2f(p1[r]);
  float ps = 0;
#pragma unroll
  for (int r = 0; r < 16; ++r) ps += p0[r];
#pragma unroll
  for (int r = 0; r < 16; ++r) ps += p1[r];
  { auto rr = __builtin_amdgcn_permlane32_swap(__float_as_uint(ps), __float_as_uint(ps), false, false);
    ps = __uint_as_float(rr[0]) + __uint_as_float(rr[1]); }
  l_reg = l_reg * alpha + ps;
#define PK4(P, BASE, OUT) do { u32x4 w = {cvt_pk_bf16(P[BASE + 0], P[BASE + 1]), cvt_pk_bf16(P[BASE + 2], P[BASE + 3]), cvt_pk_bf16(P[BASE + 4], P[BASE + 5]), cvt_pk_bf16(P[BASE + 6], P[BASE + 7])}; \
    OUT = *reinterpret_cast<bf16x8*>(&w); } while (0)
  PK4(p0, 0, pa0); PK4(p0, 8, pa1); PK4(p1, 0, pa2); PK4(p1, 8, pa3);
#undef PK4
}
__device__ __forceinline__ void qkt(f32x16& p0, f32x16& p1, const char* Ks, const bf16x8* qr, const f32x16& negm, int r32, int hi) {
  p0 = negm; p1 = negm;
#pragma unroll
  for (int d0 = 0; d0 < 6; ++d0) { int cb = (d0 * 16 + hi * 8) * 2;
    bf16x8 b0 = *reinterpret_cast<const bf16x8*>(Ks + KSWZ(r32, cb));
    bf16x8 b1 = *reinterpret_cast<const bf16x8*>(Ks + KSWZ(32 + r32, cb));
    p0 = __builtin_amdgcn_mfma_f32_32x32x16_bf16(b0, qr[d0], p0, 0, 0, 0);
    p1 = __builtin_amdgcn_mfma_f32_32x32x16_bf16(b1, qr[d0], p1, 0, 0, 0); }
}
__device__ __forceinline__ int v_st(int k, int c) { const int kk = k; return ((kk >> 3) * 4 + (c >> 5)) * 512 + ((kk & 7) * 32 + (c & 31)) * 2; }
__device__ __forceinline__ int v_rd_base(int lane) { return ((lane & 3) << 3) | (((lane >> 2) & 3) << 6) | (((lane >> 4) & 1) << 5) | (((lane >> 5) & 1) << 8); }
constexpr int v_rd_off(int d0, int ks, int half) { return d0 * 512 + ks * 4096 + half * 2048; }
typedef short v4i16_t __attribute__((ext_vector_type(4)));
typedef LAS const char* lds_cptr;
__device__ __forceinline__ s16x4 vtr(lds_cptr p) { return __builtin_bit_cast(s16x4, __builtin_amdgcn_ds_read_tr16_b64_v4i16((LAS v4i16_t*)p)); }
template <int D0> __device__ __forceinline__ void pv_one(f32x16& od, lds_cptr vp, bf16x8 pa0, bf16x8 pa1, bf16x8 pa2, bf16x8 pa3) {
  const s16x4 l0 = vtr(vp + v_rd_off(D0, 0, 0)), h0 = vtr(vp + v_rd_off(D0, 0, 1)), l1 = vtr(vp + v_rd_off(D0, 1, 0)), h1 = vtr(vp + v_rd_off(D0, 1, 1));
  const s16x4 l2 = vtr(vp + v_rd_off(D0, 2, 0)), h2 = vtr(vp + v_rd_off(D0, 2, 1)), l3 = vtr(vp + v_rd_off(D0, 3, 0)), h3 = vtr(vp + v_rd_off(D0, 3, 1));
#define PK(L, H) (bf16x8){L[0], L[1], L[2], L[3], H[0], H[1], H[2], H[3]}
  od = __builtin_amdgcn_mfma_f32_32x32x16_bf16(pa0, PK(l0, h0), od, 0, 0, 0);
  od = __builtin_amdgcn_mfma_f32_32x32x16_bf16(pa1, PK(l1, h1), od, 0, 0, 0);
  od = __builtin_amdgcn_mfma_f32_32x32x16_bf16(pa2, PK(l2, h2), od, 0, 0, 0);
  od = __builtin_amdgcn_mfma_f32_32x32x16_bf16(pa3, PK(l3, h3), od, 0, 0, 0);
#undef PK
}
__device__ __forceinline__ void pv_d0(f32x16* o, lds_cptr vp, bf16x8 pa0, bf16x8 pa1, bf16x8 pa2, bf16x8 pa3) {
  pv_one<0>(o[0], vp, pa0, pa1, pa2, pa3); pv_one<1>(o[1], vp, pa0, pa1, pa2, pa3);
}
__device__ __forceinline__ void attn_unit(const bf16_t* __restrict__ Qb, const bf16_t* __restrict__ KNh, const bf16_t* __restrict__ KRb, const bf16_t* __restrict__ Vh, bf16_t* __restrict__ Ob, char* lds) {
  const int tid = threadIdx.x, wid = tid >> 6, lane = tid & 63, r32 = lane & 31, hi = lane >> 5;
#define ABAR() asm volatile("s_waitcnt lgkmcnt(0)\n\ts_barrier" ::: "memory")
  char* V_lds = lds; char* K_lds = lds + 4 * SHM_V;
  float* ws = (float*)(lds + 4 * SHM_V + 4 * SHM_K) + wid * 64; float* li_l = ws; float* al_l = ws + 32;
  float mref = 0.f, l_reg = 0; f32x16 negm = {}; f32x16 o[2] = {}; bf16x8 qr[6];
  const bf16_t* Qw = Qb + (long)(wid * QBLK + r32) * 768 + hi * 8;
#pragma unroll
  for (int d0 = 0; d0 < 6; ++d0) qr[d0] = *reinterpret_cast<const bf16x8*>(Qw + d0 * 16);
  const int sr = tid >> 3, sc = (tid & 7) * 8, vst = v_st(sr, sc), kst = KSWZ(sr, sc * 2), krst = KSWZ(sr, 128 + (tid & 7) * 8);
  const lds_cptr vb0 = (lds_cptr)(LAS char*)lds + v_rd_base(lane);
  struct { bf16x8 vs, ks; s16x4 kr; } sr_[2];
  const unsigned lo_kv = (unsigned)(sr * 512 + sc), lo_kr = (unsigned)(sr * 32 + (tid & 7) * 4);
#define SLOAD(i, k0) do { const bf16_t* vt_ = Vh + (size_t)(k0) * 512; const bf16_t* kt_ = KNh + (size_t)(k0) * 512; const bf16_t* rt_ = KRb + (size_t)(k0) * 32; \
    sr_[i].vs = *reinterpret_cast<const bf16x8*>(vt_ + lo_kv); sr_[i].ks = *reinterpret_cast<const bf16x8*>(kt_ + lo_kv); sr_[i].kr = *reinterpret_cast<const s16x4*>(rt_ + lo_kr); } while (0)
#define SWRITE(slot, i) do { *(bf16x8*)(V_lds + (slot) * SHM_V + vst) = sr_[i].vs; *(bf16x8*)(K_lds + (slot) * SHM_K + kst) = sr_[i].ks; *(s16x4*)(K_lds + (slot) * SHM_K + krst) = sr_[i].kr; } while (0)
#define RESC(a) do { if (__any((a) < 1.f)) { if (hi == 0) al_l[r32] = (a); asm volatile("s_waitcnt lgkmcnt(0)" ::: "memory"); \
    _Pragma("unroll") for (int d = 0; d < 2; ++d) _Pragma("unroll") for (int r = 0; r < 16; ++r) o[d][r] *= al_l[crow(r, hi)]; } } while (0)
  f32x16 pA0, pA1, pB0, pB1; float alA, alB; bf16x8 pa0, pa1, pa2, pa3; constexpr int NT = SEQ / KVBLK;
  SLOAD(0, 0); SLOAD(1, KVBLK); asm volatile("s_waitcnt vmcnt(0)" ::: "memory"); SWRITE(0, 0); SWRITE(1, 1); SLOAD(0, 2 * KVBLK); ABAR();
  qkt(pA0, pA1, K_lds, qr, negm, r32, hi); partialSM<true>(pA0, pA1, mref, negm, alA);
  SWRITE(2, 0); SLOAD(1, 3 * KVBLK); ABAR();
  for (int j = 1; j + 1 < NT; j += 2) {
    SBAR(); qkt(pB0, pB1, K_lds + (j & 3) * SHM_K, qr, negm, r32, hi);
    finishSM(pA0, pA1, alA, l_reg, pa0, pa1, pa2, pa3); SBAR();
    if (j + 2 < NT) { SWRITE((j + 2) & 3, 1); } if (j + 3 < NT) { SLOAD(0, (j + 3) * KVBLK); } SBAR();
    pv_d0(o, vb0 + ((j - 1) & 3) * SHM_V, pa0, pa1, pa2, pa3); partialSM<false>(pB0, pB1, mref, negm, alB);
    RESC(alB); ABAR();
    SBAR(); qkt(pA0, pA1, K_lds + ((j + 1) & 3) * SHM_K, qr, negm, r32, hi);
    finishSM(pB0, pB1, alB, l_reg, pa0, pa1, pa2, pa3); SBAR();
    if (j + 3 < NT) { SWRITE((j + 3) & 3, 0); } if (j + 4 < NT) { SLOAD(1, (j + 4) * KVBLK); } SBAR();
    pv_d0(o, vb0 + (j & 3) * SHM_V, pa0, pa1, pa2, pa3); partialSM<false>(pA0, pA1, mref, negm, alA);
    RESC(alA); ABAR();
  }
  SBAR(); qkt(pB0, pB1, K_lds + ((NT - 1) & 3) * SHM_K, qr, negm, r32, hi);
  finishSM(pA0, pA1, alA, l_reg, pa0, pa1, pa2, pa3); SBAR();
  pv_d0(o, vb0 + ((NT - 2) & 3) * SHM_V, pa0, pa1, pa2, pa3); partialSM<false>(pB0, pB1, mref, negm, alB);
  RESC(alB);
  finishSM(pB0, pB1, alB, l_reg, pa0, pa1, pa2, pa3); SBAR();
  pv_d0(o, vb0 + ((NT - 1) & 3) * SHM_V, pa0, pa1, pa2, pa3);
  if (hi == 0) li_l[r32] = l_reg; asm volatile("s_waitcnt lgkmcnt(0)" ::: "memory");
  float rli[16];
#pragma unroll
  for (int r = 0; r < 16; ++r) rli[r] = __builtin_amdgcn_rcpf(li_l[crow(r, hi)]);
  bf16_t* Ow = Ob + (long)(wid * QBLK) * 512;
#pragma unroll
  for (int r = 0; r < 16; ++r) { int orow = crow(r, hi);
#pragma unroll
    for (int d0 = 0; d0 < 2; ++d0) Ow[(long)orow * 512 + d0 * 32 + r32] = (bf16_t)(cvt_pk_bf16(o[d0][r] * rli[r], 0.f) & 0xffffu); }
  ABAR();
#undef SLOAD
#undef SWRITE
#undef RESC
#undef ABAR
}
#undef KSWZ
#undef SBAR
}

__device__ __forceinline__ void h2f(unsigned w, float& lo, float& hi) { const __half2 h = *(const __half2*)&w; const float2 f = __half22float2(h); lo = f.x; hi = f.y; }
__device__ __forceinline__ void scan_item(int b, int cgp, unsigned* AU, const bf16_t* LY, bf16_t* REC, float* sc) {
    const int tid = threadIdx.x, wid = tid >> 6, lane = tid & 63, c = cgp * 64 + lane;
    const unsigned r0 = (unsigned)b * SEQ + wid * 256;
    unsigned* au0 = AU + c; unsigned* au1 = AU + (size_t)T * 512 + c; const bf16_t* ly = LY + c; bf16_t* rec = REC + c;
#define SC_STEP(W, H) do { float la_, u_; h2f(W, la_, u_); H = __builtin_amdgcn_exp2f(la_) * H + u_; } while (0)
    { float hf = 0.f, hb = 0.f, slf = 0.f, slb = 0.f; unsigned fa[16], ba[16], fb[16], bb[16];
#pragma unroll
      for (int k = 0; k < 16; ++k) { fa[k] = au0[(r0 + k) * 512]; ba[k] = au1[(r0 + 255 - k) * 512]; }
#pragma unroll 1
      for (int blk = 0; blk < 16; blk += 2) {
#pragma unroll
          for (int k = 0; k < 16; ++k) { fb[k] = au0[(r0 + (blk + 1) * 16 + k) * 512]; bb[k] = au1[(r0 + 255 - ((blk + 1) * 16 + k)) * 512]; }
#pragma unroll
          for (int k = 0; k < 16; ++k) { float la, u; h2f(fa[k], la, u); hf = __builtin_amdgcn_exp2f(la) * hf + u; slf += la; h2f(ba[k], la, u); hb = __builtin_amdgcn_exp2f(la) * hb + u; slb += la; }
          if (blk + 2 < 16) {
#pragma unroll
              for (int k = 0; k < 16; ++k) { fa[k] = au0[(r0 + (blk + 2) * 16 + k) * 512]; ba[k] = au1[(r0 + 255 - ((blk + 2) * 16 + k)) * 512]; } }
#pragma unroll
          for (int k = 0; k < 16; ++k) { float la, u; h2f(fb[k], la, u); hf = __builtin_amdgcn_exp2f(la) * hf + u; slf += la; h2f(bb[k], la, u); hb = __builtin_amdgcn_exp2f(la) * hb + u; slb += la; }
      }
      sc[wid * 64 + lane] = __builtin_amdgcn_exp2f(slf); sc[1024 + wid * 64 + lane] = hf;
      sc[(8 + wid) * 64 + lane] = __builtin_amdgcn_exp2f(slb); sc[1024 + (8 + wid) * 64 + lane] = hb; }
    __syncthreads();
    float cin0 = 0.f, cin1 = 0.f;
    for (int k = 0; k < wid; ++k) cin0 = sc[k * 64 + lane] * cin0 + sc[1024 + k * 64 + lane];
    for (int k = 7; k > wid; --k) cin1 = sc[(8 + k) * 64 + lane] * cin1 + sc[1024 + (8 + k) * 64 + lane];
    { float h = cin0; unsigned wa[16], wb[16];
#pragma unroll
      for (int k = 0; k < 16; ++k) wa[k] = au0[(r0 + k) * 512];
#pragma unroll 1
      for (int blk = 0; blk < 16; blk += 2) {
#pragma unroll
          for (int k = 0; k < 16; ++k) wb[k] = au0[(r0 + (blk + 1) * 16 + k) * 512];
#pragma unroll
          for (int k = 0; k < 16; ++k) { SC_STEP(wa[k], h); rec[(r0 + blk * 16 + k) * 512] = (bf16_t)(cvt_pk_bf16(h, 0.f) & 0xffffu); }
          if (blk + 2 < 16) {
#pragma unroll
              for (int k = 0; k < 16; ++k) wa[k] = au0[(r0 + (blk + 2) * 16 + k) * 512]; }
#pragma unroll
          for (int k = 0; k < 16; ++k) { SC_STEP(wb[k], h); rec[(r0 + (blk + 1) * 16 + k) * 512] = (bf16_t)(cvt_pk_bf16(h, 0.f) & 0xffffu); }
      } }
    { float h = cin1; unsigned wa[16], wb[16]; bf16_t fa[16], fb[16], ya[16], yb[16];
#pragma unroll
      for (int k = 0; k < 16; ++k) { const unsigned row = r0 + 255 - k; wa[k] = au1[row * 512]; fa[k] = rec[row * 512]; ya[k] = ly[row * 512]; }
#pragma unroll 1
      for (int blk = 0; blk < 16; blk += 2) {
#pragma unroll
          for (int k = 0; k < 16; ++k) { const unsigned row = r0 + 255 - ((blk + 1) * 16 + k); wb[k] = au1[row * 512]; fb[k] = rec[row * 512]; yb[k] = ly[row * 512]; }
#pragma unroll
          for (int k = 0; k < 16; ++k) { const unsigned row = r0 + 255 - (blk * 16 + k); SC_STEP(wa[k], h);
              const float tot = (h + __uint_as_float((unsigned)fa[k] << 16)) * __uint_as_float((unsigned)ya[k] << 16); rec[row * 512] = (bf16_t)(cvt_pk_bf16(tot, 0.f) & 0xffffu); }
          if (blk + 2 < 16) {
#pragma unroll
              for (int k = 0; k < 16; ++k) { const unsigned row = r0 + 255 - ((blk + 2) * 16 + k); wa[k] = au1[row * 512]; fa[k] = rec[row * 512]; ya[k] = ly[row * 512]; } }
#pragma unroll
          for (int k = 0; k < 16; ++k) { const unsigned row = r0 + 255 - ((blk + 1) * 16 + k); SC_STEP(wb[k], h);
              const float tot = (h + __uint_as_float((unsigned)fb[k] << 16)) * __uint_as_float((unsigned)yb[k] << 16); rec[row * 512] = (bf16_t)(cvt_pk_bf16(tot, 0.f) & 0xffffu); }
      } }
#undef SC_STEP
    __syncthreads();
}

template <class F> __device__ __forceinline__ void xpose(bf16_t* Bt, int N, int K, F f, int gw, int NGW, int lane) {
    const int nN = N / 64, total = nN * (K / 8);
    for (int item = gw; item < total; item += NGW) { const int ng = item % nN, kc = item / nN, n = ng * 64 + lane, k0 = kc * 8;
        float v[8];
#pragma unroll
        for (int e = 0; e < 8; ++e) v[e] = f(n, k0 + e);
        u32x4 w; w.x = cvt_pk_bf16(v[0], v[1]); w.y = cvt_pk_bf16(v[2], v[3]); w.z = cvt_pk_bf16(v[4], v[5]); w.w = cvt_pk_bf16(v[6], v[7]);
        *(u32x4*)(Bt + (size_t)n * K + k0) = w; }
}


template <class F> __device__ __forceinline__ void xpose_one(bf16_t* Bt, int N, int K, F f, int item, int lane) {
    const int nN = N / 64, n = (item % nN) * 64 + lane, k0 = (item / nN) * 8;
    float v[8];
#pragma unroll
    for (int e = 0; e < 8; ++e) v[e] = f(n, k0 + e);
    u32x4 w; w.x = cvt_pk_bf16(v[0], v[1]); w.y = cvt_pk_bf16(v[2], v[3]); w.z = cvt_pk_bf16(v[4], v[5]); w.w = cvt_pk_bf16(v[6], v[7]);
    *(u32x4*)(Bt + (size_t)n * K + k0) = w;
}

#define XB_TMO      128
#define XB_XCNT(j)  (256  + 64 * (j))
#define XB_XSUB(j)  (1280 + 64 * (j))
#define XB_XGEN(j)  (2304 + 64 * (j))
#define XB_TOP      3328
#define XB_TOPGEN   3392
#define XCD_BAR_WORDS 3456
#define XB_SPIN_CAP (1u << 18)
__device__ __forceinline__ unsigned xb_ld(unsigned* p)              { return __hip_atomic_load(p, __ATOMIC_RELAXED, __HIP_MEMORY_SCOPE_AGENT); }
__device__ __forceinline__ unsigned xb_add(unsigned* p, unsigned v) { return __hip_atomic_fetch_add(p, v, __ATOMIC_RELAXED, __HIP_MEMORY_SCOPE_AGENT); }
__device__ __forceinline__ unsigned xb_xcc_id() { return (unsigned)__builtin_amdgcn_s_getreg((3 << 11) | 20) & 0xFu; }
#define XB_SPIN(cond, bar) do { unsigned _sp = 0; while (cond) { __builtin_amdgcn_s_sleep(1); \
    if ((++_sp & 255u) == 0u) { if (xb_ld(&(bar)[XB_TMO])) break; if (_sp > XB_SPIN_CAP) { atomicAdd(&(bar)[XB_TMO], 1u); break; } } } } while (0)
struct XcdBarrier { unsigned* bar; unsigned x; volatile LAS unsigned* st; };
__device__ __forceinline__ XcdBarrier xcd_barrier_post(unsigned* bar, volatile LAS unsigned* st) {
    XcdBarrier b; b.bar = bar; b.x = xb_xcc_id(); b.st = st;
    if (threadIdx.x == 0) (void)xb_add(&bar[XB_XCNT(b.x)], 1u);
    return b;
}
__device__ __forceinline__ void xcd_barrier_complete(unsigned* bar, unsigned x, unsigned& nloc, unsigned& nx) {
    const unsigned G = gridDim.x * gridDim.y * gridDim.z;
    unsigned sum, cnt, mine, sp = 0u;
    for (;;) {
        sum = 0u; cnt = 0u; mine = 0u;
#pragma unroll
        for (unsigned j = 0; j < 16; ++j) { const unsigned c = xb_ld(&bar[XB_XCNT(j)]); sum += c; cnt += (c > 0u) ? 1u : 0u; mine = (j == x) ? c : mine; }
        if (sum == G) break;
        __builtin_amdgcn_s_sleep(1);
        if ((++sp & 255u) == 0u) { if (xb_ld(&bar[XB_TMO])) break; if (sp > XB_SPIN_CAP) { atomicAdd(&bar[XB_TMO], 1u); break; } }
    }
    nloc = mine > 0u ? mine : 1u; nx = cnt > 0u ? cnt : 1u;
}
__device__ __forceinline__ void xcd_barrier(const XcdBarrier& b) {
    asm volatile("s_waitcnt vmcnt(0)" ::: "memory");
    __syncthreads();
    if (threadIdx.x == 0) {
        unsigned* bar = b.bar;
        __builtin_amdgcn_s_waitcnt(0);
        unsigned nloc = b.st[0], nx = b.st[1];
        if (nloc == 0u) { xcd_barrier_complete(bar, b.x, nloc, nx); b.st[0] = nloc; b.st[1] = nx; }
        const unsigned old = xb_add(&bar[XB_XSUB(b.x)], 1u);
        const unsigned gen = old / nloc;
        if (old + 1u == (gen + 1u) * nloc) {
            __builtin_amdgcn_fence(__ATOMIC_RELEASE, "agent");
            asm volatile("s_waitcnt vmcnt(0)" ::: "memory");
            const unsigned og = xb_add(&bar[XB_TOP], 1u);
            const unsigned tg = og / nx;
            if (og + 1u == (tg + 1u) * nx) xb_add(&bar[XB_TOPGEN], 1u);
            else XB_SPIN(xb_ld(&bar[XB_TOPGEN]) == tg, bar);
            __builtin_amdgcn_fence(__ATOMIC_ACQUIRE, "agent");
            xb_add(&bar[XB_XGEN(b.x)], 1u);
            asm volatile("s_waitcnt vmcnt(0)" ::: "memory");
        } else {
            XB_SPIN(xb_ld(&bar[XB_XGEN(b.x)]) == gen, bar);
            __builtin_amdgcn_fence(__ATOMIC_ACQUIRE, "agent");
            asm volatile("s_waitcnt vmcnt(0)" ::: "memory");
        }
    }
    __syncthreads();
}

constexpr size_t MiB = 1u << 20;
constexpr size_t WS_SS = 0;
constexpr size_t WS_ROPE = 1 * MiB;
constexpr size_t WS_SP8 = WS_ROPE + 256 * 1024;
constexpr size_t WS_BAR = 1 * MiB + 512 * 1024;
constexpr size_t WS_WIN = 2 * MiB;
constexpr size_t WS_WQB = 9 * MiB;
constexpr size_t WS_WKVB = WS_WQB + 512 * 1024;
constexpr size_t WS_WG = 10 * MiB;
constexpr size_t WS_WOA = 11 * MiB;
constexpr size_t WS_WOL = 12 * MiB;
constexpr size_t WS_WOUT = 13 * MiB;
constexpr size_t WS_WGU = 15 * MiB;
constexpr size_t WS_WD = 26 * MiB;
constexpr size_t WS_A = 40 * MiB;
constexpr size_t WS_GATES = 168 * MiB;
constexpr size_t WS_LY = 424 * MiB;
constexpr size_t WS_LX = 488 * MiB;
constexpr size_t WS_QA = 552 * MiB;
constexpr size_t WS_KVA = 584 * MiB;
constexpr size_t WS_KN = 616 * MiB;
constexpr size_t WS_V = 680 * MiB;
constexpr size_t WS_KR = 744 * MiB;
constexpr size_t WS_XC = 748 * MiB;
constexpr size_t WS_X1B = 616 * MiB;
constexpr size_t WS_HID = 168 * MiB;
constexpr size_t WS_END = 812 * MiB;

struct Args { const float* in[22]; float* out; unsigned char* ws; int ph_lo, ph_hi; };

__global__ void __launch_bounds__(512, 2) mega_fwd(Args args) {
    extern __shared__ __attribute__((aligned(16))) unsigned char lds_raw[];
    LAS unsigned char* lds = (LAS unsigned char*)lds_raw;
    const int tid = threadIdx.x;
#define PHASE_IDS const int lane = threadIdx.x & 63, wave = __builtin_amdgcn_readfirstlane(threadIdx.x >> 6), gw = bid * 8 + wave, NGW = G * 8, gtid = bid * 512 + (int)threadIdx.x, NTH = G * 512; (void)lane; (void)gw; (void)NGW; (void)gtid; (void)NTH
    const int G = gridDim.x, bid = blockIdx.x;
    unsigned char* ws = args.ws;
    float* SSQ = (float*)(ws + WS_SS); float* SSKV = SSQ + T; float* SS2 = SSKV + T; float* SS3 = SS2 + T;
    float* ROPE = (float*)(ws + WS_ROPE); float* SP8 = (float*)(ws + WS_SP8);
    bf16_t* WIN = (bf16_t*)(ws + WS_WIN); bf16_t* WQB = (bf16_t*)(ws + WS_WQB); bf16_t* WKVB = (bf16_t*)(ws + WS_WKVB); bf16_t* WG = (bf16_t*)(ws + WS_WG);
    bf16_t* WOA = (bf16_t*)(ws + WS_WOA); bf16_t* WOL = (bf16_t*)(ws + WS_WOL); bf16_t* WOUT = (bf16_t*)(ws + WS_WOUT); bf16_t* WGU = (bf16_t*)(ws + WS_WGU); bf16_t* WD = (bf16_t*)(ws + WS_WD);
    bf16_t* XN = (bf16_t*)(ws + WS_A); bf16_t* Qb = (bf16_t*)(ws + WS_A); bf16_t* MERGED = (bf16_t*)(ws + WS_A);
    bf16_t* GATES = (bf16_t*)(ws + WS_GATES); bf16_t* LY = (bf16_t*)(ws + WS_LY); bf16_t* LX = (bf16_t*)(ws + WS_LX); bf16_t* ATT = (bf16_t*)(ws + WS_LX);
    bf16_t* QA = (bf16_t*)(ws + WS_QA); bf16_t* KVA = (bf16_t*)(ws + WS_KVA); bf16_t* REC = (bf16_t*)(ws + WS_QA);
    bf16_t* KN = (bf16_t*)(ws + WS_KN); bf16_t* Vb = (bf16_t*)(ws + WS_V); bf16_t* KR = (bf16_t*)(ws + WS_KR); bf16_t* XC = (bf16_t*)(ws + WS_XC);
    bf16_t* X1B = (bf16_t*)(ws + WS_X1B); bf16_t* HID = (bf16_t*)(ws + WS_HID);
    unsigned* AU = (unsigned*)args.out;
    const int lo = args.ph_lo, hi = args.ph_hi;
    volatile LAS unsigned* xst = (volatile LAS unsigned*)(lds + 140032);
    if (tid < 2) xst[tid] = 0u;
    __syncthreads();
    XcdBarrier xbar; xbar.bar = (unsigned*)(ws + WS_BAR); xbar.x = 0; xbar.st = xst;
    if (hi - lo > 1) xbar = xcd_barrier_post((unsigned*)(ws + WS_BAR), xst);
#define IN(k) (((PHASE_MASK >> (k)) & 1) && lo <= (k) && (k) < hi)
#if PROBE_MASK
    unsigned long long pr_acc = 0, pr_t0 = __builtin_amdgcn_s_memrealtime();
#define SEAM(k) do { if (IN(k) && IN((k) + 1)) { if ((k) == 0) cg::this_grid().sync(); else xcd_barrier(xbar); } { const unsigned long long t1_ = __builtin_amdgcn_s_memrealtime(); if ((PROBE_MASK >> (k)) & 1) pr_acc += t1_ - pr_t0; pr_t0 = t1_; } } while (0)
#else
#define SEAM(k) do { if (IN(k) && IN((k) + 1)) { if ((k) == 0) cg::this_grid().sync(); else xcd_barrier(xbar); } } while (0)
#endif

    if (IN(0)) { PHASE_IDS;
        for (int i = gtid; i < 4 * T; i += NTH) SSQ[i] = 0.f;
        for (int i = gtid; i < SEQ * 16; i += NTH) { const int pos = i >> 4, fi = i & 15; const float inv = 1.0f / powf(10000.0f, (float)fi * (1.0f / 16.0f)); const float ang = (float)pos * inv;
            float s, c; sincosf(ang, &s, &c); ROPE[pos * 32 + fi] = c; ROPE[pos * 32 + 16 + fi] = s; }
        for (int i = gtid; i < 1024; i += NTH) { const float lam = args.in[14][i]; SP8[i] = 8.0f * log1pf(expf(-lam)); }
        {
          const float* w_in = args.in[2]; const float* w_qb = args.in[4]; const float* g_q = args.in[3]; const float* w_kvb = args.in[6]; const float* g_kv = args.in[5];
          const float* wr_ = args.in[10]; const float* wi_ = args.in[12]; const float* w_oa = args.in[7]; const float* w_ol = args.in[15]; const float* w_o = args.in[16];
          const float* wg_ = args.in[18]; const float* wu_ = args.in[19]; const float* g2 = args.in[17]; const float* w_d = args.in[20];
          constexpr int I0 = (DIN_PAD / 64) * (1024 / 8), I1 = (768 / 64) * (256 / 8), I2 = (1024 / 64) * (128 / 8), I3 = (2048 / 64) * (128 / 8), I4 = (1024 / 64) * (512 / 8), I5 = I4,
                        I6 = (1024 / 64) * (1024 / 8), I7 = (2 * DFF / 64) * (1024 / 8), I8 = (1024 / 64) * (DFF / 8), ITOT = I0 + I1 + I2 + I3 + I4 + I5 + I6 + I7 + I8;
          auto do_item = [&](int gi) { int r = gi;
              if (r < I0) { xpose_one(WIN, DIN_PAD, 1024, [=](int n, int k) -> float { int src;
                  if (n < 384) src = n; else if (n < 416) { const int j = n - 384; src = 384 + (j & 1) * 16 + (j >> 1); } else if (n < 512) src = -1;
                  else if (n < 1024) src = 416 + (n - 512); else if (n < 1536) src = 928 + (n - 1024); else src = 1440 + (n - 1536);
                  return src < 0 ? 0.f : w_in[(size_t)k * DIN_SRC + src]; }, r, lane); return; } r -= I0;
              if (r < I1) { xpose_one(WQB, 768, 256, [=](int n, int k) -> float { const int h = n / 96, dp = n % 96; int d = dp; if (dp >= 64) { const int j = dp - 64; d = 64 + (j & 1) * 16 + (j >> 1); }
                  return w_qb[(size_t)k * 768 + h * 96 + d] * g_q[k]; }, r, lane); return; } r -= I1;
              if (r < I2) { xpose_one(WKVB, 1024, 128, [=](int n, int k) -> float { const int nn = n & 511, h = nn >> 6, d = nn & 63; return w_kvb[(size_t)k * 1024 + h * 128 + (n >> 9) * 64 + d] * g_kv[k]; }, r, lane); return; } r -= I2;
              if (r < I3) { xpose_one(WG, 2048, 128, [=](int n, int k) -> float { const int g = n >> 8, bj = (n >> 7) & 1, j = n & 127, blk = g >> 1, dir = g & 1;
                  return (bj ? wi_ : wr_)[((size_t)(dir * 4 + blk) * 128 + k) * 128 + j]; }, r, lane); return; } r -= I3;
              if (r < I4) { xpose_one(WOA, 1024, 512, [=](int n, int k) -> float { return w_oa[(size_t)k * 1024 + n]; }, r, lane); return; } r -= I4;
              if (r < I5) { xpose_one(WOL, 1024, 512, [=](int n, int k) -> float { return w_ol[(size_t)k * 1024 + n]; }, r, lane); return; } r -= I5;
              if (r < I6) { xpose_one(WOUT, 1024, 1024, [=](int n, int k) -> float { return w_o[(size_t)k * 1024 + n]; }, r, lane); return; } r -= I6;
              if (r < I7) { xpose_one(WGU, 2 * DFF, 1024, [=](int n, int k) -> float { const int pn = n >> 8, bj = (n >> 7) & 1, j = n & 127; return (bj ? wu_ : wg_)[(size_t)k * DFF + pn * 128 + j] * g2[k]; }, r, lane); return; } r -= I7;
              xpose_one(WD, 1024, DFF, [=](int n, int k) -> float { return w_d[(size_t)k * 1024 + n]; }, r, lane); };
          const float* x = args.in[0]; const float* g1 = args.in[1];
          f32x4 gv[4];
#pragma unroll
          for (int j = 0; j < 4; ++j) gv[j] = *((const f32x4*)g1 + lane + 64 * j);
          int gi = gw;
          for (int m = gw; m < T; m += 2 * NGW) { const int m2 = m + NGW; const bool two = m2 < T; const int mb = two ? m2 : m;
              const f32x4* xr = (const f32x4*)(x + (size_t)m * DM) + lane; const f32x4* xr2 = (const f32x4*)(x + (size_t)mb * DM) + lane; f32x4 v[4], v2[4]; float s = 0.f, s2 = 0.f;
#pragma unroll
              for (int j = 0; j < 4; ++j) { v[j] = __builtin_nontemporal_load(xr + 64 * j); v2[j] = __builtin_nontemporal_load(xr2 + 64 * j); }
              if (gi < ITOT) { do_item(gi); gi += NGW; }
#pragma unroll
              for (int j = 0; j < 4; ++j) { s += (v[j].x * v[j].x + v[j].y * v[j].y) + (v[j].z * v[j].z + v[j].w * v[j].w); s2 += (v2[j].x * v2[j].x + v2[j].y * v2[j].y) + (v2[j].z * v2[j].z + v2[j].w * v2[j].w); }
              const float rstd = rsqrtf(wave_sum(s) * (1.0f / DM) + EPS), rstd2 = rsqrtf(wave_sum(s2) * (1.0f / DM) + EPS);
              u32x2* o8 = (u32x2*)(XN + (size_t)m * DM) + lane; u32x2* o82 = (u32x2*)(XN + (size_t)mb * DM) + lane;
#pragma unroll
              for (int j = 0; j < 4; ++j) { const f32x4 y = v[j] * rstd * gv[j]; u32x2 w2; w2.x = cvt_pk_bf16(y.x, y.y); w2.y = cvt_pk_bf16(y.z, y.w); o8[64 * j] = w2; }
              if (two) {
#pragma unroll
                  for (int j = 0; j < 4; ++j) { const f32x4 y = v2[j] * rstd2 * gv[j]; u32x2 w2; w2.x = cvt_pk_bf16(y.x, y.y); w2.y = cvt_pk_bf16(y.z, y.w); o82[64 * j] = w2; } } }
          for (; gi < ITOT; gi += NGW) do_item(gi);
        }
    }
    SEAM(0);
    if (IN(1)) {
        pg8::Gemm g{XN, XN, WIN, WIN, 1024, 1024, 1024, 0, 0}; pg8::StaticOrder S; S.init(T, DIN_PAD, G, bid);
        EpiProj E{QA, KVA, KR, LX, LY, GATES, SSQ, SSKV, ROPE};
        pg8::gemm_phase<EpiProj, pg8::StaticOrder, true>(lds, g, S, E);
    }
    SEAM(1);
    if (IN(2)) { PHASE_IDS;
        if (P2SUB & 1) { const float* cw = args.in[8]; const float* cb = args.in[9]; const int c8 = (gtid & 63) * 8;
          float w[4][8], bias[8];
#pragma unroll
          for (int e = 0; e < 8; ++e) { bias[e] = cb[c8 + e];
#pragma unroll
              for (int j = 0; j < 4; ++j) w[j][e] = cw[j * 512 + c8 + e]; }
          const int rstride = NTH >> 6;
          for (int row = gtid >> 6; row < T; row += 2 * rstride) { const int rowb = (row + rstride < T) ? row + rstride : row;
              u32x4 xa[4], xb[4];
#pragma unroll
              for (int j = 0; j < 4; ++j) { const int ta = (row & (SEQ - 1)) - 2 + j, tb = (rowb & (SEQ - 1)) - 2 + j;
                  xa[j] = (ta >= 0 && ta < SEQ) ? *(const u32x4*)(LX + (size_t)(row - 2 + j) * 512 + c8) : (u32x4){0u, 0u, 0u, 0u};
                  xb[j] = (tb >= 0 && tb < SEQ) ? *(const u32x4*)(LX + (size_t)(rowb - 2 + j) * 512 + c8) : (u32x4){0u, 0u, 0u, 0u}; }
              float a[8], bq[8];
#pragma unroll
              for (int e = 0; e < 8; ++e) { a[e] = bias[e]; bq[e] = bias[e]; }
#pragma unroll
              for (int j = 0; j < 4; ++j) { f32x4 x0, x1, y0, y1; unpack8(xa[j], x0, x1); unpack8(xb[j], y0, y1);
#pragma unroll
                  for (int e = 0; e < 4; ++e) { a[e] += w[j][e] * x0[e]; a[4 + e] += w[j][4 + e] * x1[e]; bq[e] += w[j][e] * y0[e]; bq[4 + e] += w[j][4 + e] * y1[e]; } }
              u32x4 o; o.x = cvt_pk_bf16(a[0], a[1]); o.y = cvt_pk_bf16(a[2], a[3]); o.z = cvt_pk_bf16(a[4], a[5]); o.w = cvt_pk_bf16(a[6], a[7]);
              *(u32x4*)(XC + (size_t)row * 512 + c8) = o;
              if (rowb != row) { u32x4 o2; o2.x = cvt_pk_bf16(bq[0], bq[1]); o2.y = cvt_pk_bf16(bq[2], bq[3]); o2.z = cvt_pk_bf16(bq[4], bq[5]); o2.w = cvt_pk_bf16(bq[6], bq[7]);
                  *(u32x4*)(XC + (size_t)rowb * 512 + c8) = o2; } } }
        if (P2SUB & 2) { pg8::Gemm g{QA, QA, WQB, WQB, 256, 256, 256, 0, 0}; pg8::StaticOrder S; S.init(T, 768, G, bid); EpiQ E{Qb, SSQ, ROPE};
          pg8::gemm_phase<EpiQ, pg8::StaticOrder, true>(lds, g, S, E); }
        if (P2SUB & 4) { pg8::Gemm g{KVA, KVA, WKVB, WKVB, 128, 128, 128, 0, 0}; pg8::StaticOrder S; S.init(T, 1024, G, bid); EpiKV E{KN, Vb, SSKV};
          pg8::gemm_phase<EpiKV, pg8::StaticOrder, true>(lds, g, S, E); }
    }
    SEAM(2);
    if (IN(3)) {
        pg8::Gemm g{XC, XC, WG, WG, 512, 128, 128, 1, 128}; pg8::StaticOrder S; S.init(T, 2048, G, bid);
        EpiGates E{XC, AU, args.in[11], args.in[13], SP8};
        pg8::gemm_phase<EpiGates, pg8::StaticOrder, true>(lds, g, S, E);
    }
    SEAM(3);
    if (IN(4)) {
        __syncthreads();
        for (int it = bid; it < NBATCH * 8; it += G) scan_item(it >> 3, it & 7, AU, LY, REC, (float*)lds_raw);
        const int vcu = (G % 8 == 0) ? (bid % 8) * (G / 8) + bid / 8 : bid;
        for (int un = vcu; un < NBATCH * 8 * 8; un += G) { const int bh = un >> 3, qb = un & 7, b = bh >> 3, h = bh & 7; const size_t rb = (size_t)b * SEQ;
            att::attn_unit(Qb + (rb + qb * 256) * 768 + h * 96, KN + rb * 512 + h * 64, KR + rb * 32, Vb + rb * 512 + h * 64, ATT + (rb + qb * 256) * 512 + h * 64, (char*)lds_raw); }
    }
    SEAM(4);
    if (IN(5)) {
        pg8::Gemm g{ATT, REC, WOA, WOL, 512, 512, 512, 0, 0}; pg8::DualOrder S; S.S.init(T, 1024, G, bid);
        EpiMerge E{GATES, MERGED};
        pg8::gemm_phase<EpiMerge, pg8::DualOrder, true>(lds, g, S, E);
    }
    SEAM(5);
    if (IN(6)) {
        pg8::Gemm g{MERGED, MERGED, WOUT, WOUT, 1024, 1024, 1024, 0, 0}; pg8::StaticOrder S; S.init(T, 1024, G, bid);
        EpiOut E{args.in[0], X1B, SS2};
        pg8::gemm_phase<EpiOut, pg8::StaticOrder, true>(lds, g, S, E);
    }
    SEAM(6);
    if (IN(7)) {
        pg8::Gemm g{X1B, X1B, WGU, WGU, 1024, 1024, 1024, 0, 0}; pg8::StaticOrder S; S.init(T, 2 * DFF, G, bid);
        EpiFfn E{HID, SS2};
        pg8::gemm_phase<EpiFfn, pg8::StaticOrder, true>(lds, g, S, E);
    }
    SEAM(7);
    if (IN(8)) {
        pg8::Gemm g{HID, HID, WD, WD, DFF, DFF, DFF, 0, 0}; pg8::StaticOrder S; S.init(T, 1024, G, bid);
        EpiDown E{X1B, SS3};
        pg8::gemm_phase<EpiDown, pg8::StaticOrder, true>(lds, g, S, E);
    }
    SEAM(8);
    if (IN(9)) { PHASE_IDS;
        const float* gf = args.in[21]; f32x4 gv[4];
#pragma unroll
        for (int j = 0; j < 4; ++j) gv[j] = *((const f32x4*)gf + lane + 64 * j);
        for (int m = gw; m < T; m += NGW) { f32x4* xr = (f32x4*)(args.out + (size_t)m * DM) + lane; const u32x2* br_ = (const u32x2*)(X1B + (size_t)m * DM) + lane; const float rstd = rsqrtf(SS3[m] * (1.0f / DM) + EPS);
            u32x2 w2[4];
#pragma unroll
            for (int j = 0; j < 4; ++j) w2[j] = __builtin_nontemporal_load(br_ + 64 * j);
#pragma unroll
            for (int j = 0; j < 4; ++j) { const f32x4 v = (f32x4){bf_lo(w2[j].x), bf_hi(w2[j].x), bf_lo(w2[j].y), bf_hi(w2[j].y)}; __builtin_nontemporal_store(v * rstd * gv[j], xr + 64 * j); } }
    }
#if PROBE_MASK
    SEAM(9);
    if (bid == 0 && tid == 0) { const unsigned long long t0_ = __builtin_amdgcn_s_memrealtime(); while (__builtin_amdgcn_s_memrealtime() - t0_ < pr_acc) __builtin_amdgcn_s_sleep(8); }
#endif
#undef IN
#undef SEAM
}

constexpr int LDS_BYTES = 147456;
constexpr int N_PHASES = 10;
extern "C" void kernel_launch(void* const* d_in, const int* in_sizes, int n_in, void* d_out, int out_size, void* d_ws, size_t ws_size, hipStream_t stream) {
    static int grid = 0;
    if (grid == 0) {
        if (n_in != 22 || out_size != T * DM || ws_size < WS_END) { fprintf(stderr, "kernel_launch: unexpected shapes n_in %d out %d ws %zu\n", n_in, out_size, ws_size); grid = -1; return; }
        int dev = 0, cus = 0, per_cu = 0;
        hipGetDevice(&dev); hipDeviceGetAttribute(&cus, hipDeviceAttributeMultiprocessorCount, dev);
        if (hipFuncSetAttribute((const void*)mega_fwd, hipFuncAttributeMaxDynamicSharedMemorySize, LDS_BYTES) != hipSuccess) { fprintf(stderr, "kernel_launch: hipFuncSetAttribute failed\n"); grid = -1; return; }
        if (hipOccupancyMaxActiveBlocksPerMultiprocessor(&per_cu, (const void*)mega_fwd, 512, LDS_BYTES) != hipSuccess || per_cu < 1) { fprintf(stderr, "kernel_launch: occupancy query gives %d\n", per_cu); per_cu = 1; }
        (void)hipGetLastError();
        grid = cus * (per_cu > 1 ? 1 : per_cu);
        if (grid > 256) grid = 256;
    }
    if (grid < 0) return;
    Args a{};
    for (int i = 0; i < 22; ++i) a.in[i] = (const float*)d_in[i];
    a.out = (float*)d_out; a.ws = (unsigned char*)d_ws;
#if MK_SINGLE
    if (hipMemsetAsync((char*)d_ws + WS_BAR, 0, 16384, stream) != hipSuccess) { fprintf(stderr, "kernel_launch: memset failed\n"); return; }
    a.ph_lo = 0; a.ph_hi = N_PHASES;
    void* kargs[] = {&a};
    hipError_t e = hipLaunchCooperativeKernel((const void*)mega_fwd, dim3(grid), dim3(512), kargs, LDS_BYTES, stream);
    if (e != hipSuccess) fprintf(stderr, "cooperative launch failed: %s (grid %d)\n", hipGetErrorString(e), grid);
#else
    for (int p = 0; p < N_PHASES; ++p) { a.ph_lo = p; a.ph_hi = p + 1; hipLaunchKernelGGL(mega_fwd, dim3(grid), dim3(512), LDS_BYTES, stream, a); }
#endif
}
```

```cpp
#include <hip/hip_runtime.h>
#include <hip/hip_cooperative_groups.h>
#include <hip/hip_bf16.h>
#include <hip/hip_fp16.h>
#include <cstdio>
#include <cstdint>
namespace cg = cooperative_groups;

#ifndef PHASE_MASK
#define PHASE_MASK 0x3ff
#endif
#ifndef P2SUB
#define P2SUB 7
#endif
#ifndef PROBE_MASK
#define PROBE_MASK 0
#endif
#ifndef MK_SINGLE
#define MK_SINGLE 1
#endif

constexpr int T = 65536, DM = 1024, SEQ = 2048, NBATCH = 32;
constexpr int DIN_SRC = 3488, DIN_PAD = 3584, DFF = 2816;
constexpr float EPS = 1e-6f;
constexpr float LOG2E = 1.4426950408889634f;

typedef unsigned short bf16_t;
typedef short bf16x8 __attribute__((ext_vector_type(8)));
typedef short s16x4 __attribute__((ext_vector_type(4)));
typedef float f32x4 __attribute__((ext_vector_type(4)));
typedef float f32x2 __attribute__((ext_vector_type(2)));
typedef float f32x16 __attribute__((ext_vector_type(16)));
typedef unsigned u32x4 __attribute__((ext_vector_type(4)));
typedef unsigned u32x2 __attribute__((ext_vector_type(2)));
#define LAS __attribute__((address_space(3)))

__device__ __forceinline__ unsigned cvt_pk_bf16(float lo, float hi) { unsigned r; asm volatile("v_cvt_pk_bf16_f32 %0, %1, %2" : "=v"(r) : "v"(lo), "v"(hi)); return r; }
__device__ __forceinline__ float bf_lo(unsigned w) { return __uint_as_float(w << 16); }
__device__ __forceinline__ float bf_hi(unsigned w) { return __uint_as_float(w & 0xffff0000u); }
__device__ __forceinline__ float fsigmoid(float x) { return __builtin_amdgcn_rcpf(1.0f + __builtin_amdgcn_exp2f(-x * LOG2E)); }
__device__ __forceinline__ u32x4 pack8(f32x4 a, f32x4 b) { u32x4 w; w.x = cvt_pk_bf16(a[0], a[1]); w.y = cvt_pk_bf16(a[2], a[3]); w.z = cvt_pk_bf16(b[0], b[1]); w.w = cvt_pk_bf16(b[2], b[3]); return w; }
__device__ __forceinline__ void unpack8(u32x4 w, f32x4& a, f32x4& b) { a = (f32x4){bf_lo(w.x), bf_hi(w.x), bf_lo(w.y), bf_hi(w.y)}; b = (f32x4){bf_lo(w.z), bf_hi(w.z), bf_lo(w.w), bf_hi(w.w)}; }
__device__ __forceinline__ float wave_sum(float v) {
#pragma unroll
    for (int o = 1; o < 64; o <<= 1) v += __shfl_xor(v, o);
    return v;
}

namespace pg8 {
constexpr int BM = 256, BK = 64, HALF = 128, HTB = HALF * BK * 2, STAGE_BYTES = 8 * HTB, NXCD = 8, WGM = 8;
__host__ __device__ __forceinline__ int lds_byte(int r, int c) { const int st = (r >> 4) * 2 + (c >> 5), rr = r & 15, cc = c & 31, ob = rr * 64 + cc * 2; return st * 1024 + (ob ^ (((ob >> 9) & 1) << 5)); }
__host__ __device__ __forceinline__ void stage_rc(int b, int& R, int& C) { const int st = b / 1024, sb = b % 1024, swz = sb ^ (((sb >> 9) & 1) << 5); R = (st >> 1) * 16 + swz / 64; C = (st & 1) * 32 + (swz % 64) / 2; }
__host__ __device__ __forceinline__ int perm32(int rho) { const int n = rho >> 4, i = rho & 15; return 8 * (i >> 2) + 4 * n + (i & 3); }

struct Unit { int pm, pn, sel; };
struct Gemm {
    const bf16_t *A0, *A1, *B0, *B1; int lda, ldb, K; int a_grp_shift, a_grp_cols;
    __device__ __forceinline__ const char* a_ptr(const Unit& u) const { return (const char*)(u.sel ? A1 : A0) + ((size_t)u.pm * BM * lda + (size_t)(u.pn >> a_grp_shift) * a_grp_cols) * 2; }
    __device__ __forceinline__ const char* b_ptr(const Unit& u) const { return (const char*)(u.sel ? B1 : B0) + (size_t)u.pn * BM * ldb * 2; }
};

struct StaticOrder {
    int nM, nN, nwg, G, c;
    __device__ void init(int M, int N, int G_, int c_) { nM = M / BM; nN = N / BM; nwg = nM * nN; G = G_; c = c_; }
    __device__ bool next(int i, Unit& u) const {
        const long L = (long)i * G + c; if (L >= nwg) return false;
        int wgid = (int)L; { const int q = nwg / NXCD, r = nwg % NXCD, xcd = wgid % NXCD, off = wgid / NXCD; wgid = (xcd < r ? xcd * (q + 1) : r * (q + 1) + (xcd - r) * q) + off; }
        const int nig = WGM * nN, gid = wgid / nig, fm = gid * WGM, gsz = (nM - fm) < WGM ? (nM - fm) : WGM;
        u.pm = fm + ((wgid % nig) % gsz); u.pn = (wgid % nig) / gsz; u.sel = 0; return true;
    }
};
struct DualOrder {
    StaticOrder S;
    __device__ bool next(int i, Unit& u) const { if (!S.next(i >> 1, u)) return false; u.sel = i & 1; return true; }
};

template <class Epi, class Sched, bool ALIGN_EPI>
__device__ __forceinline__ void gemm_phase(LAS unsigned char* lds, const Gemm g, const Sched& S, const Epi& E) {
    int tid = threadIdx.x; asm volatile("" : "+v"(tid) :: "memory");
    const int wid = __builtin_amdgcn_readfirstlane(tid >> 6), lane = tid & 63, wr = wid >> 2, wc = wid & 3, fr = lane & 15, fq = lane >> 4;
    int lda_ = g.lda, ldb_ = g.ldb, K = g.K; asm volatile("" : "+s"(lda_), "+s"(ldb_), "+s"(K) :: "memory");
    const int nt = K / BK;
    unsigned voffA[2], voffB[2];
#pragma unroll
    for (int i = 0; i < 2; ++i) { int R, C; stage_rc(tid * 16 + i * 8192, R, C); const int Rb = Epi::PERM ? ((R & ~31) + perm32(R & 31)) : R;
        voffA[i] = (unsigned)(R * lda_ + C) * 2u; voffB[i] = (unsigned)(Rb * ldb_ + C) * 2u; }
    const size_t kstep = (size_t)(BK * 2);
    const size_t hstepA = (size_t)HALF * lda_ * 2, hstepB = (size_t)HALF * ldb_ * 2;
    const unsigned ldsw = (unsigned)wid * 1024u;
    const int aoff = lds_byte(wr * 64 + fr, fq * 8), boff = lds_byte(wc * 32 + fr, fq * 8);
#define PG8_SA(b, h) (((b) * 2 + (h)) * HTB)
#define PG8_SB(b, h) ((4 + (b) * 2 + (h)) * HTB)
#define PG8_STAGE(bufoff, gbase, voff) do { _Pragma("unroll") for (int _i = 0; _i < 2; ++_i) \
        __builtin_amdgcn_global_load_lds((const unsigned*)((const char*)(gbase) + (voff)[_i]), (LAS unsigned*)(lds + (bufoff) + ldsw + _i * 8192), 16, 0, 0); } while (0)
#define PG8_LDA(dst, b, h) do { _Pragma("unroll") for (int m = 0; m < 4; ++m) _Pragma("unroll") for (int k = 0; k < 2; ++k) dst[m][k] = *(const LAS bf16x8*)(lds + PG8_SA(b, h) + aoff + m * 2048 + k * 1024); } while (0)
#define PG8_LDB(dst, b, h) do { _Pragma("unroll") for (int n = 0; n < 2; ++n) _Pragma("unroll") for (int k = 0; k < 2; ++k) dst[n][k] = *(const LAS bf16x8*)(lds + PG8_SB(b, h) + boff + n * 2048 + k * 1024); } while (0)
#define PG8_MMA(ai, bj, At, Bt) do { __builtin_amdgcn_s_setprio(1); _Pragma("unroll") for (int m = 0; m < 4; ++m) _Pragma("unroll") for (int n = 0; n < 2; ++n) _Pragma("unroll") for (int k = 0; k < 2; ++k) \
        acc[ai][bj][m][n] = __builtin_amdgcn_mfma_f32_16x16x32_bf16(Bt[n][k], At[m][k], acc[ai][bj][m][n], 0, 0, 0); __builtin_amdgcn_s_setprio(0); } while (0)
#define PG8_WAIT_V(n) asm volatile("s_waitcnt vmcnt(" #n ")" ::: "memory")
#define PG8_WAIT_L(n) asm volatile("s_waitcnt lgkmcnt(" #n ")" ::: "memory")
#define PG8_BAR __builtin_amdgcn_s_barrier()
#define PG8_SCHED __builtin_amdgcn_sched_barrier(0)
    Unit cur, nxt; int ui = 0;
    if (!S.next(0, cur)) return;
    f32x4 acc[2][2][4][2];
#pragma unroll
    for (int a = 0; a < 2; ++a)
#pragma unroll
        for (int b = 0; b < 2; ++b)
#pragma unroll
            for (int m = 0; m < 4; ++m)
#pragma unroll
                for (int n = 0; n < 2; ++n) acc[a][b][m][n] = (f32x4){0.f, 0.f, 0.f, 0.f};
    bf16x8 At[4][2], B0[2][2], B1[2][2];
    const char* cA = g.a_ptr(cur); const char* cB = g.b_ptr(cur);
    PG8_STAGE(PG8_SB(0, 0), cB, voffB); PG8_STAGE(PG8_SB(0, 1), cB + hstepB, voffB); PG8_STAGE(PG8_SA(0, 0), cA, voffA); PG8_STAGE(PG8_SA(0, 1), cA + hstepA, voffA);
    if (wr == 1) PG8_BAR;
    PG8_WAIT_V(2); PG8_BAR;
    PG8_STAGE(PG8_SB(1, 0), cB + kstep, voffB); PG8_STAGE(PG8_SA(1, 0), cA + kstep, voffA); PG8_STAGE(PG8_SB(1, 1), cB + hstepB + kstep, voffB);
    PG8_WAIT_V(6); PG8_BAR;
    for (;;) {
        const bool has_next = S.next(ui + 1, nxt);
        const char* nA = has_next ? g.a_ptr(nxt) : cA; const char* nB = has_next ? g.b_ptr(nxt) : cB;
        for (int t = 0; t < nt; t += 2) {
            const bool last = (t == nt - 2);
            const char* a1 = cA + (size_t)(t + 1) * kstep;
            const char* a2 = last ? nA : cA + (size_t)(t + 2) * kstep; const char* b2 = last ? nB : cB + (size_t)(t + 2) * kstep;
            const char* a3 = a2 + kstep; const char* b3 = b2 + kstep;
            PG8_LDB(B0, 0, 0); PG8_LDB(B1, 0, 1); PG8_SCHED; PG8_LDA(At, 0, 0); PG8_STAGE(PG8_SA(1, 1), a1 + hstepA, voffA);
            PG8_WAIT_V(8); PG8_WAIT_L(0); PG8_BAR; PG8_MMA(0, 0, At, B0); PG8_MMA(0, 1, At, B1); PG8_BAR; PG8_SCHED;
            PG8_LDA(At, 0, 1); PG8_STAGE(PG8_SB(0, 0), b2, voffB); PG8_STAGE(PG8_SB(0, 1), b2 + hstepB, voffB); PG8_STAGE(PG8_SA(0, 0), a2, voffA);
            PG8_WAIT_V(8); PG8_WAIT_L(0); PG8_BAR; PG8_MMA(1, 0, At, B0); PG8_MMA(1, 1, At, B1); PG8_BAR; PG8_SCHED;
            PG8_LDB(B0, 1, 0); PG8_LDB(B1, 1, 1); PG8_SCHED; PG8_LDA(At, 1, 0); PG8_STAGE(PG8_SA(0, 1), a2 + hstepA, voffA);
            PG8_WAIT_V(8); PG8_WAIT_L(0); PG8_BAR; PG8_MMA(0, 0, At, B0); PG8_MMA(0, 1, At, B1); PG8_BAR; PG8_SCHED;
            PG8_LDA(At, 1, 1); PG8_STAGE(PG8_SB(1, 0), b3, voffB); PG8_STAGE(PG8_SB(1, 1), b3 + hstepB, voffB); PG8_STAGE(PG8_SA(1, 0), a3, voffA);
            PG8_WAIT_V(8); PG8_WAIT_L(0); PG8_BAR; PG8_MMA(1, 0, At, B0); PG8_MMA(1, 1, At, B1); PG8_BAR; PG8_SCHED;
        }
        if constexpr (ALIGN_EPI) { if (wr == 0) PG8_BAR; }
        PG8_SCHED; E(acc, cur, wr, wc, fr, fq); PG8_SCHED;
        if (!has_next) break;
        bool keep_ = false; if constexpr (Epi::DUAL) keep_ = (cur.sel == 0);
        if (!keep_)
#pragma unroll
        for (int a = 0; a < 2; ++a)
#pragma unroll
            for (int b = 0; b < 2; ++b)
#pragma unroll
                for (int m = 0; m < 4; ++m)
#pragma unroll
                    for (int n = 0; n < 2; ++n) acc[a][b][m][n] = (f32x4){0.f, 0.f, 0.f, 0.f};
        cur = nxt; cA = nA; cB = nB; ++ui;
        if constexpr (ALIGN_EPI) { if (wr == 1) PG8_BAR; }
    }
    PG8_WAIT_V(0);
    if constexpr (!ALIGN_EPI) { if (wr == 0) PG8_BAR; }
    PG8_BAR;
#undef PG8_SA
#undef PG8_SB
#undef PG8_STAGE
#undef PG8_LDA
#undef PG8_LDB
#undef PG8_MMA
#undef PG8_WAIT_V
#undef PG8_WAIT_L
#undef PG8_BAR
#undef PG8_SCHED
}
}
using pg8::Unit;
typedef f32x4 Acc[2][2][4][2];


#ifndef ST_AUX
#define ST_AUX 2
#endif
#define ST16(BASE, OFF, VAL) __builtin_amdgcn_raw_buffer_store_b128((VAL), __builtin_amdgcn_make_buffer_rsrc((void*)(BASE), (short)0, 0x7ffffff0, 0x00020000), (int)((unsigned)(OFF) * (unsigned)sizeof(*(BASE))), 0, ST_AUX)
__device__ __forceinline__ void rope4(f32x4& v0, f32x4& v1, const float* rp, int i0) {
    const f32x4 c = *(const f32x4*)(rp + i0), s = *(const f32x4*)(rp + 16 + i0);
    const f32x4 a = v0, b = v1;
    v0[0] = a[0] * c[0] - a[1] * s[0]; v0[1] = a[1] * c[0] + a[0] * s[0];
    v0[2] = a[2] * c[1] - a[3] * s[1]; v0[3] = a[3] * c[1] + a[2] * s[1];
    v1[0] = b[0] * c[2] - b[1] * s[2]; v1[1] = b[1] * c[2] + b[0] * s[2];
    v1[2] = b[2] * c[3] - b[3] * s[3]; v1[3] = b[3] * c[3] + b[2] * s[3];
}
__device__ __forceinline__ float gelu_tanh(float y) { const float z = 0.7978845608028654f * (y + 0.044715f * y * y * y); return y * fsigmoid(2.0f * z); }

struct EpiProj {
    static constexpr bool PERM = true, DUAL = false;
    bf16_t *QA, *KVA, *KR, *LX, *LY, *GATES; float *SSQ, *SSKV; const float* rope;
    __device__ __forceinline__ void operator()(const Acc& acc, const Unit& u, int wr, int wc, int fr, int fq) const {
        const int pn = u.pn, rowt = u.pm * 256 + wr * 64 + fr, cw = wc * 32 + 8 * fq;
        if (pn >= 2) {
            bf16_t* base; int ld, mode;
            if (pn >= 6) { base = GATES + (pn - 6) * 256; ld = 2048; mode = 2; } else if (pn >= 4) { base = LY + (pn - 4) * 256; ld = 512; mode = 1; } else { base = LX + (pn - 2) * 256; ld = 512; mode = 0; }
#pragma unroll
            for (int ai = 0; ai < 2; ++ai)
#pragma unroll
                for (int m = 0; m < 4; ++m) { const unsigned row = rowt + ai * 128 + m * 16;
#pragma unroll
                    for (int bj = 0; bj < 2; ++bj) { f32x4 v0 = acc[ai][bj][m][0], v1 = acc[ai][bj][m][1];
                        if (mode == 2) {
#pragma unroll
                            for (int e = 0; e < 4; ++e) { v0[e] = fsigmoid(v0[e]); v1[e] = fsigmoid(v1[e]); } }
                        else if (mode == 1) {
#pragma unroll
                            for (int e = 0; e < 4; ++e) { v0[e] = gelu_tanh(v0[e]); v1[e] = gelu_tanh(v1[e]); } }
                        ST16(base, row * ld + bj * 128 + cw, pack8(v0, v1)); } }
        } else if (pn == 0) {
#pragma unroll
            for (int ai = 0; ai < 2; ++ai)
#pragma unroll
                for (int m = 0; m < 4; ++m) { const unsigned row = rowt + ai * 128 + m * 16; float ss = 0.f;
#pragma unroll
                    for (int bj = 0; bj < 2; ++bj) { const f32x4 v0 = acc[ai][bj][m][0], v1 = acc[ai][bj][m][1];
                        ss += (v0[0] * v0[0] + v0[1] * v0[1]) + (v0[2] * v0[2] + v0[3] * v0[3]) + (v1[0] * v1[0] + v1[1] * v1[1]) + (v1[2] * v1[2] + v1[3] * v1[3]);
                        ST16(QA, row * 256 + bj * 128 + cw, pack8(v0, v1)); }
                    ss += __shfl_xor(ss, 16); ss += __shfl_xor(ss, 32);
                    if (fq == 0) atomicAdd(SSQ + row, ss); }
        } else {
#pragma unroll
            for (int ai = 0; ai < 2; ++ai)
#pragma unroll
                for (int m = 0; m < 4; ++m) { const unsigned row = rowt + ai * 128 + m * 16;
                    { const f32x4 v0 = acc[ai][0][m][0], v1 = acc[ai][0][m][1];
                      float ss = (v0[0] * v0[0] + v0[1] * v0[1]) + (v0[2] * v0[2] + v0[3] * v0[3]) + (v1[0] * v1[0] + v1[1] * v1[1]) + (v1[2] * v1[2] + v1[3] * v1[3]);
                      ST16(KVA, row * 128 + cw, pack8(v0, v1));
                      ss += __shfl_xor(ss, 16); ss += __shfl_xor(ss, 32);
                      if (fq == 0) atomicAdd(SSKV + row, ss); }
                    if (wc == 0) { f32x4 v0 = acc[ai][1][m][0], v1 = acc[ai][1][m][1];
                      rope4(v0, v1, rope + (row & (SEQ - 1)) * 32, 4 * fq);
                      ST16(KR, row * 32 + 8 * fq, pack8(v0, v1)); } }
        }
    }
};

constexpr float QSCALE = 0.10206207261596577f * 1.4426950408889634f;
struct EpiQ {
    static constexpr bool PERM = true, DUAL = false;
    bf16_t* Q; const float* SSQ; const float* rope;
    __device__ __forceinline__ void operator()(const Acc& acc, const Unit& u, int wr, int wc, int fr, int fq) const {
        const int rowt = u.pm * 256 + wr * 64 + fr;
        const int c00 = u.pn * 256 + wc * 32 + 8 * fq, c01 = c00 + 128, d0 = c00 % 96, d1 = c01 % 96;
#pragma unroll
        for (int am = 0; am < 4; ++am) { const int ai = am >> 1, mb = (am & 1) * 2;
            f32x4 cs[2][2][2]; float ss[2];
#pragma unroll
            for (int mm = 0; mm < 2; ++mm) ss[mm] = SSQ[(unsigned)(rowt + ai * 128 + (mb + mm) * 16)];
#pragma unroll
            for (int mm = 0; mm < 2; ++mm) { const unsigned pos = (unsigned)(rowt + ai * 128 + (mb + mm) * 16) & (SEQ - 1);
#pragma unroll
                for (int bj = 0; bj < 2; ++bj) { const int d = bj ? d1 : d0; if (d >= 64) { const float* rp = rope + (pos * 32 + ((d - 64) >> 1)); cs[mm][bj][0] = *(const f32x4*)rp; cs[mm][bj][1] = *(const f32x4*)(rp + 16); }
                    else { cs[mm][bj][0] = (f32x4){1.f, 1.f, 1.f, 1.f}; cs[mm][bj][1] = (f32x4){0.f, 0.f, 0.f, 0.f}; } } }
#pragma unroll
            for (int mm = 0; mm < 2; ++mm) { const int m = mb + mm; const unsigned row = rowt + ai * 128 + m * 16; const float rstd = rsqrtf(ss[mm] * (1.0f / 256.0f) + EPS) * QSCALE;
#pragma unroll
                for (int bj = 0; bj < 2; ++bj) { const int c0 = bj ? c01 : c00;
                    const f32x4 a = acc[ai][bj][m][0] * rstd, b = acc[ai][bj][m][1] * rstd, c = cs[mm][bj][0], sn = cs[mm][bj][1]; f32x4 v0, v1;
                    v0[0] = a[0] * c[0] - a[1] * sn[0]; v0[1] = a[1] * c[0] + a[0] * sn[0]; v0[2] = a[2] * c[1] - a[3] * sn[1]; v0[3] = a[3] * c[1] + a[2] * sn[1];
                    v1[0] = b[0] * c[2] - b[1] * sn[2]; v1[1] = b[1] * c[2] + b[0] * sn[2]; v1[2] = b[2] * c[3] - b[3] * sn[3]; v1[3] = b[3] * c[3] + b[2] * sn[3];
                    if ((bj ? d1 : d0) < 64) { v0 = a; v1 = b; }
                    ST16(Q, (row * 768 + c0), pack8(v0, v1)); } }
            asm volatile("" ::: "memory"); }
    }
};

struct EpiKV {
    static constexpr bool PERM = true, DUAL = false;
    bf16_t *KN, *V; const float* SSKV;
    __device__ __forceinline__ void operator()(const Acc& acc, const Unit& u, int wr, int wc, int fr, int fq) const {
        const int rowt = u.pm * 256 + wr * 64 + fr; bf16_t* base = (u.pn < 2 ? KN : V) + (u.pn & 1) * 256; const unsigned cw = wc * 32 + 8 * fq;
        float ss[8];
#pragma unroll
        for (int i = 0; i < 8; ++i) ss[i] = SSKV[(unsigned)(rowt + (i >> 2) * 128 + (i & 3) * 16)];
#pragma unroll
        for (int ai = 0; ai < 2; ++ai)
#pragma unroll
            for (int m = 0; m < 4; ++m) { const unsigned row = rowt + ai * 128 + m * 16; const float rstd = rsqrtf(ss[ai * 4 + m] * (1.0f / 128.0f) + EPS);
#pragma unroll
                for (int bj = 0; bj < 2; ++bj) ST16(base, (row * 512 + bj * 128 + cw), pack8(acc[ai][bj][m][0] * rstd, acc[ai][bj][m][1] * rstd)); }
    }
};

__device__ __forceinline__ unsigned pack_h2(float lo, float hi) { const __half2 h = __floats2half2_rn(lo, hi); return *(const unsigned*)&h; }
struct EpiGates {
    static constexpr bool PERM = true, DUAL = false;
    const bf16_t* XC; unsigned* AU; const float *br, *bi, *sp8;
    __device__ __forceinline__ void operator()(const Acc& acc, const Unit& u, int wr, int wc, int fr, int fq) const {
        const int blk = u.pn >> 1, dir = u.pn & 1, rowt = u.pm * 256 + wr * 64 + fr, j0 = wc * 32 + 8 * fq, ch = blk * 128 + j0;
        const float* pbr = br + (dir * 4 + blk) * 128; const float* pbi = bi + (dir * 4 + blk) * 128; const float* psp = sp8 + dir * 512 + blk * 128;
        u32x4 xw[8];
#pragma unroll
        for (int i = 0; i < 8; ++i) xw[i] = *(const u32x4*)(XC + (unsigned)((rowt + (i >> 2) * 128 + (i & 3) * 16) * 512 + ch));
        f32x4 cbr[2], cbi[2], csp[2];
#pragma unroll
        for (int h = 0; h < 2; ++h) { cbr[h] = *(const f32x4*)(pbr + (unsigned)(j0 + 4 * h)); cbi[h] = *(const f32x4*)(pbi + (unsigned)(j0 + 4 * h)); csp[h] = *(const f32x4*)(psp + (unsigned)(j0 + 4 * h)); }
        unsigned* dst = AU + (size_t)dir * T * 512;
#pragma unroll
        for (int ai = 0; ai < 2; ++ai)
#pragma unroll
            for (int m = 0; m < 4; ++m) { const unsigned row = rowt + ai * 128 + m * 16;
                f32x4 x0, x1; unpack8(xw[ai * 4 + m], x0, x1);
                u32x4 o0, o1;
#pragma unroll
                for (int h = 0; h < 2; ++h) { const f32x4 ar = acc[ai][0][m][h] + cbr[h], aiq = acc[ai][1][m][h] + cbi[h], sp = csp[h], xx = h ? x1 : x0; u32x4 o;
#pragma unroll
                    for (int e = 0; e < 4; ++e) { const float rr = fsigmoid(ar[e]), ii = fsigmoid(aiq[e]); const float la = -rr * sp[e], y = 2.0f * la;
                        float m2 = -y * (1.0f + y * (0.5f + y * (0.16666667f + y * (0.041666668f + y * 0.0083333338f))));
                        if (__builtin_expect(__any(y < -0.25f), 0)) m2 = (y < -0.25f) ? 1.0f - __builtin_amdgcn_exp2f(y * LOG2E) : m2;
                        const float uu = ii * xx[e] * __builtin_amdgcn_sqrtf(m2); o[e] = pack_h2(la * LOG2E, uu); }
                    if (h) o1 = o; else o0 = o; }
                ST16(dst, (row * 512 + ch), o0); ST16(dst, (row * 512 + ch + 4), o1); }
    }
};

struct EpiMerge {
    static constexpr bool PERM = true, DUAL = true;
    const bf16_t* GATES; bf16_t* MERGED;
    __device__ __forceinline__ void operator()(Acc& acc, const Unit& u, int wr, int wc, int fr, int fq) const {
        const int rowt = u.pm * 256 + wr * 64 + fr, c0 = u.pn * 256 + wc * 32 + 8 * fq;
#pragma unroll
        for (int ai = 0; ai < 2; ++ai) {
            u32x4 gw_[4][2], hw_[4][2];
#pragma unroll
            for (int m = 0; m < 4; ++m)
#pragma unroll
                for (int bj = 0; bj < 2; ++bj) { const unsigned o = (unsigned)((rowt + ai * 128 + m * 16) * 2048 + c0 + bj * 128);
                    gw_[m][bj] = *(const u32x4*)(GATES + (o + 1024)); if (u.sel == 0) hw_[m][bj] = *(const u32x4*)(GATES + o); else hw_[m][bj] = gw_[m][bj]; }
#pragma unroll
            for (int m = 0; m < 4; ++m) { const unsigned row = rowt + ai * 128 + m * 16;
#pragma unroll
                for (int bj = 0; bj < 2; ++bj) { f32x4 r0, r1, a0, a1; unpack8(gw_[m][bj], r0, r1); unpack8(hw_[m][bj], a0, a1);
                    if (u.sel == 0) {
#pragma unroll
                        for (int e = 0; e < 4; ++e) { acc[ai][bj][m][0][e] *= a0[e] * __builtin_amdgcn_rcpf(r0[e]); acc[ai][bj][m][1][e] *= a1[e] * __builtin_amdgcn_rcpf(r1[e]); } }
                    else { ST16(MERGED, (row * 1024 + c0 + bj * 128), pack8(acc[ai][bj][m][0] * r0, acc[ai][bj][m][1] * r1)); } } }
            asm volatile("" ::: "memory"); }
    }
};

struct EpiOut {
    static constexpr bool PERM = true, DUAL = false;
    const float* X; bf16_t* X1B; float* SS2;
    __device__ __forceinline__ void operator()(const Acc& acc, const Unit& u, int wr, int wc, int fr, int fq) const {
        const int rowt = u.pm * 256 + wr * 64 + fr, c0 = u.pn * 256 + wc * 32 + 8 * fq;
#pragma unroll
        for (int ai = 0; ai < 2; ++ai) {
            f32x4 xv[4][2][2];
#pragma unroll
            for (int m = 0; m < 4; ++m)
#pragma unroll
                for (int bj = 0; bj < 2; ++bj) { const unsigned o = (rowt + ai * 128 + m * 16) * 1024 + c0 + bj * 128; xv[m][bj][0] = __builtin_nontemporal_load((const f32x4*)(X + o)); xv[m][bj][1] = __builtin_nontemporal_load((const f32x4*)(X + (o + 4))); }
#pragma unroll
            for (int m = 0; m < 4; ++m) { const unsigned row = rowt + ai * 128 + m * 16; float ss = 0.f;
#pragma unroll
                for (int bj = 0; bj < 2; ++bj) { const unsigned o = row * 1024 + c0 + bj * 128;
                    const f32x4 v0 = acc[ai][bj][m][0] + xv[m][bj][0], v1 = acc[ai][bj][m][1] + xv[m][bj][1];
                    ss += (v0[0] * v0[0] + v0[1] * v0[1]) + (v0[2] * v0[2] + v0[3] * v0[3]) + (v1[0] * v1[0] + v1[1] * v1[1]) + (v1[2] * v1[2] + v1[3] * v1[3]);
                    ST16(X1B, o, pack8(v0, v1)); }
                ss += __shfl_xor(ss, 16); ss += __shfl_xor(ss, 32);
                if (fq == 0) atomicAdd(SS2 + row, ss); }
            asm volatile("" ::: "memory"); }
    }
};

struct EpiFfn {
    static constexpr bool PERM = true, DUAL = false;
    bf16_t* HID; const float* SS2;
    __device__ __forceinline__ void operator()(const Acc& acc, const Unit& u, int wr, int wc, int fr, int fq) const {
        const int rowt = u.pm * 256 + wr * 64 + fr, c0 = u.pn * 128 + wc * 32 + 8 * fq;
        float ss[8];
#pragma unroll
        for (int i = 0; i < 8; ++i) ss[i] = SS2[(unsigned)(rowt + (i >> 2) * 128 + (i & 3) * 16)];
#pragma unroll
        for (int ai = 0; ai < 2; ++ai)
#pragma unroll
            for (int m = 0; m < 4; ++m) { const unsigned row = rowt + ai * 128 + m * 16; const float rstd = rsqrtf(ss[ai * 4 + m] * (1.0f / 1024.0f) + EPS);
                f32x4 h0, h1;
#pragma unroll
                for (int e = 0; e < 4; ++e) { const float g0 = acc[ai][0][m][0][e] * rstd, g1 = acc[ai][0][m][1][e] * rstd;
                    h0[e] = g0 * fsigmoid(g0) * (acc[ai][1][m][0][e] * rstd); h1[e] = g1 * fsigmoid(g1) * (acc[ai][1][m][1][e] * rstd); }
                ST16(HID, (row * DFF + c0), pack8(h0, h1)); }
    }
};

struct EpiDown {
    static constexpr bool PERM = true, DUAL = false;
    bf16_t* X1B; float* SS3;
    __device__ __forceinline__ void operator()(const Acc& acc, const Unit& u, int wr, int wc, int fr, int fq) const {
        const int rowt = u.pm * 256 + wr * 64 + fr, c0 = u.pn * 256 + wc * 32 + 8 * fq;
        u32x4 xv[8][2];
#pragma unroll
        for (int i = 0; i < 8; ++i)
#pragma unroll
            for (int bj = 0; bj < 2; ++bj) xv[i][bj] = *(const u32x4*)(X1B + (unsigned)((rowt + (i >> 2) * 128 + (i & 3) * 16) * 1024 + c0 + bj * 128));
#pragma unroll
        for (int ai = 0; ai < 2; ++ai)
#pragma unroll
            for (int m = 0; m < 4; ++m) { const unsigned row = rowt + ai * 128 + m * 16; float ss = 0.f;
#pragma unroll
                for (int bj = 0; bj < 2; ++bj) { const unsigned o = row * 1024 + c0 + bj * 128; f32x4 p0, p1; unpack8(xv[ai * 4 + m][bj], p0, p1);
                    const f32x4 v0 = acc[ai][bj][m][0] + p0, v1 = acc[ai][bj][m][1] + p1;
                    ss += (v0[0] * v0[0] + v0[1] * v0[1]) + (v0[2] * v0[2] + v0[3] * v0[3]) + (v1[0] * v1[0] + v1[1] * v1[1]) + (v1[2] * v1[2] + v1[3] * v1[3]);
                    ST16(X1B, o, pack8(v0, v1)); }
                ss += __shfl_xor(ss, 16); ss += __shfl_xor(ss, 32);
                if (fq == 0) atomicAdd(SS3 + row, ss); }
    }
};

namespace att {
constexpr int NW = 8, QBLK = 32, KVBLK = 64;
constexpr float SCALE = 0.10206207261596577f;
constexpr float THR = 8.f;
constexpr int SHM_V = 16384, SHM_K = 16384;
#define KSWZ(row, colB) ((row) * 256 + ((colB) ^ (((row) & 7) << 4)))
#define SBAR() __builtin_amdgcn_sched_barrier(0)
__device__ __forceinline__ int crow(int r, int hi) { return (r & 3) + 8 * (r >> 2) + 4 * hi; }
template <bool FIRST> __device__ __forceinline__ void partialSM(f32x16& p0, f32x16& p1, float& mref, f32x16& negm, float& alpha) {
  constexpr float THRL = THR * 1.4426950408889634f;
  float pmax = p0[0];
#pragma unroll
  for (int r = 1; r < 16; ++r) pmax = fmaxf(pmax, p0[r]);
#pragma unroll
  for (int r = 0; r < 16; ++r) pmax = fmaxf(pmax, p1[r]);
  { auto rr = __builtin_amdgcn_permlane32_swap(__float_as_uint(pmax), __float_as_uint(pmax), false, false);
    pmax = fmaxf(__uint_as_float(rr[0]), __uint_as_float(rr[1])); }
  if (!FIRST && __builtin_expect(__all(pmax <= THRL), 1)) { alpha = 1.f; }
  else { const float dl = FIRST ? pmax : fmaxf(pmax, 0.f); mref += dl; alpha = FIRST ? 1.f : __builtin_amdgcn_exp2f(-dl);
#pragma unroll
    for (int r = 0; r < 16; ++r) { p0[r] -= dl; p1[r] -= dl; }
    const float nm = -mref;
#pragma unroll
    for (int r = 0; r < 16; ++r) negm[r] = nm; }
#pragma unroll
  for (int r = 0; r < 16; ++r) p0[r] = __builtin_amdgcn_exp2f(p0[r]);
}
__device__ __forceinline__ void finishSM(f32x16& p0, f32x16& p1, float alpha, float& l_reg, bf16x8& pa0, bf16x8& pa1, bf16x8& pa2, bf16x8& pa3) {
#pragma unroll
  for (int r = 0; r < 16; ++r) p1[r] = __builtin_amdgcn_exp2f(p1[r]);
  float ps = 0;
#pragma unroll
  for (int r = 0; r < 16; ++r) ps += p0[r];
#pragma unroll
  for (int r = 0; r < 16; ++r) ps += p1[r];
  { auto rr = __builtin_amdgcn_permlane32_swap(__float_as_uint(ps), __float_as_uint(ps), false, false);
    ps = __uint_as_float(rr[0]) + __uint_as_float(rr[1]); }
  l_reg = l_reg * alpha + ps;
#define PK4(P, BASE, OUT) do { u32x4 w = {cvt_pk_bf16(P[BASE + 0], P[BASE + 1]), cvt_pk_bf16(P[BASE + 2], P[BASE + 3]), cvt_pk_bf16(P[BASE + 4], P[BASE + 5]), cvt_pk_bf16(P[BASE + 6], P[BASE + 7])}; \
    OUT = *reinterpret_cast<bf16x8*>(&w); } while (0)
  PK4(p0, 0, pa0); PK4(p0, 8, pa1); PK4(p1, 0, pa2); PK4(p1, 8, pa3);
#undef PK4
}
__device__ __forceinline__ void qkt(f32x16& p0, f32x16& p1, const char* Ks, const bf16x8* qr, const f32x16& negm, int r32, int hi) {
  p0 = negm; p1 = negm;
#pragma unroll
  for (int d0 = 0; d0 < 6; ++d0) { int cb = (d0 * 16 + hi * 8) * 2;
    bf16x8 b0 = *reinterpret_cast<const bf16x8*>(Ks + KSWZ(r32, cb));
    bf16x8 b1 = *reinterpret_cast<const bf16x8*>(Ks + KSWZ(32 + r32, cb));
    p0 = __builtin_amdgcn_mfma_f32_32x32x16_bf16(b0, qr[d0], p0, 0, 0, 0);
    p1 = __builtin_amdgcn_mfma_f32_32x32x16_bf16(b1, qr[d0], p1, 0, 0, 0); }
}
__device__ __forceinline__ int v_st(int k, int c) { const int kk = k; return ((kk >> 3) * 4 + (c >> 5)) * 512 + ((kk & 7) * 32 + (c & 31)) * 2; }
__device__ __forceinline__ int v_rd_base(int lane) { return ((lane & 3) << 3) | (((lane >> 2) & 3) << 6) | (((lane >> 4) & 1) << 5) | (((lane >> 5) & 1) << 8); }
constexpr int v_rd_off(int d0, int ks, int half) { return d0 * 512 + ks * 4096 + half * 2048; }
typedef short v4i16_t __attribute__((ext_vector_type(4)));
typedef LAS const char* lds_cptr;
__device__ __forceinline__ s16x4 vtr(lds_cptr p) { return __builtin_bit_cast(s16x4, __builtin_amdgcn_ds_read_tr16_b64_v4i16((LAS v4i16_t*)p)); }
template <int D0> __device__ __forceinline__ void pv_one(f32x16& od, lds_cptr vp, bf16x8 pa0, bf16x8 pa1, bf16x8 pa2, bf16x8 pa3) {
  const s16x4 l0 = vtr(vp + v_rd_off(D0, 0, 0)), h0 = vtr(vp + v_rd_off(D0, 0, 1)), l1 = vtr(vp + v_rd_off(D0, 1, 0)), h1 = vtr(vp + v_rd_off(D0, 1, 1));
  const s16x4 l2 = vtr(vp + v_rd_off(D0, 2, 0)), h2 = vtr(vp + v_rd_off(D0, 2, 1)), l3 = vtr(vp + v_rd_off(D0, 3, 0)), h3 = vtr(vp + v_rd_off(D0, 3, 1));
#define PK(L, H) (bf16x8){L[0], L[1], L[2], L[3], H[0], H[1], H[2], H[3]}
  od = __builtin_amdgcn_mfma_f32_32x32x16_bf16(pa0, PK(l0, h0), od, 0, 0, 0);
  od = __builtin_amdgcn_mfma_f32_32x32x16_bf16(pa1, PK(l1, h1), od, 0, 0, 0);
  od = __builtin_amdgcn_mfma_f32_32x32x16_bf16(pa2, PK(l2, h2), od, 0, 0, 0);
  od = __builtin_amdgcn_mfma_f32_32x32x16_bf16(pa3, PK(l3, h3), od, 0, 0, 0);
#undef PK
}
__device__ __forceinline__ void pv_d0(f32x16* o, lds_cptr vp, bf16x8 pa0, bf16x8 pa1, bf16x8 pa2, bf16x8 pa3) {
  pv_one<0>(o[0], vp, pa0, pa1, pa2, pa3); pv_one<1>(o[1], vp, pa0, pa1, pa2, pa3);
}
__device__ __forceinline__ void attn_unit(const bf16_t* __restrict__ Qb, const bf16_t* __restrict__ KNh, const bf16_t* __restrict__ KRb, const bf16_t* __restrict__ Vh, bf16_t* __restrict__ Ob, char* lds) {
  const int tid = threadIdx.x, wid = tid >> 6, lane = tid & 63, r32 = lane & 31, hi = lane >> 5;
#define ABAR() asm volatile("s_waitcnt lgkmcnt(0)\n\ts_barrier" ::: "memory")
  char* V_lds = lds; char* K_lds = lds + 4 * SHM_V;
  float* ws = (float*)(lds + 4 * SHM_V + 4 * SHM_K) + wid * 64; float* li_l = ws; float* al_l = ws + 32;
  float mref = 0.f, l_reg = 0; f32x16 negm = {}; f32x16 o[2] = {}; bf16x8 qr[6];
  const bf16_t* Qw = Qb + (long)(wid * QBLK + r32) * 768 + hi * 8;
#pragma unroll
  for (int d0 = 0; d0 < 6; ++d0) qr[d0] = *reinterpret_cast<const bf16x8*>(Qw + d0 * 16);
  const int sr = tid >> 3, sc = (tid & 7) * 8, vst = v_st(sr, sc), kst = KSWZ(sr, sc * 2), krst = KSWZ(sr, 128 + (tid & 7) * 8);
  const lds_cptr vb0 = (lds_cptr)(LAS char*)lds + v_rd_base(lane);
  struct { bf16x8 vs, ks; s16x4 kr; } sr_[2];
  const unsigned lo_kv = (unsigned)(sr * 512 + sc), lo_kr = (unsigned)(sr * 32 + (tid & 7) * 4);
#define SLOAD(i, k0) do { const bf16_t* vt_ = Vh + (size_t)(k0) * 512; const bf16_t* kt_ = KNh + (size_t)(k0) * 512; const bf16_t* rt_ = KRb + (size_t)(k0) * 32; \
    sr_[i].vs = *reinterpret_cast<const bf16x8*>(vt_ + lo_kv); sr_[i].ks = *reinterpret_cast<const bf16x8*>(kt_ + lo_kv); sr_[i].kr = *reinterpret_cast<const s16x4*>(rt_ + lo_kr); } while (0)
#define SWRITE(slot, i) do { *(bf16x8*)(V_lds + (slot) * SHM_V + vst) = sr_[i].vs; *(bf16x8*)(K_lds + (slot) * SHM_K + kst) = sr_[i].ks; *(s16x4*)(K_lds + (slot) * SHM_K + krst) = sr_[i].kr; } while (0)
#define RESC(a) do { if (__any((a) < 1.f)) { if (hi == 0) al_l[r32] = (a); asm volatile("s_waitcnt lgkmcnt(0)" ::: "memory"); \
    _Pragma("unroll") for (int d = 0; d < 2; ++d) _Pragma("unroll") for (int r = 0; r < 16; ++r) o[d][r] *= al_l[crow(r, hi)]; } } while (0)
  f32x16 pA0, pA1, pB0, pB1; float alA, alB; bf16x8 pa0, pa1, pa2, pa3; constexpr int NT = SEQ / KVBLK;
  SLOAD(0, 0); SLOAD(1, KVBLK); asm volatile("s_waitcnt vmcnt(0)" ::: "memory"); SWRITE(0, 0); SWRITE(1, 1); SLOAD(0, 2 * KVBLK); ABAR();
  qkt(pA0, pA1, K_lds, qr, negm, r32, hi); partialSM<true>(pA0, pA1, mref, negm, alA);
  SWRITE(2, 0); SLOAD(1, 3 * KVBLK); ABAR();
  for (int j = 1; j + 1 < NT; j += 2) {
    SBAR(); qkt(pB0, pB1, K_lds + (j & 3) * SHM_K, qr, negm, r32, hi);
    finishSM(pA0, pA1, alA, l_reg, pa0, pa1, pa2, pa3); SBAR();
    if (j + 2 < NT) { SWRITE((j + 2) & 3, 1); } if (j + 3 < NT) { SLOAD(0, (j + 3) * KVBLK); } SBAR();
    pv_d0(o, vb0 + ((j - 1) & 3) * SHM_V, pa0, pa1, pa2, pa3); partialSM<false>(pB0, pB1, mref, negm, alB);
    RESC(alB); ABAR();
    SBAR(); qkt(pA0, pA1, K_lds + ((j + 1) & 3) * SHM_K, qr, negm, r32, hi);
    finishSM(pB0, pB1, alB, l_reg, pa0, pa1, pa2, pa3); SBAR();
    if (j + 3 < NT) { SWRITE((j + 3) & 3, 0); } if (j + 4 < NT) { SLOAD(1, (j + 4) * KVBLK); } SBAR();
    pv_d0(o, vb0 + (j & 3) * SHM_V, pa0, pa1, pa2, pa3); partialSM<false>(pA0, pA1, mref, negm, alA);
    RESC(alA); ABAR();
  }
  SBAR(); qkt(pB0, pB1, K_lds + ((NT - 1) & 3) * SHM_K, qr, negm, r32, hi);
  finishSM(pA0, pA1, alA, l_reg, pa0, pa1, pa2, pa3); SBAR();
  pv_d0(o, vb0 + ((NT - 2) & 3) * SHM_V, pa0, pa1, pa2, pa3); partialSM<false>(pB0, pB1, mref, negm, alB);
  RESC(alB);
  finishSM(pB0, pB1, alB, l_reg, pa0, pa1, pa2, pa3); SBAR();
  pv_d0(o, vb0 + ((NT - 1) & 3) * SHM_V, pa0, pa1, pa2, pa3);
  if (hi == 0) li_l[r32] = l_reg; asm volatile("s_waitcnt lgkmcnt(0)" ::: "memory");
  float rli[16];
#pragma unroll
  for (int r = 0; r < 16; ++r) rli[r] = __builtin_amdgcn_rcpf(li_l[crow(r, hi)]);
  bf16_t* Ow = Ob + (long)(wid * QBLK) * 512;
#pragma unroll
  for (int r = 0; r < 16; ++r) { int orow = crow(r, hi);
#pragma unroll
    for (int d0 = 0; d0 < 2; ++d0) Ow[(long)orow * 512 + d0 * 32 + r32] = (bf16_t)(cvt_pk_bf16(o[d0][r] * rli[r], 0.f) & 0xffffu); }
  ABAR();
#undef SLOAD
#undef SWRITE
#undef RESC
#undef ABAR
}
#undef KSWZ
#undef SBAR
}

__device__ __forceinline__ void h2f(unsigned w, float& lo, float& hi) { const __half2 h = *(const __half2*)&w; const float2 f = __half22float2(h); lo = f.x; hi = f.y; }
__device__ __forceinline__ void scan_item(int b, int cgp, unsigned* AU, const bf16_t* LY, bf16_t* REC, float* sc) {
    const int tid = threadIdx.x, wid = tid >> 6, lane = tid & 63, c = cgp * 64 + lane;
    const unsigned r0 = (unsigned)b * SEQ + wid * 256;
    unsigned* au0 = AU + c; unsigned* au1 = AU + (size_t)T * 512 + c; const bf16_t* ly = LY + c; bf16_t* rec = REC + c;
#define SC_STEP(W, H) do { float la_, u_; h2f(W, la_, u_); H = __builtin_amdgcn_exp2f(la_) * H + u_; } while (0)
    { float hf = 0.f, hb = 0.f, slf = 0.f, slb = 0.f; unsigned fa[16], ba[16], fb[16], bb[16];
#pragma unroll
      for (int k = 0; k < 16; ++k) { fa[k] = au0[(r0 + k) * 512]; ba[k] = au1[(r0 + 255 - k) * 512]; }
#pragma unroll 1
      for (int blk = 0; blk < 16; blk += 2) {
#pragma unroll
          for (int k = 0; k < 16; ++k) { fb[k] = au0[(r0 + (blk + 1) * 16 + k) * 512]; bb[k] = au1[(r0 + 255 - ((blk + 1) * 16 + k)) * 512]; }
#pragma unroll
          for (int k = 0; k < 16; ++k) { float la, u; h2f(fa[k], la, u); hf = __builtin_amdgcn_exp2f(la) * hf + u; slf += la; h2f(ba[k], la, u); hb = __builtin_amdgcn_exp2f(la) * hb + u; slb += la; }
          if (blk + 2 < 16) {
#pragma unroll
              for (int k = 0; k < 16; ++k) { fa[k] = au0[(r0 + (blk + 2) * 16 + k) * 512]; ba[k] = au1[(r0 + 255 - ((blk + 2) * 16 + k)) * 512]; } }
#pragma unroll
          for (int k = 0; k < 16; ++k) { float la, u; h2f(fb[k], la, u); hf = __builtin_amdgcn_exp2f(la) * hf + u; slf += la; h2f(bb[k], la, u); hb = __builtin_amdgcn_exp2f(la) * hb + u; slb += la; }
      }
      sc[wid * 64 + lane] = __builtin_amdgcn_exp2f(slf); sc[1024 + wid * 64 + lane] = hf;
      sc[(8 + wid) * 64 + lane] = __builtin_amdgcn_exp2f(slb); sc[1024 + (8 + wid) * 64 + lane] = hb; }
    __syncthreads();
    float cin0 = 0.f, cin1 = 0.f;
    for (int k = 0; k < wid; ++k) cin0 = sc[k * 64 + lane] * cin0 + sc[1024 + k * 64 + lane];
    for (int k = 7; k > wid; --k) cin1 = sc[(8 + k) * 64 + lane] * cin1 + sc[1024 + (8 + k) * 64 + lane];
    { float h = cin0; unsigned wa[16], wb[16];
#pragma unroll
      for (int k = 0; k < 16; ++k) wa[k] = au0[(r0 + k) * 512];
#pragma unroll 1
      for (int blk = 0; blk < 16; blk += 2) {
#pragma unroll
          for (int k = 0; k < 16; ++k) wb[k] = au0[(r0 + (blk + 1) * 16 + k) * 512];
#pragma unroll
          for (int k = 0; k < 16; ++k) { SC_STEP(wa[k], h); rec[(r0 + blk * 16 + k) * 512] = (bf16_t)(cvt_pk_bf16(h, 0.f) & 0xffffu); }
          if (blk + 2 < 16) {
#pragma unroll
              for (int k = 0; k < 16; ++k) wa[k] = au0[(r0 + (blk + 2) * 16 + k) * 512]; }
#pragma unroll
          for (int k = 0; k < 16; ++k) { SC_STEP(wb[k], h); rec[(r0 + (blk + 1) * 16 + k) * 512] = (bf16_t)(cvt_pk_bf16(h, 0.f) & 0xffffu); }
      } }
    { float h = cin1; unsigned wa[16], wb[16]; bf16_t fa[16], fb[16], ya[16], yb[16];
#pragma unroll
      for (int k = 0; k < 16; ++k) { const unsigned row = r0 + 255 - k; wa[k] = au1[row * 512]; fa[k] = rec[row * 512]; ya[k] = ly[row * 512]; }
#pragma unroll 1
      for (int blk = 0; blk < 16; blk += 2) {
#pragma unroll
          for (int k = 0; k < 16; ++k) { const unsigned row = r0 + 255 - ((blk + 1) * 16 + k); wb[k] = au1[row * 512]; fb[k] = rec[row * 512]; yb[k] = ly[row * 512]; }
#pragma unroll
          for (int k = 0; k < 16; ++k) { const unsigned row = r0 + 255 - (blk * 16 + k); SC_STEP(wa[k], h);
              const float tot = (h + __uint_as_float((unsigned)fa[k] << 16)) * __uint_as_float((unsigned)ya[k] << 16); rec[row * 512] = (bf16_t)(cvt_pk_bf16(tot, 0.f) & 0xffffu); }
          if (blk + 2 < 16) {
#pragma unroll
              for (int k = 0; k < 16; ++k) { const unsigned row = r0 + 255 - ((blk + 2) * 16 + k); wa[k] = au1[row * 512]; fa[k] = rec[row * 512]; ya[k] = ly[row * 512]; } }
#pragma unroll
          for (int k = 0; k < 16; ++k) { const unsigned row = r0 + 255 - ((blk + 1) * 16 + k); SC_STEP(wb[k], h);
              const float tot = (h + __uint_as_float((unsigned)fb[k] << 16)) * __uint_as_float((unsigned)yb[k] << 16); rec[row * 512] = (bf16_t)(cvt_pk_bf16(tot, 0.f) & 0xffffu); }
      } }
#undef SC_STEP
    __syncthreads();
}

template <class F> __device__ __forceinline__ void xpose(bf16_t* Bt, int N, int K, F f, int gw, int NGW, int lane) {
    const int nN = N / 64, total = nN * (K / 8);
    for (int item = gw; item < total; item += NGW) { const int ng = item % nN, kc = item / nN, n = ng * 64 + lane, k0 = kc * 8;
        float v[8];
#pragma unroll
        for (int e = 0; e < 8; ++e) v[e] = f(n, k0 + e);
        u32x4 w; w.x = cvt_pk_bf16(v[0], v[1]); w.y = cvt_pk_bf16(v[2], v[3]); w.z = cvt_pk_bf16(v[4], v[5]); w.w = cvt_pk_bf16(v[6], v[7]);
        *(u32x4*)(Bt + (size_t)n * K + k0) = w; }
}


template <class F> __device__ __forceinline__ void xpose_one(bf16_t* Bt, int N, int K, F f, int item, int lane) {
    const int nN = N / 64, n = (item % nN) * 64 + lane, k0 = (item / nN) * 8;
    float v[8];
#pragma unroll
    for (int e = 0; e < 8; ++e) v[e] = f(n, k0 + e);
    u32x4 w; w.x = cvt_pk_bf16(v[0], v[1]); w.y = cvt_pk_bf16(v[2], v[3]); w.z = cvt_pk_bf16(v[4], v[5]); w.w = cvt_pk_bf16(v[6], v[7]);
    *(u32x4*)(Bt + (size_t)n * K + k0) = w;
}

#define XB_TMO      128
#define XB_XCNT(j)  (256  + 64 * (j))
#define XB_XSUB(j)  (1280 + 64 * (j))
#define XB_XGEN(j)  (2304 + 64 * (j))
#define XB_TOP      3328
#define XB_TOPGEN   3392
#define XCD_BAR_WORDS 3456
#define XB_SPIN_CAP (1u << 18)
__device__ __forceinline__ unsigned xb_ld(unsigned* p)              { return __hip_atomic_load(p, __ATOMIC_RELAXED, __HIP_MEMORY_SCOPE_AGENT); }
__device__ __forceinline__ unsigned xb_add(unsigned* p, unsigned v) { return __hip_atomic_fetch_add(p, v, __ATOMIC_RELAXED, __HIP_MEMORY_SCOPE_AGENT); }
__device__ __forceinline__ unsigned xb_xcc_id() { return (unsigned)__builtin_amdgcn_s_getreg((3 << 11) | 20) & 0xFu; }
#define XB_SPIN(cond, bar) do { unsigned _sp = 0; while (cond) { __builtin_amdgcn_s_sleep(1); \
    if ((++_sp & 255u) == 0u) { if (xb_ld(&(bar)[XB_TMO])) break; if (_sp > XB_SPIN_CAP) { atomicAdd(&(bar)[XB_TMO], 1u); break; } } } } while (0)
struct XcdBarrier { unsigned* bar; unsigned x; volatile LAS unsigned* st; };
__device__ __forceinline__ XcdBarrier xcd_barrier_post(unsigned* bar, volatile LAS unsigned* st) {
    XcdBarrier b; b.bar = bar; b.x = xb_xcc_id(); b.st = st;
    if (threadIdx.x == 0) (void)xb_add(&bar[XB_XCNT(b.x)], 1u);
    return b;
}
__device__ __forceinline__ void xcd_barrier_complete(unsigned* bar, unsigned x, unsigned& nloc, unsigned& nx) {
    const unsigned G = gridDim.x * gridDim.y * gridDim.z;
    unsigned sum, cnt, mine, sp = 0u;
    for (;;) {
        sum = 0u; cnt = 0u; mine = 0u;
#pragma unroll
        for (unsigned j = 0; j < 16; ++j) { const unsigned c = xb_ld(&bar[XB_XCNT(j)]); sum += c; cnt += (c > 0u) ? 1u : 0u; mine = (j == x) ? c : mine; }
        if (sum == G) break;
        __builtin_amdgcn_s_sleep(1);
        if ((++sp & 255u) == 0u) { if (xb_ld(&bar[XB_TMO])) break; if (sp > XB_SPIN_CAP) { atomicAdd(&bar[XB_TMO], 1u); break; } }
    }
    nloc = mine > 0u ? mine : 1u; nx = cnt > 0u ? cnt : 1u;
}
__device__ __forceinline__ void xcd_barrier(const XcdBarrier& b) {
    asm volatile("s_waitcnt vmcnt(0)" ::: "memory");
    __syncthreads();
    if (threadIdx.x == 0) {
        unsigned* bar = b.bar;
        __builtin_amdgcn_s_waitcnt(0);
        unsigned nloc = b.st[0], nx = b.st[1];
        if (nloc == 0u) { xcd_barrier_complete(bar, b.x, nloc, nx); b.st[0] = nloc; b.st[1] = nx; }
        const unsigned old = xb_add(&bar[XB_XSUB(b.x)], 1u);
        const unsigned gen = old / nloc;
        if (old + 1u == (gen + 1u) * nloc) {
            __builtin_amdgcn_fence(__ATOMIC_RELEASE, "agent");
            asm volatile("s_waitcnt vmcnt(0)" ::: "memory");
            const unsigned og = xb_add(&bar[XB_TOP], 1u);
            const unsigned tg = og / nx;
            if (og + 1u == (tg + 1u) * nx) xb_add(&bar[XB_TOPGEN], 1u);
            else XB_SPIN(xb_ld(&bar[XB_TOPGEN]) == tg, bar);
            __builtin_amdgcn_fence(__ATOMIC_ACQUIRE, "agent");
            xb_add(&bar[XB_XGEN(b.x)], 1u);
            asm volatile("s_waitcnt vmcnt(0)" ::: "memory");
        } else {
            XB_SPIN(xb_ld(&bar[XB_XGEN(b.x)]) == gen, bar);
            __builtin_amdgcn_fence(__ATOMIC_ACQUIRE, "agent");
            asm volatile("s_waitcnt vmcnt(0)" ::: "memory");
        }
    }
    __syncthreads();
}

constexpr size_t MiB = 1u << 20;
constexpr size_t WS_SS = 0;
constexpr size_t WS_ROPE = 1 * MiB;
constexpr size_t WS_SP8 = WS_ROPE + 256 * 1024;
constexpr size_t WS_BAR = 1 * MiB + 512 * 1024;
constexpr size_t WS_WIN = 2 * MiB;
constexpr size_t WS_WQB = 9 * MiB;
constexpr size_t WS_WKVB = WS_WQB + 512 * 1024;
constexpr size_t WS_WG = 10 * MiB;
constexpr size_t WS_WOA = 11 * MiB;
constexpr size_t WS_WOL = 12 * MiB;
constexpr size_t WS_WOUT = 13 * MiB;
constexpr size_t WS_WGU = 15 * MiB;
constexpr size_t WS_WD = 26 * MiB;
constexpr size_t WS_A = 40 * MiB;
constexpr size_t WS_GATES = 168 * MiB;
constexpr size_t WS_LY = 424 * MiB;
constexpr size_t WS_LX = 488 * MiB;
constexpr size_t WS_QA = 552 * MiB;
constexpr size_t WS_KVA = 584 * MiB;
constexpr size_t WS_KN = 616 * MiB;
constexpr size_t WS_V = 680 * MiB;
constexpr size_t WS_KR = 744 * MiB;
constexpr size_t WS_XC = 748 * MiB;
constexpr size_t WS_X1B = 616 * MiB;
constexpr size_t WS_HID = 168 * MiB;
constexpr size_t WS_END = 812 * MiB;

struct Args { const float* in[22]; float* out; unsigned char* ws; int ph_lo, ph_hi; };

__global__ void __launch_bounds__(512, 2) mega_fwd(Args args) {
    extern __shared__ __attribute__((aligned(16))) unsigned char lds_raw[];
    LAS unsigned char* lds = (LAS unsigned char*)lds_raw;
    const int tid = threadIdx.x;
#define PHASE_IDS const int lane = threadIdx.x & 63, wave = __builtin_amdgcn_readfirstlane(threadIdx.x >> 6), gw = bid * 8 + wave, NGW = G * 8, gtid = bid * 512 + (int)threadIdx.x, NTH = G * 512; (void)lane; (void)gw; (void)NGW; (void)gtid; (void)NTH
    const int G = gridDim.x, bid = blockIdx.x;
    unsigned char* ws = args.ws;
    float* SSQ = (float*)(ws + WS_SS); float* SSKV = SSQ + T; float* SS2 = SSKV + T; float* SS3 = SS2 + T;
    float* ROPE = (float*)(ws + WS_ROPE); float* SP8 = (float*)(ws + WS_SP8);
    bf16_t* WIN = (bf16_t*)(ws + WS_WIN); bf16_t* WQB = (bf16_t*)(ws + WS_WQB); bf16_t* WKVB = (bf16_t*)(ws + WS_WKVB); bf16_t* WG = (bf16_t*)(ws + WS_WG);
    bf16_t* WOA = (bf16_t*)(ws + WS_WOA); bf16_t* WOL = (bf16_t*)(ws + WS_WOL); bf16_t* WOUT = (bf16_t*)(ws + WS_WOUT); bf16_t* WGU = (bf16_t*)(ws + WS_WGU); bf16_t* WD = (bf16_t*)(ws + WS_WD);
    bf16_t* XN = (bf16_t*)(ws + WS_A); bf16_t* Qb = (bf16_t*)(ws + WS_A); bf16_t* MERGED = (bf16_t*)(ws + WS_A);
    bf16_t* GATES = (bf16_t*)(ws + WS_GATES); bf16_t* LY = (bf16_t*)(ws + WS_LY); bf16_t* LX = (bf16_t*)(ws + WS_LX); bf16_t* ATT = (bf16_t*)(ws + WS_LX);
    bf16_t* QA = (bf16_t*)(ws + WS_QA); bf16_t* KVA = (bf16_t*)(ws + WS_KVA); bf16_t* REC = (bf16_t*)(ws + WS_QA);
    bf16_t* KN = (bf16_t*)(ws + WS_KN); bf16_t* Vb = (bf16_t*)(ws + WS_V); bf16_t* KR = (bf16_t*)(ws + WS_KR); bf16_t* XC = (bf16_t*)(ws + WS_XC);
    bf16_t* X1B = (bf16_t*)(ws + WS_X1B); bf16_t* HID = (bf16_t*)(ws + WS_HID);
    unsigned* AU = (unsigned*)args.out;
    const int lo = args.ph_lo, hi = args.ph_hi;
    volatile LAS unsigned* xst = (volatile LAS unsigned*)(lds + 140032);
    if (tid < 2) xst[tid] = 0u;
    __syncthreads();
    XcdBarrier xbar; xbar.bar = (unsigned*)(ws + WS_BAR); xbar.x = 0; xbar.st = xst;
    if (hi - lo > 1) xbar = xcd_barrier_post((unsigned*)(ws + WS_BAR), xst);
#define IN(k) (((PHASE_MASK >> (k)) & 1) && lo <= (k) && (k) < hi)
#if PROBE_MASK
    unsigned long long pr_acc = 0, pr_t0 = __builtin_amdgcn_s_memrealtime();
#define SEAM(k) do { if (IN(k) && IN((k) + 1)) { if ((k) == 0) cg::this_grid().sync(); else xcd_barrier(xbar); } { const unsigned long long t1_ = __builtin_amdgcn_s_memrealtime(); if ((PROBE_MASK >> (k)) & 1) pr_acc += t1_ - pr_t0; pr_t0 = t1_; } } while (0)
#else
#define SEAM(k) do { if (IN(k) && IN((k) + 1)) { if ((k) == 0) cg::this_grid().sync(); else xcd_barrier(xbar); } } while (0)
#endif

    if (IN(0)) { PHASE_IDS;
        for (int i = gtid; i < 4 * T; i += NTH) SSQ[i] = 0.f;
        for (int i = gtid; i < SEQ * 16; i += NTH) { const int pos = i >> 4, fi = i & 15; const float inv = 1.0f / powf(10000.0f, (float)fi * (1.0f / 16.0f)); const float ang = (float)pos * inv;
            float s, c; sincosf(ang, &s, &c); ROPE[pos * 32 + fi] = c; ROPE[pos * 32 + 16 + fi] = s; }
        for (int i = gtid; i < 1024; i += NTH) { const float lam = args.in[14][i]; SP8[i] = 8.0f * log1pf(expf(-lam)); }
        {
          const float* w_in = args.in[2]; const float* w_qb = args.in[4]; const float* g_q = args.in[3]; const float* w_kvb = args.in[6]; const float* g_kv = args.in[5];
          const float* wr_ = args.in[10]; const float* wi_ = args.in[12]; const float* w_oa = args.in[7]; const float* w_ol = args.in[15]; const float* w_o = args.in[16];
          const float* wg_ = args.in[18]; const float* wu_ = args.in[19]; const float* g2 = args.in[17]; const float* w_d = args.in[20];
          constexpr int I0 = (DIN_PAD / 64) * (1024 / 8), I1 = (768 / 64) * (256 / 8), I2 = (1024 / 64) * (128 / 8), I3 = (2048 / 64) * (128 / 8), I4 = (1024 / 64) * (512 / 8), I5 = I4,
                        I6 = (1024 / 64) * (1024 / 8), I7 = (2 * DFF / 64) * (1024 / 8), I8 = (1024 / 64) * (DFF / 8), ITOT = I0 + I1 + I2 + I3 + I4 + I5 + I6 + I7 + I8;
          auto do_item = [&](int gi) { int r = gi;
              if (r < I0) { xpose_one(WIN, DIN_PAD, 1024, [=](int n, int k) -> float { int src;
                  if (n < 384) src = n; else if (n < 416) { const int j = n - 384; src = 384 + (j & 1) * 16 + (j >> 1); } else if (n < 512) src = -1;
                  else if (n < 1024) src = 416 + (n - 512); else if (n < 1536) src = 928 + (n - 1024); else src = 1440 + (n - 1536);
                  return src < 0 ? 0.f : w_in[(size_t)k * DIN_SRC + src]; }, r, lane); return; } r -= I0;
              if (r < I1) { xpose_one(WQB, 768, 256, [=](int n, int k) -> float { const int h = n / 96, dp = n % 96; int d = dp; if (dp >= 64) { const int j = dp - 64; d = 64 + (j & 1) * 16 + (j >> 1); }
                  return w_qb[(size_t)k * 768 + h * 96 + d] * g_q[k]; }, r, lane); return; } r -= I1;
              if (r < I2) { xpose_one(WKVB, 1024, 128, [=](int n, int k) -> float { const int nn = n & 511, h = nn >> 6, d = nn & 63; return w_kvb[(size_t)k * 1024 + h * 128 + (n >> 9) * 64 + d] * g_kv[k]; }, r, lane); return; } r -= I2;
              if (r < I3) { xpose_one(WG, 2048, 128, [=](int n, int k) -> float { const int g = n >> 8, bj = (n >> 7) & 1, j = n & 127, blk = g >> 1, dir = g & 1;
                  return (bj ? wi_ : wr_)[((size_t)(dir * 4 + blk) * 128 + k) * 128 + j]; }, r, lane); return; } r -= I3;
              if (r < I4) { xpose_one(WOA, 1024, 512, [=](int n, int k) -> float { return w_oa[(size_t)k * 1024 + n]; }, r, lane); return; } r -= I4;
              if (r < I5) { xpose_one(WOL, 1024, 512, [=](int n, int k) -> float { return w_ol[(size_t)k * 1024 + n]; }, r, lane); return; } r -= I5;
              if (r < I6) { xpose_one(WOUT, 1024, 1024, [=](int n, int k) -> float { return w_o[(size_t)k * 1024 + n]; }, r, lane); return; } r -= I6;
              if (r < I7) { xpose_one(WGU, 2 * DFF, 1024, [=](int n, int k) -> float { const int pn = n >> 8, bj = (n >> 7) & 1, j = n & 127; return (bj ? wu_ : wg_)[(size_t)k * DFF + pn * 128 + j] * g2[k]; }, r, lane); return; } r -= I7;
              xpose_one(WD, 1024, DFF, [=](int n, int k) -> float { return w_d[(size_t)k * 1024 + n]; }, r, lane); };
          const float* x = args.in[0]; const float* g1 = args.in[1];
          f32x4 gv[4];
#pragma unroll
          for (int j = 0; j < 4; ++j) gv[j] = *((const f32x4*)g1 + lane + 64 * j);
          int gi = gw;
          for (int m = gw; m < T; m += 2 * NGW) { const int m2 = m + NGW; const bool two = m2 < T; const int mb = two ? m2 : m;
              const f32x4* xr = (const f32x4*)(x + (size_t)m * DM) + lane; const f32x4* xr2 = (const f32x4*)(x + (size_t)mb * DM) + lane; f32x4 v[4], v2[4]; float s = 0.f, s2 = 0.f;
#pragma unroll
              for (int j = 0; j < 4; ++j) { v[j] = __builtin_nontemporal_load(xr + 64 * j); v2[j] = __builtin_nontemporal_load(xr2 + 64 * j); }
              if (gi < ITOT) { do_item(gi); gi += NGW; }
#pragma unroll
              for (int j = 0; j < 4; ++j) { s += (v[j].x * v[j].x + v[j].y * v[j].y) + (v[j].z * v[j].z + v[j].w * v[j].w); s2 += (v2[j].x * v2[j].x + v2[j].y * v2[j].y) + (v2[j].z * v2[j].z + v2[j].w * v2[j].w); }
              const float rstd = rsqrtf(wave_sum(s) * (1.0f / DM) + EPS), rstd2 = rsqrtf(wave_sum(s2) * (1.0f / DM) + EPS);
              u32x2* o8 = (u32x2*)(XN + (size_t)m * DM) + lane; u32x2* o82 = (u32x2*)(XN + (size_t)mb * DM) + lane;
#pragma unroll
              for (int j = 0; j < 4; ++j) { const f32x4 y = v[j] * rstd * gv[j]; u32x2 w2; w2.x = cvt_pk_bf16(y.x, y.y); w2.y = cvt_pk_bf16(y.z, y.w); o8[64 * j] = w2; }
              if (two) {
#pragma unroll
                  for (int j = 0; j < 4; ++j) { const f32x4 y = v2[j] * rstd2 * gv[j]; u32x2 w2; w2.x = cvt_pk_bf16(y.x, y.y); w2.y = cvt_pk_bf16(y.z, y.w); o82[64 * j] = w2; } } }
          for (; gi < ITOT; gi += NGW) do_item(gi);
        }
    }
    SEAM(0);
    if (IN(1)) {
        pg8::Gemm g{XN, XN, WIN, WIN, 1024, 1024, 1024, 0, 0}; pg8::StaticOrder S; S.init(T, DIN_PAD, G, bid);
        EpiProj E{QA, KVA, KR, LX, LY, GATES, SSQ, SSKV, ROPE};
        pg8::gemm_phase<EpiProj, pg8::StaticOrder, true>(lds, g, S, E);
    }
    SEAM(1);
    if (IN(2)) { PHASE_IDS;
        if (P2SUB & 1) { const float* cw = args.in[8]; const float* cb = args.in[9]; const int c8 = (gtid & 63) * 8;
          float w[4][8], bias[8];
#pragma unroll
          for (int e = 0; e < 8; ++e) { bias[e] = cb[c8 + e];
#pragma unroll
              for (int j = 0; j < 4; ++j) w[j][e] = cw[j * 512 + c8 + e]; }
          const int rstride = NTH >> 6;
          for (int row = gtid >> 6; row < T; row += 2 * rstride) { const int rowb = (row + rstride < T) ? row + rstride : row;
              u32x4 xa[4], xb[4];
#pragma unroll
              for (int j = 0; j < 4; ++j) { const int ta = (row & (SEQ - 1)) - 2 + j, tb = (rowb & (SEQ - 1)) - 2 + j;
                  xa[j] = (ta >= 0 && ta < SEQ) ? *(const u32x4*)(LX + (size_t)(row - 2 + j) * 512 + c8) : (u32x4){0u, 0u, 0u, 0u};
                  xb[j] = (tb >= 0 && tb < SEQ) ? *(const u32x4*)(LX + (size_t)(rowb - 2 + j) * 512 + c8) : (u32x4){0u, 0u, 0u, 0u}; }
              float a[8], bq[8];
#pragma unroll
              for (int e = 0; e < 8; ++e) { a[e] = bias[e]; bq[e] = bias[e]; }
#pragma unroll
              for (int j = 0; j < 4; ++j) { f32x4 x0, x1, y0, y1; unpack8(xa[j], x0, x1); unpack8(xb[j], y0, y1);
#pragma unroll
                  for (int e = 0; e < 4; ++e) { a[e] += w[j][e] * x0[e]; a[4 + e] += w[j][4 + e] * x1[e]; bq[e] += w[j][e] * y0[e]; bq[4 + e] += w[j][4 + e] * y1[e]; } }
              u32x4 o; o.x = cvt_pk_bf16(a[0], a[1]); o.y = cvt_pk_bf16(a[2], a[3]); o.z = cvt_pk_bf16(a[4], a[5]); o.w = cvt_pk_bf16(a[6], a[7]);
              *(u32x4*)(XC + (size_t)row * 512 + c8) = o;
              if (rowb != row) { u32x4 o2; o2.x = cvt_pk_bf16(bq[0], bq[1]); o2.y = cvt_pk_bf16(bq[2], bq[3]); o2.z = cvt_pk_bf16(bq[4], bq[5]); o2.w = cvt_pk_bf16(bq[6], bq[7]);
                  *(u32x4*)(XC + (size_t)rowb * 512 + c8) = o2; } } }
        if (P2SUB & 2) { pg8::Gemm g{QA, QA, WQB, WQB, 256, 256, 256, 0, 0}; pg8::StaticOrder S; S.init(T, 768, G, bid); EpiQ E{Qb, SSQ, ROPE};
          pg8::gemm_phase<EpiQ, pg8::StaticOrder, true>(lds, g, S, E); }
        if (P2SUB & 4) { pg8::Gemm g{KVA, KVA, WKVB, WKVB, 128, 128, 128, 0, 0}; pg8::StaticOrder S; S.init(T, 1024, G, bid); EpiKV E{KN, Vb, SSKV};
          pg8::gemm_phase<EpiKV, pg8::StaticOrder, true>(lds, g, S, E); }
    }
    SEAM(2);
    if (IN(3)) {
        pg8::Gemm g{XC, XC, WG, WG, 512, 128, 128, 1, 128}; pg8::StaticOrder S; S.init(T, 2048, G, bid);
        EpiGates E{XC, AU, args.in[11], args.in[13], SP8};
        pg8::gemm_phase<EpiGates, pg8::StaticOrder, true>(lds, g, S, E);
    }
    SEAM(3);
    if (IN(4)) {
        __syncthreads();
        const int vcu = (G % 8 == 0) ? (bid % 8) * (G / 8) + bid / 8 : bid;
        const bool scan_first = ((bid >> 3) & 1) == 0;
        if (scan_first) for (int it = bid; it < NBATCH * 8; it += G) scan_item(it >> 3, it & 7, AU, LY, REC, (float*)lds_raw);
        for (int un = vcu; un < NBATCH * 8 * 8; un += G) { const int bh = un >> 3, qb = un & 7, b = bh >> 3, h = bh & 7; const size_t rb = (size_t)b * SEQ;
            att::attn_unit(Qb + (rb + qb * 256) * 768 + h * 96, KN + rb * 512 + h * 64, KR + rb * 32, Vb + rb * 512 + h * 64, ATT + (rb + qb * 256) * 512 + h * 64, (char*)lds_raw); }
        if (!scan_first) { __syncthreads(); for (int it = bid; it < NBATCH * 8; it += G) scan_item(it >> 3, it & 7, AU, LY, REC, (float*)lds_raw); }
    }
    SEAM(4);
    if (IN(5)) {
        pg8::Gemm g{ATT, REC, WOA, WOL, 512, 512, 512, 0, 0}; pg8::DualOrder S; S.S.init(T, 1024, G, bid);
        EpiMerge E{GATES, MERGED};
        pg8::gemm_phase<EpiMerge, pg8::DualOrder, true>(lds, g, S, E);
    }
    SEAM(5);
    if (IN(6)) {
        pg8::Gemm g{MERGED, MERGED, WOUT, WOUT, 1024, 1024, 1024, 0, 0}; pg8::StaticOrder S; S.init(T, 1024, G, bid);
        EpiOut E{args.in[0], X1B, SS2};
        pg8::gemm_phase<EpiOut, pg8::StaticOrder, true>(lds, g, S, E);
    }
    SEAM(6);
    if (IN(7)) {
        pg8::Gemm g{X1B, X1B, WGU, WGU, 1024, 1024, 1024, 0, 0}; pg8::StaticOrder S; S.init(T, 2 * DFF, G, bid);
        EpiFfn E{HID, SS2};
        pg8::gemm_phase<EpiFfn, pg8::StaticOrder, true>(lds, g, S, E);
    }
    SEAM(7);
    if (IN(8)) {
        pg8::Gemm g{HID, HID, WD, WD, DFF, DFF, DFF, 0, 0}; pg8::StaticOrder S; S.init(T, 1024, G, bid);
        EpiDown E{X1B, SS3};
        pg8::gemm_phase<EpiDown, pg8::StaticOrder, true>(lds, g, S, E);
    }
    SEAM(8);
    if (IN(9)) { PHASE_IDS;
        const float* gf = args.in[21]; f32x4 gv[4];
#pragma unroll
        for (int j = 0; j < 4; ++j) gv[j] = *((const f32x4*)gf + lane + 64 * j);
        for (int m = gw; m < T; m += NGW) { f32x4* xr = (f32x4*)(args.out + (size_t)m * DM) + lane; const u32x2* br_ = (const u32x2*)(X1B + (size_t)m * DM) + lane; const float rstd = rsqrtf(SS3[m] * (1.0f / DM) + EPS);
            u32x2 w2[4];
#pragma unroll
            for (int j = 0; j < 4; ++j) w2[j] = __builtin_nontemporal_load(br_ + 64 * j);
#pragma unroll
            for (int j = 0; j < 4; ++j) { const f32x4 v = (f32x4){bf_lo(w2[j].x), bf_hi(w2[j].x), bf_lo(w2[j].y), bf_hi(w2[j].y)}; __builtin_nontemporal_store(v * rstd * gv[j], xr + 64 * j); } }
    }
#if PROBE_MASK
    SEAM(9);
    if (bid == 0 && tid == 0) { const unsigned long long t0_ = __builtin_amdgcn_s_memrealtime(); while (__builtin_amdgcn_s_memrealtime() - t0_ < pr_acc) __builtin_amdgcn_s_sleep(8); }
#endif
#undef IN
#undef SEAM
}

constexpr int LDS_BYTES = 147456;
constexpr int N_PHASES = 10;
extern "C" void kernel_launch(void* const* d_in, const int* in_sizes, int n_in, void* d_out, int out_size, void* d_ws, size_t ws_size, hipStream_t stream) {
    static int grid = 0;
    if (grid == 0) {
        if (n_in != 22 || out_size != T * DM || ws_size < WS_END) { fprintf(stderr, "kernel_launch: unexpected shapes n_in %d out %d ws %zu\n", n_in, out_size, ws_size); grid = -1; return; }
        int dev = 0, cus = 0, per_cu = 0;
        hipGetDevice(&dev); hipDeviceGetAttribute(&cus, hipDeviceAttributeMultiprocessorCount, dev);
        if (hipFuncSetAttribute((const void*)mega_fwd, hipFuncAttributeMaxDynamicSharedMemorySize, LDS_BYTES) != hipSuccess) { fprintf(stderr, "kernel_launch: hipFuncSetAttribute failed\n"); grid = -1; return; }
        if (hipOccupancyMaxActiveBlocksPerMultiprocessor(&per_cu, (const void*)mega_fwd, 512, LDS_BYTES) != hipSuccess || per_cu < 1) { fprintf(stderr, "kernel_launch: occupancy query gives %d\n", per_cu); per_cu = 1; }
        (void)hipGetLastError();
        grid = cus * (per_cu > 1 ? 1 : per_cu);
        if (grid > 256) grid = 256;
    }
    if (grid < 0) return;
    Args a{};
    for (int i = 0; i < 22; ++i) a.in[i] = (const float*)d_in[i];
    a.out = (float*)d_out; a.ws = (unsigned char*)d_ws;
#if MK_SINGLE
    if (hipMemsetAsync((char*)d_ws + WS_BAR, 0, 16384, stream) != hipSuccess) { fprintf(stderr, "kernel_launch: memset failed\n"); return; }
    a.ph_lo = 0; a.ph_hi = N_PHASES;
    void* kargs[] = {&a};
    hipError_t e = hipLaunchCooperativeKernel((const void*)mega_fwd, dim3(grid), dim3(512), kargs, LDS_BYTES, stream);
    if (e != hipSuccess) fprintf(stderr, "cooperative launch failed: %s (grid %d)\n", hipGetErrorString(e), grid);
#else
    for (int p = 0; p < N_PHASES; ++p) { a.ph_lo = p; a.ph_hi = p + 1; hipLaunchKernelGGL(mega_fwd, dim3(grid), dim3(512), LDS_BYTES, stream, a); }
#endif
}
```

```cpp
#include <hip/hip_runtime.h>
#include <hip/hip_cooperative_groups.h>
#include <hip/hip_bf16.h>
#include <hip/hip_fp16.h>
#include <cstdio>
#include <cstdint>
namespace cg = cooperative_groups;

#ifndef PHASE_MASK
#define PHASE_MASK 0x3ff
#endif
#ifndef P2SUB
#define P2SUB 7
#endif
#ifndef PROBE_MASK
#define PROBE_MASK 0
#endif
#ifndef MK_SINGLE
#define MK_SINGLE 1
#endif

constexpr int T = 65536, DM = 1024, SEQ = 2048, NBATCH = 32;
constexpr int DIN_SRC = 3488, DIN_PAD = 3584, DFF = 2816;
constexpr float EPS = 1e-6f;
constexpr float LOG2E = 1.4426950408889634f;

typedef unsigned short bf16_t;
typedef short bf16x8 __attribute__((ext_vector_type(8)));
typedef short s16x4 __attribute__((ext_vector_type(4)));
typedef float f32x4 __attribute__((ext_vector_type(4)));
typedef float f32x2 __attribute__((ext_vector_type(2)));
typedef float f32x16 __attribute__((ext_vector_type(16)));
typedef unsigned u32x4 __attribute__((ext_vector_type(4)));
typedef unsigned u32x2 __attribute__((ext_vector_type(2)));
#define LAS __attribute__((address_space(3)))

__device__ __forceinline__ unsigned cvt_pk_bf16(float lo, float hi) { unsigned r; asm volatile("v_cvt_pk_bf16_f32 %0, %1, %2" : "=v"(r) : "v"(lo), "v"(hi)); return r; }
__device__ __forceinline__ float bf_lo(unsigned w) { return __uint_as_float(w << 16); }
__device__ __forceinline__ float bf_hi(unsigned w) { return __uint_as_float(w & 0xffff0000u); }
__device__ __forceinline__ float fsigmoid(float x) { return __builtin_amdgcn_rcpf(1.0f + __builtin_amdgcn_exp2f(-x * LOG2E)); }
__device__ __forceinline__ u32x4 pack8(f32x4 a, f32x4 b) { u32x4 w; w.x = cvt_pk_bf16(a[0], a[1]); w.y = cvt_pk_bf16(a[2], a[3]); w.z = cvt_pk_bf16(b[0], b[1]); w.w = cvt_pk_bf16(b[2], b[3]); return w; }
__device__ __forceinline__ void unpack8(u32x4 w, f32x4& a, f32x4& b) { a = (f32x4){bf_lo(w.x), bf_hi(w.x), bf_lo(w.y), bf_hi(w.y)}; b = (f32x4){bf_lo(w.z), bf_hi(w.z), bf_lo(w.w), bf_hi(w.w)}; }
__device__ __forceinline__ float wave_sum(float v) {
#pragma unroll
    for (int o = 1; o < 64; o <<= 1) v += __shfl_xor(v, o);
    return v;
}

namespace pg8 {
constexpr int BM = 256, BK = 64, HALF = 128, HTB = HALF * BK * 2, STAGE_BYTES = 8 * HTB, NXCD = 8, WGM = 8;
__host__ __device__ __forceinline__ int lds_byte(int r, int c) { const int st = (r >> 4) * 2 + (c >> 5), rr = r & 15, cc = c & 31, ob = rr * 64 + cc * 2; return st * 1024 + (ob ^ (((ob >> 9) & 1) << 5)); }
__host__ __device__ __forceinline__ void stage_rc(int b, int& R, int& C) { const int st = b / 1024, sb = b % 1024, swz = sb ^ (((sb >> 9) & 1) << 5); R = (st >> 1) * 16 + swz / 64; C = (st & 1) * 32 + (swz % 64) / 2; }
__host__ __device__ __forceinline__ int perm32(int rho) { const int n = rho >> 4, i = rho & 15; return 8 * (i >> 2) + 4 * n + (i & 3); }

struct Unit { int pm, pn, sel; };
struct Gemm {
    const bf16_t *A0, *A1, *B0, *B1; int lda, ldb, K; int a_grp_shift, a_grp_cols;
    __device__ __forceinline__ const char* a_ptr(const Unit& u) const { return (const char*)(u.sel ? A1 : A0) + ((size_t)u.pm * BM * lda + (size_t)(u.pn >> a_grp_shift) * a_grp_cols) * 2; }
    __device__ __forceinline__ const char* b_ptr(const Unit& u) const { return (const char*)(u.sel ? B1 : B0) + (size_t)u.pn * BM * ldb * 2; }
};

struct StaticOrder {
    int nM, nN, nwg, G, c;
    __device__ void init(int M, int N, int G_, int c_) { nM = M / BM; nN = N / BM; nwg = nM * nN; G = G_; c = c_; }
    __device__ bool next(int i, Unit& u) const {
        const long L = (long)i * G + c; if (L >= nwg) return false;
        int wgid = (int)L; { const int q = nwg / NXCD, r = nwg % NXCD, xcd = wgid % NXCD, off = wgid / NXCD; wgid = (xcd < r ? xcd * (q + 1) : r * (q + 1) + (xcd - r) * q) + off; }
        const int nig = WGM * nN, gid = wgid / nig, fm = gid * WGM, gsz = (nM - fm) < WGM ? (nM - fm) : WGM;
        u.pm = fm + ((wgid % nig) % gsz); u.pn = (wgid % nig) / gsz; u.sel = 0; return true;
    }
};
struct DualOrder {
    StaticOrder S;
    __device__ bool next(int i, Unit& u) const { if (!S.next(i >> 1, u)) return false; u.sel = i & 1; return true; }
};

template <class Epi, class Sched, bool ALIGN_EPI>
__device__ __forceinline__ void gemm_phase(LAS unsigned char* lds, const Gemm g, const Sched& S, const Epi& E) {
    int tid = threadIdx.x; asm volatile("" : "+v"(tid) :: "memory");
    const int wid = __builtin_amdgcn_readfirstlane(tid >> 6), lane = tid & 63, wr = wid >> 2, wc = wid & 3, fr = lane & 15, fq = lane >> 4;
    int lda_ = g.lda, ldb_ = g.ldb, K = g.K; asm volatile("" : "+s"(lda_), "+s"(ldb_), "+s"(K) :: "memory");
    const int nt = K / BK;
    unsigned voffA[2], voffB[2];
#pragma unroll
    for (int i = 0; i < 2; ++i) { int R, C; stage_rc(tid * 16 + i * 8192, R, C); const int Rb = Epi::PERM ? ((R & ~31) + perm32(R & 31)) : R;
        voffA[i] = (unsigned)(R * lda_ + C) * 2u; voffB[i] = (unsigned)(Rb * ldb_ + C) * 2u; }
    const size_t kstep = (size_t)(BK * 2);
    const size_t hstepA = (size_t)HALF * lda_ * 2, hstepB = (size_t)HALF * ldb_ * 2;
    const unsigned ldsw = (unsigned)wid * 1024u;
    const int aoff = lds_byte(wr * 64 + fr, fq * 8), boff = lds_byte(wc * 32 + fr, fq * 8);
#define PG8_SA(b, h) (((b) * 2 + (h)) * HTB)
#define PG8_SB(b, h) ((4 + (b) * 2 + (h)) * HTB)
#define PG8_STAGE(bufoff, gbase, voff) do { _Pragma("unroll") for (int _i = 0; _i < 2; ++_i) \
        __builtin_amdgcn_global_load_lds((const unsigned*)((const char*)(gbase) + (voff)[_i]), (LAS unsigned*)(lds + (bufoff) + ldsw + _i * 8192), 16, 0, 0); } while (0)
#define PG8_LDA(dst, b, h) do { _Pragma("unroll") for (int m = 0; m < 4; ++m) _Pragma("unroll") for (int k = 0; k < 2; ++k) dst[m][k] = *(const LAS bf16x8*)(lds + PG8_SA(b, h) + aoff + m * 2048 + k * 1024); } while (0)
#define PG8_LDB(dst, b, h) do { _Pragma("unroll") for (int n = 0; n < 2; ++n) _Pragma("unroll") for (int k = 0; k < 2; ++k) dst[n][k] = *(const LAS bf16x8*)(lds + PG8_SB(b, h) + boff + n * 2048 + k * 1024); } while (0)
#define PG8_MMA(ai, bj, At, Bt) do { __builtin_amdgcn_s_setprio(1); _Pragma("unroll") for (int m = 0; m < 4; ++m) _Pragma("unroll") for (int n = 0; n < 2; ++n) _Pragma("unroll") for (int k = 0; k < 2; ++k) \
        acc[ai][bj][m][n] = __builtin_amdgcn_mfma_f32_16x16x32_bf16(Bt[n][k], At[m][k], acc[ai][bj][m][n], 0, 0, 0); __builtin_amdgcn_s_setprio(0); } while (0)
#define PG8_WAIT_V(n) asm volatile("s_waitcnt vmcnt(" #n ")" ::: "memory")
#define PG8_WAIT_L(n) asm volatile("s_waitcnt lgkmcnt(" #n ")" ::: "memory")
#define PG8_BAR __builtin_amdgcn_s_barrier()
#define PG8_SCHED __builtin_amdgcn_sched_barrier(0)
    Unit cur, nxt; int ui = 0;
    if (!S.next(0, cur)) return;
    f32x4 acc[2][2][4][2];
#pragma unroll
    for (int a = 0; a < 2; ++a)
#pragma unroll
        for (int b = 0; b < 2; ++b)
#pragma unroll
            for (int m = 0; m < 4; ++m)
#pragma unroll
                for (int n = 0; n < 2; ++n) acc[a][b][m][n] = (f32x4){0.f, 0.f, 0.f, 0.f};
    bf16x8 At[4][2], B0[2][2], B1[2][2];
    const char* cA = g.a_ptr(cur); const char* cB = g.b_ptr(cur);
    PG8_STAGE(PG8_SB(0, 0), cB, voffB); PG8_STAGE(PG8_SB(0, 1), cB + hstepB, voffB); PG8_STAGE(PG8_SA(0, 0), cA, voffA); PG8_STAGE(PG8_SA(0, 1), cA + hstepA, voffA);
    if (wr == 1) PG8_BAR;
    PG8_WAIT_V(2); PG8_BAR;
    PG8_STAGE(PG8_SB(1, 0), cB + kstep, voffB); PG8_STAGE(PG8_SA(1, 0), cA + kstep, voffA); PG8_STAGE(PG8_SB(1, 1), cB + hstepB + kstep, voffB);
    PG8_WAIT_V(6); PG8_BAR;
    for (;;) {
        const bool has_next = S.next(ui + 1, nxt);
        const char* nA = has_next ? g.a_ptr(nxt) : cA; const char* nB = has_next ? g.b_ptr(nxt) : cB;
        for (int t = 0; t < nt; t += 2) {
            const bool last = (t == nt - 2);
            const char* a1 = cA + (size_t)(t + 1) * kstep;
            const char* a2 = last ? nA : cA + (size_t)(t + 2) * kstep; const char* b2 = last ? nB : cB + (size_t)(t + 2) * kstep;
            const char* a3 = a2 + kstep; const char* b3 = b2 + kstep;
            PG8_LDB(B0, 0, 0); PG8_LDB(B1, 0, 1); PG8_SCHED; PG8_LDA(At, 0, 0); PG8_STAGE(PG8_SA(1, 1), a1 + hstepA, voffA);
            PG8_WAIT_V(8); PG8_WAIT_L(0); PG8_BAR; PG8_MMA(0, 0, At, B0); PG8_MMA(0, 1, At, B1); PG8_BAR; PG8_SCHED;
            PG8_LDA(At, 0, 1); PG8_STAGE(PG8_SB(0, 0), b2, voffB); PG8_STAGE(PG8_SB(0, 1), b2 + hstepB, voffB); PG8_STAGE(PG8_SA(0, 0), a2, voffA);
            PG8_WAIT_V(8); PG8_WAIT_L(0); PG8_BAR; PG8_MMA(1, 0, At, B0); PG8_MMA(1, 1, At, B1); PG8_BAR; PG8_SCHED;
            PG8_LDB(B0, 1, 0); PG8_LDB(B1, 1, 1); PG8_SCHED; PG8_LDA(At, 1, 0); PG8_STAGE(PG8_SA(0, 1), a2 + hstepA, voffA);
            PG8_WAIT_V(8); PG8_WAIT_L(0); PG8_BAR; PG8_MMA(0, 0, At, B0); PG8_MMA(0, 1, At, B1); PG8_BAR; PG8_SCHED;
            PG8_LDA(At, 1, 1); PG8_STAGE(PG8_SB(1, 0), b3, voffB); PG8_STAGE(PG8_SB(1, 1), b3 + hstepB, voffB); PG8_STAGE(PG8_SA(1, 0), a3, voffA);
            PG8_WAIT_V(8); PG8_WAIT_L(0); PG8_BAR; PG8_MMA(1, 0, At, B0); PG8_MMA(1, 1, At, B1); PG8_BAR; PG8_SCHED;
        }
        if constexpr (ALIGN_EPI) { if (wr == 0) PG8_BAR; }
        PG8_SCHED; E(acc, cur, wr, wc, fr, fq); PG8_SCHED;
        if (!has_next) break;
        bool keep_ = false; if constexpr (Epi::DUAL) keep_ = (cur.sel == 0);
        if (!keep_)
#pragma unroll
        for (int a = 0; a < 2; ++a)
#pragma unroll
            for (int b = 0; b < 2; ++b)
#pragma unroll
                for (int m = 0; m < 4; ++m)
#pragma unroll
                    for (int n = 0; n < 2; ++n) acc[a][b][m][n] = (f32x4){0.f, 0.f, 0.f, 0.f};
        cur = nxt; cA = nA; cB = nB; ++ui;
        if constexpr (ALIGN_EPI) { if (wr == 1) PG8_BAR; }
    }
    PG8_WAIT_V(0);
    if constexpr (!ALIGN_EPI) { if (wr == 0) PG8_BAR; }
    PG8_BAR;
#undef PG8_SA
#undef PG8_SB
#undef PG8_STAGE
#undef PG8_LDA
#undef PG8_LDB
#undef PG8_MMA
#undef PG8_WAIT_V
#undef PG8_WAIT_L
#undef PG8_BAR
#undef PG8_SCHED
}
}
using pg8::Unit;
typedef f32x4 Acc[2][2][4][2];


#ifndef ST_AUX
#define ST_AUX 2
#endif
#define ST16(BASE, OFF, VAL) __builtin_amdgcn_raw_buffer_store_b128((VAL), __builtin_amdgcn_make_buffer_rsrc((void*)(BASE), (short)0, 0x7ffffff0, 0x00020000), (int)((unsigned)(OFF) * (unsigned)sizeof(*(BASE))), 0, ST_AUX)
__device__ __forceinline__ void rope4(f32x4& v0, f32x4& v1, const float* rp, int i0) {
    const f32x4 c = *(const f32x4*)(rp + i0), s = *(const f32x4*)(rp + 16 + i0);
    const f32x4 a = v0, b = v1;
    v0[0] = a[0] * c[0] - a[1] * s[0]; v0[1] = a[1] * c[0] + a[0] * s[0];
    v0[2] = a[2] * c[1] - a[3] * s[1]; v0[3] = a[3] * c[1] + a[2] * s[1];
    v1[0] = b[0] * c[2] - b[1] * s[2]; v1[1] = b[1] * c[2] + b[0] * s[2];
    v1[2] = b[2] * c[3] - b[3] * s[3]; v1[3] = b[3] * c[3] + b[2] * s[3];
}
__device__ __forceinline__ float gelu_tanh(float y) { const float z = 0.7978845608028654f * (y + 0.044715f * y * y * y); return y * fsigmoid(2.0f * z); }

struct EpiProj {
    static constexpr bool PERM = true, DUAL = false;
    bf16_t *QA, *KVA, *KR, *LX, *LY, *GATES; float *SSQ, *SSKV; const float* rope;
    __device__ __forceinline__ void operator()(const Acc& acc, const Unit& u, int wr, int wc, int fr, int fq) const {
        const int pn = u.pn, rowt = u.pm * 256 + wr * 64 + fr, cw = wc * 32 + 8 * fq;
        if (pn >= 2) {
            bf16_t* base; int ld, mode;
            if (pn >= 6) { base = GATES + (pn - 6) * 256; ld = 2048; mode = 2; } else if (pn >= 4) { base = LY + (pn - 4) * 256; ld = 512; mode = 1; } else { base = LX + (pn - 2) * 256; ld = 512; mode = 0; }
#pragma unroll
            for (int ai = 0; ai < 2; ++ai)
#pragma unroll
                for (int m = 0; m < 4; ++m) { const unsigned row = rowt + ai * 128 + m * 16;
#pragma unroll
                    for (int bj = 0; bj < 2; ++bj) { f32x4 v0 = acc[ai][bj][m][0], v1 = acc[ai][bj][m][1];
                        if (mode == 2) {
#pragma unroll
                            for (int e = 0; e < 4; ++e) { v0[e] = fsigmoid(v0[e]); v1[e] = fsigmoid(v1[e]); } }
                        else if (mode == 1) {
#pragma unroll
                            for (int e = 0; e < 4; ++e) { v0[e] = gelu_tanh(v0[e]); v1[e] = gelu_tanh(v1[e]); } }
                        ST16(base, row * ld + bj * 128 + cw, pack8(v0, v1)); } }
        } else if (pn == 0) {
#pragma unroll
            for (int ai = 0; ai < 2; ++ai)
#pragma unroll
                for (int m = 0; m < 4; ++m) { const unsigned row = rowt + ai * 128 + m * 16; float ss = 0.f;
#pragma unroll
                    for (int bj = 0; bj < 2; ++bj) { const f32x4 v0 = acc[ai][bj][m][0], v1 = acc[ai][bj][m][1];
                        ss += (v0[0] * v0[0] + v0[1] * v0[1]) + (v0[2] * v0[2] + v0[3] * v0[3]) + (v1[0] * v1[0] + v1[1] * v1[1]) + (v1[2] * v1[2] + v1[3] * v1[3]);
                        ST16(QA, row * 256 + bj * 128 + cw, pack8(v0, v1)); }
                    ss += __shfl_xor(ss, 16); ss += __shfl_xor(ss, 32);
                    if (fq == 0) atomicAdd(SSQ + row, ss); }
        } else {
#pragma unroll
            for (int ai = 0; ai < 2; ++ai)
#pragma unroll
                for (int m = 0; m < 4; ++m) { const unsigned row = rowt + ai * 128 + m * 16;
                    { const f32x4 v0 = acc[ai][0][m][0], v1 = acc[ai][0][m][1];
                      float ss = (v0[0] * v0[0] + v0[1] * v0[1]) + (v0[2] * v0[2] + v0[3] * v0[3]) + (v1[0] * v1[0] + v1[1] * v1[1]) + (v1[2] * v1[2] + v1[3] * v1[3]);
                      ST16(KVA, row * 128 + cw, pack8(v0, v1));
                      ss += __shfl_xor(ss, 16); ss += __shfl_xor(ss, 32);
                      if (fq == 0) atomicAdd(SSKV + row, ss); }
                    if (wc == 0) { f32x4 v0 = acc[ai][1][m][0], v1 = acc[ai][1][m][1];
                      rope4(v0, v1, rope + (row & (SEQ - 1)) * 32, 4 * fq);
                      ST16(KR, row * 32 + 8 * fq, pack8(v0, v1)); } }
        }
    }
};

constexpr float QSCALE = 0.10206207261596577f * 1.4426950408889634f;
struct EpiQ {
    static constexpr bool PERM = true, DUAL = false;
    bf16_t* Q; const float* SSQ; const float* rope;
    __device__ __forceinline__ void operator()(const Acc& acc, const Unit& u, int wr, int wc, int fr, int fq) const {
        const int rowt = u.pm * 256 + wr * 64 + fr;
        const int c00 = u.pn * 256 + wc * 32 + 8 * fq, c01 = c00 + 128, d0 = c00 % 96, d1 = c01 % 96;
#pragma unroll
        for (int am = 0; am < 4; ++am) { const int ai = am >> 1, mb = (am & 1) * 2;
            f32x4 cs[2][2][2]; float ss[2];
#pragma unroll
            for (int mm = 0; mm < 2; ++mm) ss[mm] = SSQ[(unsigned)(rowt + ai * 128 + (mb + mm) * 16)];
#pragma unroll
            for (int mm = 0; mm < 2; ++mm) { const unsigned pos = (unsigned)(rowt + ai * 128 + (mb + mm) * 16) & (SEQ - 1);
#pragma unroll
                for (int bj = 0; bj < 2; ++bj) { const int d = bj ? d1 : d0; if (d >= 64) { const float* rp = rope + (pos * 32 + ((d - 64) >> 1)); cs[mm][bj][0] = *(const f32x4*)rp; cs[mm][bj][1] = *(const f32x4*)(rp + 16); }
                    else { cs[mm][bj][0] = (f32x4){1.f, 1.f, 1.f, 1.f}; cs[mm][bj][1] = (f32x4){0.f, 0.f, 0.f, 0.f}; } } }
#pragma unroll
            for (int mm = 0; mm < 2; ++mm) { const int m = mb + mm; const unsigned row = rowt + ai * 128 + m * 16; const float rstd = rsqrtf(ss[mm] * (1.0f / 256.0f) + EPS) * QSCALE;
#pragma unroll
                for (int bj = 0; bj < 2; ++bj) { const int c0 = bj ? c01 : c00;
                    const f32x4 a = acc[ai][bj][m][0] * rstd, b = acc[ai][bj][m][1] * rstd, c = cs[mm][bj][0], sn = cs[mm][bj][1]; f32x4 v0, v1;
                    v0[0] = a[0] * c[0] - a[1] * sn[0]; v0[1] = a[1] * c[0] + a[0] * sn[0]; v0[2] = a[2] * c[1] - a[3] * sn[1]; v0[3] = a[3] * c[1] + a[2] * sn[1];
                    v1[0] = b[0] * c[2] - b[1] * sn[2]; v1[1] = b[1] * c[2] + b[0] * sn[2]; v1[2] = b[2] * c[3] - b[3] * sn[3]; v1[3] = b[3] * c[3] + b[2] * sn[3];
                    if ((bj ? d1 : d0) < 64) { v0 = a; v1 = b; }
                    ST16(Q, (row * 768 + c0), pack8(v0, v1)); } }
            asm volatile("" ::: "memory"); }
    }
};

struct EpiKV {
    static constexpr bool PERM = true, DUAL = false;
    bf16_t *KN, *V; const float* SSKV;
    __device__ __forceinline__ void operator()(const Acc& acc, const Unit& u, int wr, int wc, int fr, int fq) const {
        const int rowt = u.pm * 256 + wr * 64 + fr; bf16_t* base = (u.pn < 2 ? KN : V) + (u.pn & 1) * 256; const unsigned cw = wc * 32 + 8 * fq;
        float ss[8];
#pragma unroll
        for (int i = 0; i < 8; ++i) ss[i] = SSKV[(unsigned)(rowt + (i >> 2) * 128 + (i & 3) * 16)];
#pragma unroll
        for (int ai = 0; ai < 2; ++ai)
#pragma unroll
            for (int m = 0; m < 4; ++m) { const unsigned row = rowt + ai * 128 + m * 16; const float rstd = rsqrtf(ss[ai * 4 + m] * (1.0f / 128.0f) + EPS);
#pragma unroll
                for (int bj = 0; bj < 2; ++bj) ST16(base, (row * 512 + bj * 128 + cw), pack8(acc[ai][bj][m][0] * rstd, acc[ai][bj][m][1] * rstd)); }
    }
};

__device__ __forceinline__ unsigned pack_h2(float lo, float hi) { const __half2 h = __floats2half2_rn(lo, hi); return *(const unsigned*)&h; }
struct EpiGates {
    static constexpr bool PERM = true, DUAL = false;
    const bf16_t* XC; unsigned* AU; const float *br, *bi, *sp8;
    __device__ __forceinline__ void operator()(const Acc& acc, const Unit& u, int wr, int wc, int fr, int fq) const {
        const int blk = u.pn >> 1, dir = u.pn & 1, rowt = u.pm * 256 + wr * 64 + fr, j0 = wc * 32 + 8 * fq, ch = blk * 128 + j0;
        const float* pbr = br + (dir * 4 + blk) * 128; const float* pbi = bi + (dir * 4 + blk) * 128; const float* psp = sp8 + dir * 512 + blk * 128;
        u32x4 xw[8];
#pragma unroll
        for (int i = 0; i < 8; ++i) xw[i] = *(const u32x4*)(XC + (unsigned)((rowt + (i >> 2) * 128 + (i & 3) * 16) * 512 + ch));
        f32x4 cbr[2], cbi[2], csp[2];
#pragma unroll
        for (int h = 0; h < 2; ++h) { cbr[h] = *(const f32x4*)(pbr + (unsigned)(j0 + 4 * h)); cbi[h] = *(const f32x4*)(pbi + (unsigned)(j0 + 4 * h)); csp[h] = *(const f32x4*)(psp + (unsigned)(j0 + 4 * h)); }
        unsigned* dst = AU + (size_t)dir * T * 512;
#pragma unroll
        for (int ai = 0; ai < 2; ++ai)
#pragma unroll
            for (int m = 0; m < 4; ++m) { const unsigned row = rowt + ai * 128 + m * 16;
                f32x4 x0, x1; unpack8(xw[ai * 4 + m], x0, x1);
                u32x4 o0, o1;
#pragma unroll
                for (int h = 0; h < 2; ++h) { const f32x4 ar = acc[ai][0][m][h] + cbr[h], aiq = acc[ai][1][m][h] + cbi[h], sp = csp[h], xx = h ? x1 : x0; u32x4 o;
#pragma unroll
                    for (int e = 0; e < 4; ++e) { const float rr = fsigmoid(ar[e]), ii = fsigmoid(aiq[e]); const float la = -rr * sp[e], y = 2.0f * la;
                        float m2 = -y * (1.0f + y * (0.5f + y * (0.16666667f + y * (0.041666668f + y * 0.0083333338f))));
                        if (__builtin_expect(__any(y < -0.25f), 0)) m2 = (y < -0.25f) ? 1.0f - __builtin_amdgcn_exp2f(y * LOG2E) : m2;
                        const float uu = ii * xx[e] * __builtin_amdgcn_sqrtf(m2); o[e] = pack_h2(la * LOG2E, uu); }
                    if (h) o1 = o; else o0 = o; }
                ST16(dst, (row * 512 + ch), o0); ST16(dst, (row * 512 + ch + 4), o1); }
    }
};

struct EpiMerge {
    static constexpr bool PERM = true, DUAL = true;
    const bf16_t* GATES; bf16_t* MERGED;
    __device__ __forceinline__ void operator()(Acc& acc, const Unit& u, int wr, int wc, int fr, int fq) const {
        const int rowt = u.pm * 256 + wr * 64 + fr, c0 = u.pn * 256 + wc * 32 + 8 * fq;
#pragma unroll
        for (int ai = 0; ai < 2; ++ai) {
            u32x4 gw_[4][2], hw_[4][2];
#pragma unroll
            for (int m = 0; m < 4; ++m)
#pragma unroll
                for (int bj = 0; bj < 2; ++bj) { const unsigned o = (unsigned)((rowt + ai * 128 + m * 16) * 2048 + c0 + bj * 128);
                    gw_[m][bj] = *(const u32x4*)(GATES + (o + 1024)); if (u.sel == 0) hw_[m][bj] = *(const u32x4*)(GATES + o); else hw_[m][bj] = gw_[m][bj]; }
#pragma unroll
            for (int m = 0; m < 4; ++m) { const unsigned row = rowt + ai * 128 + m * 16;
#pragma unroll
                for (int bj = 0; bj < 2; ++bj) { f32x4 r0, r1, a0, a1; unpack8(gw_[m][bj], r0, r1); unpack8(hw_[m][bj], a0, a1);
                    if (u.sel == 0) {
#pragma unroll
                        for (int e = 0; e < 4; ++e) { acc[ai][bj][m][0][e] *= a0[e] * __builtin_amdgcn_rcpf(r0[e]); acc[ai][bj][m][1][e] *= a1[e] * __builtin_amdgcn_rcpf(r1[e]); } }
                    else { ST16(MERGED, (row * 1024 + c0 + bj * 128), pack8(acc[ai][bj][m][0] * r0, acc[ai][bj][m][1] * r1)); } } }
            asm volatile("" ::: "memory"); }
    }
};

struct EpiOut {
    static constexpr bool PERM = true, DUAL = false;
    const float* X; bf16_t* X1B; float* SS2;
    __device__ __forceinline__ void operator()(const Acc& acc, const Unit& u, int wr, int wc, int fr, int fq) const {
        const int rowt = u.pm * 256 + wr * 64 + fr, c0 = u.pn * 256 + wc * 32 + 8 * fq;
#pragma unroll
        for (int ai = 0; ai < 2; ++ai) {
            f32x4 xv[4][2][2];
#pragma unroll
            for (int m = 0; m < 4; ++m)
#pragma unroll
                for (int bj = 0; bj < 2; ++bj) { const unsigned o = (rowt + ai * 128 + m * 16) * 1024 + c0 + bj * 128; xv[m][bj][0] = __builtin_nontemporal_load((const f32x4*)(X + o)); xv[m][bj][1] = __builtin_nontemporal_load((const f32x4*)(X + (o + 4))); }
#pragma unroll
            for (int m = 0; m < 4; ++m) { const unsigned row = rowt + ai * 128 + m * 16; float ss = 0.f;
#pragma unroll
                for (int bj = 0; bj < 2; ++bj) { const unsigned o = row * 1024 + c0 + bj * 128;
                    const f32x4 v0 = acc[ai][bj][m][0] + xv[m][bj][0], v1 = acc[ai][bj][m][1] + xv[m][bj][1];
                    ss += (v0[0] * v0[0] + v0[1] * v0[1]) + (v0[2] * v0[2] + v0[3] * v0[3]) + (v1[0] * v1[0] + v1[1] * v1[1]) + (v1[2] * v1[2] + v1[3] * v1[3]);
                    ST16(X1B, o, pack8(v0, v1)); }
                ss += __shfl_xor(ss, 16); ss += __shfl_xor(ss, 32);
                if (fq == 0) atomicAdd(SS2 + row, ss); }
            asm volatile("" ::: "memory"); }
    }
};

struct EpiFfn {
    static constexpr bool PERM = true, DUAL = false;
    bf16_t* HID; const float* SS2;
    __device__ __forceinline__ void operator()(const Acc& acc, const Unit& u, int wr, int wc, int fr, int fq) const {
        const int rowt = u.pm * 256 + wr * 64 + fr, c0 = u.pn * 128 + wc * 32 + 8 * fq;
        float ss[8];
#pragma unroll
        for (int i = 0; i < 8; ++i) ss[i] = SS2[(unsigned)(rowt + (i >> 2) * 128 + (i & 3) * 16)];
#pragma unroll
        for (int ai = 0; ai < 2; ++ai)
#pragma unroll
            for (int m = 0; m < 4; ++m) { const unsigned row = rowt + ai * 128 + m * 16; const float rstd = rsqrtf(ss[ai * 4 + m] * (1.0f / 1024.0f) + EPS);
                f32x4 h0, h1;
#pragma unroll
                for (int e = 0; e < 4; ++e) { const float g0 = acc[ai][0][m][0][e] * rstd, g1 = acc[ai][0][m][1][e] * rstd;
                    h0[e] = g0 * fsigmoid(g0) * (acc[ai][1][m][0][e] * rstd); h1[e] = g1 * fsigmoid(g1) * (acc[ai][1][m][1][e] * rstd); }
                ST16(HID, (row * DFF + c0), pack8(h0, h1)); }
    }
};

struct EpiDown {
    static constexpr bool PERM = true, DUAL = false;
    bf16_t* X1B; float* SS3;
    __device__ __forceinline__ void operator()(const Acc& acc, const Unit& u, int wr, int wc, int fr, int fq) const {
        const int rowt = u.pm * 256 + wr * 64 + fr, c0 = u.pn * 256 + wc * 32 + 8 * fq;
        u32x4 xv[8][2];
#pragma unroll
        for (int i = 0; i < 8; ++i)
#pragma unroll
            for (int bj = 0; bj < 2; ++bj) xv[i][bj] = *(const u32x4*)(X1B + (unsigned)((rowt + (i >> 2) * 128 + (i & 3) * 16) * 1024 + c0 + bj * 128));
#pragma unroll
        for (int ai = 0; ai < 2; ++ai)
#pragma unroll
            for (int m = 0; m < 4; ++m) { const unsigned row = rowt + ai * 128 + m * 16; float ss = 0.f;
#pragma unroll
                for (int bj = 0; bj < 2; ++bj) { const unsigned o = row * 1024 + c0 + bj * 128; f32x4 p0, p1; unpack8(xv[ai * 4 + m][bj], p0, p1);
                    const f32x4 v0 = acc[ai][bj][m][0] + p0, v1 = acc[ai][bj][m][1] + p1;
                    ss += (v0[0] * v0[0] + v0[1] * v0[1]) + (v0[2] * v0[2] + v0[3] * v0[3]) + (v1[0] * v1[0] + v1[1] * v1[1]) + (v1[2] * v1[2] + v1[3] * v1[3]);
                    ST16(X1B, o, pack8(v0, v1)); }
                ss += __shfl_xor(ss, 16); ss += __shfl_xor(ss, 32);
                if (fq == 0) atomicAdd(SS3 + row, ss); }
    }
};

namespace att {
constexpr int NW = 8, QBLK = 32, KVBLK = 64;
constexpr float SCALE = 0.10206207261596577f;
constexpr float THR = 8.f;
constexpr int SHM_V = 16384, SHM_K = 16384;
#define KSWZ(row, colB) ((row) * 256 + ((colB) ^ (((row) & 7) << 4)))
#define SBAR() __builtin_amdgcn_sched_barrier(0)
__device__ __forceinline__ int crow(int r, int hi) { return (r & 3) + 8 * (r >> 2) + 4 * hi; }
template <bool FIRST> __device__ __forceinline__ void partialSM(f32x16& p0, f32x16& p1, float& mref, f32x16& negm, float& alpha) {
  constexpr float THRL = THR * 1.4426950408889634f;
  float pmax = p0[0];
#pragma unroll
  for (int r = 1; r < 16; ++r) pmax = fmaxf(pmax, p0[r]);
#pragma unroll
  for (int r = 0; r < 16; ++r) pmax = fmaxf(pmax, p1[r]);
  { auto rr = __builtin_amdgcn_permlane32_swap(__float_as_uint(pmax), __float_as_uint(pmax), false, false);
    pmax = fmaxf(__uint_as_float(rr[0]), __uint_as_float(rr[1])); }
  if (!FIRST && __builtin_expect(__all(pmax <= THRL), 1)) { alpha = 1.f; }
  else { const float dl = FIRST ? pmax : fmaxf(pmax, 0.f); mref += dl; alpha = FIRST ? 1.f : __builtin_amdgcn_exp2f(-dl);
#pragma unroll
    for (int r = 0; r < 16; ++r) { p0[r] -= dl; p1[r] -= dl; }
    const float nm = -mref;
#pragma unroll
    for (int r = 0; r < 16; ++r) negm[r] = nm; }
#pragma unroll
  for (int r = 0; r < 16; ++r) p0[r] = __builtin_amdgcn_exp2f(p0[r]);
}
__device__ __forceinline__ void finishSM(f32x16& p0, f32x16& p1, float alpha, float& l_reg, bf16x8& pa0, bf16x8& pa1, bf16x8& pa2, bf16x8& pa3) {
#pragma unroll
  for (int r = 0; r < 16; ++r) p1[r] = __builtin_amdgcn_exp2f(p1[r]);
  float ps = 0;
#pragma unroll
  for (int r = 0; r < 16; ++r) ps += p0[r];
#pragma unroll
  for (int r = 0; r < 16; ++r) ps += p1[r];
  { auto rr = __builtin_amdgcn_permlane32_swap(__float_as_uint(ps), __float_as_uint(ps), false, false);
    ps = __uint_as_float(rr[0]) + __uint_as_float(rr[1]); }
  l_reg = l_reg * alpha + ps;
#define PK4(P, BASE, OUT) do { u32x4 w = {cvt_pk_bf16(P[BASE + 0], P[BASE + 1]), cvt_pk_bf16(P[BASE + 2], P[BASE + 3]), cvt_pk_bf16(P[BASE + 4], P[BASE + 5]), cvt_pk_bf16(P[BASE + 6], P[BASE + 7])}; \
    OUT = *reinterpret_cast<bf16x8*>(&w); } while (0)
  PK4(p0, 0, pa0); PK4(p0, 8, pa1); PK4(p1, 0, pa2); PK4(p1, 8, pa3);
#undef PK4
}
__device__ __forceinline__ void qkt(f32x16& p0, f32x16& p1, const char* Ks, const bf16x8* qr, const f32x16& negm, int r32, int hi) {
  p0 = negm; p1 = negm;
#pragma unroll
  for (int d0 = 0; d0 < 6; ++d0) { int cb = (d0 * 16 + hi * 8) * 2;
    bf16x8 b0 = *reinterpret_cast<const bf16x8*>(Ks + KSWZ(r32, cb));
    bf16x8 b1 = *reinterpret_cast<const bf16x8*>(Ks + KSWZ(32 + r32, cb));
    p0 = __builtin_amdgcn_mfma_f32_32x32x16_bf16(b0, qr[d0], p0, 0, 0, 0);
    p1 = __builtin_amdgcn_mfma_f32_32x32x16_bf16(b1, qr[d0], p1, 0, 0, 0); }
}
__device__ __forceinline__ int v_st(int k, int c) { const int kk = k; return ((kk >> 3) * 4 + (c >> 5)) * 512 + ((kk & 7) * 32 + (c & 31)) * 2; }
__device__ __forceinline__ int v_rd_base(int lane) { return ((lane & 3) << 3) | (((lane >> 2) & 3) << 6) | (((lane >> 4) & 1) << 5) | (((lane >> 5) & 1) << 8); }
constexpr int v_rd_off(int d0, int ks, int half) { return d0 * 512 + ks * 4096 + half * 2048; }
typedef short v4i16_t __attribute__((ext_vector_type(4)));
typedef LAS const char* lds_cptr;
__device__ __forceinline__ s16x4 vtr(lds_cptr p) { return __builtin_bit_cast(s16x4, __builtin_amdgcn_ds_read_tr16_b64_v4i16((LAS v4i16_t*)p)); }
template <int D0> __device__ __forceinline__ void pv_one(f32x16& od, lds_cptr vp, bf16x8 pa0, bf16x8 pa1, bf16x8 pa2, bf16x8 pa3) {
  const s16x4 l0 = vtr(vp + v_rd_off(D0, 0, 0)), h0 = vtr(vp + v_rd_off(D0, 0, 1)), l1 = vtr(vp + v_rd_off(D0, 1, 0)), h1 = vtr(vp + v_rd_off(D0, 1, 1));
  const s16x4 l2 = vtr(vp + v_rd_off(D0, 2, 0)), h2 = vtr(vp + v_rd_off(D0, 2, 1)), l3 = vtr(vp + v_rd_off(D0, 3, 0)), h3 = vtr(vp + v_rd_off(D0, 3, 1));
#define PK(L, H) (bf16x8){L[0], L[1], L[2], L[3], H[0], H[1], H[2], H[3]}
  od = __builtin_amdgcn_mfma_f32_32x32x16_bf16(pa0, PK(l0, h0), od, 0, 0, 0);
  od = __builtin_amdgcn_mfma_f32_32x32x16_bf16(pa1, PK(l1, h1), od, 0, 0, 0);
  od = __builtin_amdgcn_mfma_f32_32x32x16_bf16(pa2, PK(l2, h2), od, 0, 0, 0);
  od = __builtin_amdgcn_mfma_f32_32x32x16_bf16(pa3, PK(l3, h3), od, 0, 0, 0);
#undef PK
}
__device__ __forceinline__ void pv_d0(f32x16* o, lds_cptr vp, bf16x8 pa0, bf16x8 pa1, bf16x8 pa2, bf16x8 pa3) {
  pv_one<0>(o[0], vp, pa0, pa1, pa2, pa3); pv_one<1>(o[1], vp, pa0, pa1, pa2, pa3);
}
__device__ __forceinline__ void attn_unit(const bf16_t* __restrict__ Qb, const bf16_t* __restrict__ KNh, const bf16_t* __restrict__ KRb, const bf16_t* __restrict__ Vh, bf16_t* __restrict__ Ob, char* lds) {
  const int tid = threadIdx.x, wid = tid >> 6, lane = tid & 63, r32 = lane & 31, hi = lane >> 5;
#define ABAR() asm volatile("s_waitcnt lgkmcnt(0)\n\ts_barrier" ::: "memory")
  char* V_lds = lds; char* K_lds = lds + 4 * SHM_V;
  float* ws = (float*)(lds + 4 * SHM_V + 4 * SHM_K) + wid * 64; float* li_l = ws; float* al_l = ws + 32;
  float mref = 0.f, l_reg = 0; f32x16 negm = {}; f32x16 o[2] = {}; bf16x8 qr[6];
  const bf16_t* Qw = Qb + (long)(wid * QBLK + r32) * 768 + hi * 8;
#pragma unroll
  for (int d0 = 0; d0 < 6; ++d0) qr[d0] = *reinterpret_cast<const bf16x8*>(Qw + d0 * 16);
  const int sr = tid >> 3, sc = (tid & 7) * 8, vst = v_st(sr, sc), kst = KSWZ(sr, sc * 2), krst = KSWZ(sr, 128 + (tid & 7) * 8);
  const lds_cptr vb0 = (lds_cptr)(LAS char*)lds + v_rd_base(lane);
  struct { bf16x8 vs, ks; s16x4 kr; } sr_[2];
  const unsigned lo_kv = (unsigned)(sr * 512 + sc), lo_kr = (unsigned)(sr * 32 + (tid & 7) * 4);
#define SLOAD(i, k0) do { const bf16_t* vt_ = Vh + (size_t)(k0) * 512; const bf16_t* kt_ = KNh + (size_t)(k0) * 512; const bf16_t* rt_ = KRb + (size_t)(k0) * 32; \
    sr_[i].vs = *reinterpret_cast<const bf16x8*>(vt_ + lo_kv); sr_[i].ks = *reinterpret_cast<const bf16x8*>(kt_ + lo_kv); sr_[i].kr = *reinterpret_cast<const s16x4*>(rt_ + lo_kr); } while (0)
#define SWRITE(slot, i) do { *(bf16x8*)(V_lds + (slot) * SHM_V + vst) = sr_[i].vs; *(bf16x8*)(K_lds + (slot) * SHM_K + kst) = sr_[i].ks; *(s16x4*)(K_lds + (slot) * SHM_K + krst) = sr_[i].kr; } while (0)
#define RESC(a) do { if (__any((a) < 1.f)) { if (hi == 0) al_l[r32] = (a); asm volatile("s_waitcnt lgkmcnt(0)" ::: "memory"); \
    _Pragma("unroll") for (int d = 0; d < 2; ++d) _Pragma("unroll") for (int r = 0; r < 16; ++r) o[d][r] *= al_l[crow(r, hi)]; } } while (0)
  f32x16 pA0, pA1, pB0, pB1; float alA, alB; bf16x8 pa0, pa1, pa2, pa3; constexpr int NT = SEQ / KVBLK;
  SLOAD(0, 0); SLOAD(1, KVBLK); asm volatile("s_waitcnt vmcnt(0)" ::: "memory"); SWRITE(0, 0); SWRITE(1, 1); SLOAD(0, 2 * KVBLK); ABAR();
  qkt(pA0, pA1, K_lds, qr, negm, r32, hi); partialSM<true>(pA0, pA1, mref, negm, alA);
  SWRITE(2, 0); SLOAD(1, 3 * KVBLK); ABAR();
  for (int j = 1; j + 1 < NT; j += 2) {
    SBAR(); qkt(pB0, pB1, K_lds + (j & 3) * SHM_K, qr, negm, r32, hi);
    finishSM(pA0, pA1, alA, l_reg, pa0, pa1, pa2, pa3); SBAR();
    if (j + 2 < NT) { SWRITE((j + 2) & 3, 1); } if (j + 3 < NT) { SLOAD(0, (j + 3) * KVBLK); } SBAR();
    pv_d0(o, vb0 + ((j - 1) & 3) * SHM_V, pa0, pa1, pa2, pa3); partialSM<false>(pB0, pB1, mref, negm, alB);
    RESC(alB); ABAR();
    SBAR(); qkt(pA0, pA1, K_lds + ((j + 1) & 3) * SHM_K, qr, negm, r32, hi);
    finishSM(pB0, pB1, alB, l_reg, pa0, pa1, pa2, pa3); SBAR();
    if (j + 3 < NT) { SWRITE((j + 3) & 3, 0); } if (j + 4 < NT) { SLOAD(1, (j + 4) * KVBLK); } SBAR();
    pv_d0(o, vb0 + (j & 3) * SHM_V, pa0, pa1, pa2, pa3); partialSM<false>(pA0, pA1, mref, negm, alA);
    RESC(alA); ABAR();
  }
  SBAR(); qkt(pB0, pB1, K_lds + ((NT - 1) & 3) * SHM_K, qr, negm, r32, hi);
  finishSM(pA0, pA1, alA, l_reg, pa0, pa1, pa2, pa3); SBAR();
  pv_d0(o, vb0 + ((NT - 2) & 3) * SHM_V, pa0, pa1, pa2, pa3); partialSM<false>(pB0, pB1, mref, negm, alB);
  RESC(alB);
  finishSM(pB0, pB1, alB, l_reg, pa0, pa1, pa2, pa3); SBAR();
  pv_d0(o, vb0 + ((NT - 1) & 3) * SHM_V, pa0, pa1, pa2, pa3);
  if (hi == 0) li_l[r32] = l_reg; asm volatile("s_waitcnt lgkmcnt(0)" ::: "memory");
  float rli[16];
#pragma unroll
  for (int r = 0; r < 16; ++r) rli[r] = __builtin_amdgcn_rcpf(li_l[crow(r, hi)]);
  bf16_t* Ow = Ob + (long)(wid * QBLK) * 512;
#pragma unroll
  for (int r = 0; r < 16; ++r) { int orow = crow(r, hi);
#pragma unroll
    for (int d0 = 0; d0 < 2; ++d0) Ow[(long)orow * 512 + d0 * 32 + r32] = (bf16_t)(cvt_pk_bf16(o[d0][r] * rli[r], 0.f) & 0xffffu); }
  ABAR();
#undef SLOAD
#undef SWRITE
#undef RESC
#undef ABAR
}
#undef KSWZ
#undef SBAR
}

__device__ __forceinline__ void h2f(unsigned w, float& lo, float& hi) { const __half2 h = *(const __half2*)&w; const float2 f = __half22float2(h); lo = f.x; hi = f.y; }
__device__ __forceinline__ void scan_item(int b, int cgp, unsigned* AU, const bf16_t* LY, bf16_t* REC, float* sc) {
    const int tid = threadIdx.x, wid = tid >> 6, lane = tid & 63, c = cgp * 64 + lane;
    const unsigned r0 = (unsigned)b * SEQ + wid * 256;
    unsigned* au0 = AU + c; unsigned* au1 = AU + (size_t)T * 512 + c; const bf16_t* ly = LY + c; bf16_t* rec = REC + c;
#define SC_STEP(W, H) do { float la_, u_; h2f(W, la_, u_); H = __builtin_amdgcn_exp2f(la_) * H + u_; } while (0)
    { float hf = 0.f, hb = 0.f, slf = 0.f, slb = 0.f; unsigned fa[16], ba[16], fb[16], bb[16];
#pragma unroll
      for (int k = 0; k < 16; ++k) { fa[k] = au0[(r0 + k) * 512]; ba[k] = au1[(r0 + 255 - k) * 512]; }
#pragma unroll 1
      for (int blk = 0; blk < 16; blk += 2) {
#pragma unroll
          for (int k = 0; k < 16; ++k) { fb[k] = au0[(r0 + (blk + 1) * 16 + k) * 512]; bb[k] = au1[(r0 + 255 - ((blk + 1) * 16 + k)) * 512]; }
#pragma unroll
          for (int k = 0; k < 16; ++k) { float la, u; h2f(fa[k], la, u); hf = __builtin_amdgcn_exp2f(la) * hf + u; slf += la; h2f(ba[k], la, u); hb = __builtin_amdgcn_exp2f(la) * hb + u; slb += la; }
          if (blk + 2 < 16) {
#pragma unroll
              for (int k = 0; k < 16; ++k) { fa[k] = au0[(r0 + (blk + 2) * 16 + k) * 512]; ba[k] = au1[(r0 + 255 - ((blk + 2) * 16 + k)) * 512]; } }
#pragma unroll
          for (int k = 0; k < 16; ++k) { float la, u; h2f(fb[k], la, u); hf = __builtin_amdgcn_exp2f(la) * hf + u; slf += la; h2f(bb[k], la, u); hb = __builtin_amdgcn_exp2f(la) * hb + u; slb += la; }
      }
      sc[wid * 64 + lane] = __builtin_amdgcn_exp2f(slf); sc[1024 + wid * 64 + lane] = hf;
      sc[(8 + wid) * 64 + lane] = __builtin_amdgcn_exp2f(slb); sc[1024 + (8 + wid) * 64 + lane] = hb; }
    __syncthreads();
    float cin0 = 0.f, cin1 = 0.f;
    for (int k = 0; k < wid; ++k) cin0 = sc[k * 64 + lane] * cin0 + sc[1024 + k * 64 + lane];
    for (int k = 7; k > wid; --k) cin1 = sc[(8 + k) * 64 + lane] * cin1 + sc[1024 + (8 + k) * 64 + lane];
    { float h = cin0; unsigned wa[16], wb[16];
#pragma unroll
      for (int k = 0; k < 16; ++k) wa[k] = au0[(r0 + k) * 512];
#pragma unroll 1
      for (int blk = 0; blk < 16; blk += 2) {
#pragma unroll
          for (int k = 0; k < 16; ++k) wb[k] = au0[(r0 + (blk + 1) * 16 + k) * 512];
#pragma unroll
          for (int k = 0; k < 16; ++k) { SC_STEP(wa[k], h); rec[(r0 + blk * 16 + k) * 512] = (bf16_t)(cvt_pk_bf16(h, 0.f) & 0xffffu); }
          if (blk + 2 < 16) {
#pragma unroll
              for (int k = 0; k < 16; ++k) wa[k] = au0[(r0 + (blk + 2) * 16 + k) * 512]; }
#pragma unroll
          for (int k = 0; k < 16; ++k) { SC_STEP(wb[k], h); rec[(r0 + (blk + 1) * 16 + k) * 512] = (bf16_t)(cvt_pk_bf16(h, 0.f) & 0xffffu); }
      } }
    { float h = cin1; unsigned wa[16], wb[16]; bf16_t fa[16], fb[16], ya[16], yb[16];
#pragma unroll
      for (int k = 0; k < 16; ++k) { const unsigned row = r0 + 255 - k; wa[k] = au1[row * 512]; fa[k] = rec[row * 512]; ya[k] = ly[row * 512]; }
#pragma unroll 1
      for (int blk = 0; blk < 16; blk += 2) {
#pragma unroll
          for (int k = 0; k < 16; ++k) { const unsigned row = r0 + 255 - ((blk + 1) * 16 + k); wb[k] = au1[row * 512]; fb[k] = rec[row * 512]; yb[k] = ly[row * 512]; }
#pragma unroll
          for (int k = 0; k < 16; ++k) { const unsigned row = r0 + 255 - (blk * 16 + k); SC_STEP(wa[k], h);
              const float tot = (h + __uint_as_float((unsigned)fa[k] << 16)) * __uint_as_float((unsigned)ya[k] << 16); rec[row * 512] = (bf16_t)(cvt_pk_bf16(tot, 0.f) & 0xffffu); }
          if (blk + 2 < 16) {
#pragma unroll
              for (int k = 0; k < 16; ++k) { const unsigned row = r0 + 255 - ((blk + 2) * 16 + k); wa[k] = au1[row * 512]; fa[k] = rec[row * 512]; ya[k] = ly[row * 512]; } }
#pragma unroll
          for (int k = 0; k < 16; ++k) { const unsigned row = r0 + 255 - ((blk + 1) * 16 + k); SC_STEP(wb[k], h);
              const float tot = (h + __uint_as_float((unsigned)fb[k] << 16)) * __uint_as_float((unsigned)yb[k] << 16); rec[row * 512] = (bf16_t)(cvt_pk_bf16(tot, 0.f) & 0xffffu); }
      } }
#undef SC_STEP
    __syncthreads();
}

template <class F> __device__ __forceinline__ void xpose(bf16_t* Bt, int N, int K, F f, int gw, int NGW, int lane) {
    const int nN = N / 64, total = nN * (K / 8);
    for (int item = gw; item < total; item += NGW) { const int ng = item % nN, kc = item / nN, n = ng * 64 + lane, k0 = kc * 8;
        float v[8];
#pragma unroll
        for (int e = 0; e < 8; ++e) v[e] = f(n, k0 + e);
        u32x4 w; w.x = cvt_pk_bf16(v[0], v[1]); w.y = cvt_pk_bf16(v[2], v[3]); w.z = cvt_pk_bf16(v[4], v[5]); w.w = cvt_pk_bf16(v[6], v[7]);
        *(u32x4*)(Bt + (size_t)n * K + k0) = w; }
}


template <class F> __device__ __forceinline__ void xpose_one(bf16_t* Bt, int N, int K, F f, int item, int lane) {
    const int nN = N / 64, n = (item % nN) * 64 + lane, k0 = (item / nN) * 8;
    float v[8];
#pragma unroll
    for (int e = 0; e < 8; ++e) v[e] = f(n, k0 + e);
    u32x4 w; w.x = cvt_pk_bf16(v[0], v[1]); w.y = cvt_pk_bf16(v[2], v[3]); w.z = cvt_pk_bf16(v[4], v[5]); w.w = cvt_pk_bf16(v[6], v[7]);
    *(u32x4*)(Bt + (size_t)n * K + k0) = w;
}

#define XB_TMO      128
#define XB_XCNT(j)  (256  + 64 * (j))
#define XB_XSUB(j)  (1280 + 64 * (j))
#define XB_XGEN(j)  (2304 + 64 * (j))
#define XB_TOP      3328
#define XB_TOPGEN   3392
#define XCD_BAR_WORDS 3456
#define XB_SPIN_CAP (1u << 18)
__device__ __forceinline__ unsigned xb_ld(unsigned* p)              { return __hip_atomic_load(p, __ATOMIC_RELAXED, __HIP_MEMORY_SCOPE_AGENT); }
__device__ __forceinline__ unsigned xb_add(unsigned* p, unsigned v) { return __hip_atomic_fetch_add(p, v, __ATOMIC_RELAXED, __HIP_MEMORY_SCOPE_AGENT); }
__device__ __forceinline__ unsigned xb_xcc_id() { return (unsigned)__builtin_amdgcn_s_getreg((3 << 11) | 20) & 0xFu; }
#define XB_SPIN(cond, bar) do { unsigned _sp = 0; while (cond) { __builtin_amdgcn_s_sleep(1); \
    if ((++_sp & 255u) == 0u) { if (xb_ld(&(bar)[XB_TMO])) break; if (_sp > XB_SPIN_CAP) { atomicAdd(&(bar)[XB_TMO], 1u); break; } } } } while (0)
struct XcdBarrier { unsigned* bar; unsigned x; volatile LAS unsigned* st; };
__device__ __forceinline__ XcdBarrier xcd_barrier_post(unsigned* bar, volatile LAS unsigned* st) {
    XcdBarrier b; b.bar = bar; b.x = xb_xcc_id(); b.st = st;
    if (threadIdx.x == 0) (void)xb_add(&bar[XB_XCNT(b.x)], 1u);
    return b;
}
__device__ __forceinline__ void xcd_barrier_complete(unsigned* bar, unsigned x, unsigned& nloc, unsigned& nx) {
    const unsigned G = gridDim.x * gridDim.y * gridDim.z;
    unsigned sum, cnt, mine, sp = 0u;
    for (;;) {
        sum = 0u; cnt = 0u; mine = 0u;
#pragma unroll
        for (unsigned j = 0; j < 16; ++j) { const unsigned c = xb_ld(&bar[XB_XCNT(j)]); sum += c; cnt += (c > 0u) ? 1u : 0u; mine = (j == x) ? c : mine; }
        if (sum == G) break;
        __builtin_amdgcn_s_sleep(1);
        if ((++sp & 255u) == 0u) { if (xb_ld(&bar[XB_TMO])) break; if (sp > XB_SPIN_CAP) { atomicAdd(&bar[XB_TMO], 1u); break; } }
    }
    nloc = mine > 0u ? mine : 1u; nx = cnt > 0u ? cnt : 1u;
}
__device__ __forceinline__ void xcd_barrier(const XcdBarrier& b) {
    asm volatile("s_waitcnt vmcnt(0)" ::: "memory");
    __syncthreads();
    if (threadIdx.x == 0) {
        unsigned* bar = b.bar;
        __builtin_amdgcn_s_waitcnt(0);
        unsigned nloc = b.st[0], nx = b.st[1];
        if (nloc == 0u) { xcd_barrier_complete(bar, b.x, nloc, nx); b.st[0] = nloc; b.st[1] = nx; }
        const unsigned old = xb_add(&bar[XB_XSUB(b.x)], 1u);
        const unsigned gen = old / nloc;
        if (old + 1u == (gen + 1u) * nloc) {
            __builtin_amdgcn_fence(__ATOMIC_RELEASE, "agent");
            asm volatile("s_waitcnt vmcnt(0)" ::: "memory");
            const unsigned og = xb_add(&bar[XB_TOP], 1u);
            const unsigned tg = og / nx;
            if (og + 1u == (tg + 1u) * nx) xb_add(&bar[XB_TOPGEN], 1u);
            else XB_SPIN(xb_ld(&bar[XB_TOPGEN]) == tg, bar);
            __builtin_amdgcn_fence(__ATOMIC_ACQUIRE, "agent");
            xb_add(&bar[XB_XGEN(b.x)], 1u);
            asm volatile("s_waitcnt vmcnt(0)" ::: "memory");
        } else {
            XB_SPIN(xb_ld(&bar[XB_XGEN(b.x)]) == gen, bar);
            __builtin_amdgcn_fence(__ATOMIC_ACQUIRE, "agent");
            asm volatile("s_waitcnt vmcnt(0)" ::: "memory");
        }
    }
    __syncthreads();
}

constexpr size_t MiB = 1u << 20;
constexpr size_t WS_SS = 0;
constexpr size_t WS_ROPE = 1 * MiB;
constexpr size_t WS_SP8 = WS_ROPE + 256 * 1024;
constexpr size_t WS_BAR = 1 * MiB + 512 * 1024;
constexpr size_t WS_WIN = 2 * MiB;
constexpr size_t WS_WQB = 9 * MiB;
constexpr size_t WS_WKVB = WS_WQB + 512 * 1024;
constexpr size_t WS_WG = 10 * MiB;
constexpr size_t WS_WOA = 11 * MiB;
constexpr size_t WS_WOL = 12 * MiB;
constexpr size_t WS_WOUT = 13 * MiB;
constexpr size_t WS_WGU = 15 * MiB;
constexpr size_t WS_WD = 26 * MiB;
constexpr size_t WS_A = 40 * MiB;
constexpr size_t WS_GATES = 168 * MiB;
constexpr size_t WS_LY = 424 * MiB;
constexpr size_t WS_LX = 488 * MiB;
constexpr size_t WS_QA = 552 * MiB;
constexpr size_t WS_KVA = 584 * MiB;
constexpr size_t WS_KN = 616 * MiB;
constexpr size_t WS_V = 680 * MiB;
constexpr size_t WS_KR = 744 * MiB;
constexpr size_t WS_XC = 748 * MiB;
constexpr size_t WS_X1B = 616 * MiB;
constexpr size_t WS_HID = 168 * MiB;
constexpr size_t WS_END = 812 * MiB;

struct Args { const float* in[22]; float* out; unsigned char* ws; int ph_lo, ph_hi; };

__global__ void __launch_bounds__(512, 2) mega_fwd(Args args) {
    extern __shared__ __attribute__((aligned(16))) unsigned char lds_raw[];
    LAS unsigned char* lds = (LAS unsigned char*)lds_raw;
    const int tid = threadIdx.x;
#define PHASE_IDS const int lane = threadIdx.x & 63, wave = __builtin_amdgcn_readfirstlane(threadIdx.x >> 6), gw = bid * 8 + wave, NGW = G * 8, gtid = bid * 512 + (int)threadIdx.x, NTH = G * 512; (void)lane; (void)gw; (void)NGW; (void)gtid; (void)NTH
    const int G = gridDim.x, bid = blockIdx.x;
    unsigned char* ws = args.ws;
    float* SSQ = (float*)(ws + WS_SS); float* SSKV = SSQ + T; float* SS2 = SSKV + T; float* SS3 = SS2 + T;
    float* ROPE = (float*)(ws + WS_ROPE); float* SP8 = (float*)(ws + WS_SP8);
    bf16_t* WIN = (bf16_t*)(ws + WS_WIN); bf16_t* WQB = (bf16_t*)(ws + WS_WQB); bf16_t* WKVB = (bf16_t*)(ws + WS_WKVB); bf16_t* WG = (bf16_t*)(ws + WS_WG);
    bf16_t* WOA = (bf16_t*)(ws + WS_WOA); bf16_t* WOL = (bf16_t*)(ws + WS_WOL); bf16_t* WOUT = (bf16_t*)(ws + WS_WOUT); bf16_t* WGU = (bf16_t*)(ws + WS_WGU); bf16_t* WD = (bf16_t*)(ws + WS_WD);
    bf16_t* XN = (bf16_t*)(ws + WS_A); bf16_t* Qb = (bf16_t*)(ws + WS_A); bf16_t* MERGED = (bf16_t*)(ws + WS_A);
    bf16_t* GATES = (bf16_t*)(ws + WS_GATES); bf16_t* LY = (bf16_t*)(ws + WS_LY); bf16_t* LX = (bf16_t*)(ws + WS_LX); bf16_t* ATT = (bf16_t*)(ws + WS_LX);
    bf16_t* QA = (bf16_t*)(ws + WS_QA); bf16_t* KVA = (bf16_t*)(ws + WS_KVA); bf16_t* REC = (bf16_t*)(ws + WS_QA);
    bf16_t* KN = (bf16_t*)(ws + WS_KN); bf16_t* Vb = (bf16_t*)(ws + WS_V); bf16_t* KR = (bf16_t*)(ws + WS_KR); bf16_t* XC = (bf16_t*)(ws + WS_XC);
    bf16_t* X1B = (bf16_t*)(ws + WS_X1B); bf16_t* HID = (bf16_t*)(ws + WS_HID);
    unsigned* AU = (unsigned*)args.out;
    const int lo = args.ph_lo, hi = args.ph_hi;
    volatile LAS unsigned* xst = (volatile LAS unsigned*)(lds + 140032);
    if (tid < 2) xst[tid] = 0u;
    __syncthreads();
    XcdBarrier xbar; xbar.bar = (unsigned*)(ws + WS_BAR); xbar.x = 0; xbar.st = xst;
    if (hi - lo > 1) xbar = xcd_barrier_post((unsigned*)(ws + WS_BAR), xst);
#define IN(k) (((PHASE_MASK >> (k)) & 1) && lo <= (k) && (k) < hi)
#if PROBE_MASK
    unsigned long long pr_acc = 0, pr_t0 = __builtin_amdgcn_s_memrealtime();
#define SEAM(k) do { if (IN(k) && IN((k) + 1)) { if ((k) == 0) cg::this_grid().sync(); else xcd_barrier(xbar); } { const unsigned long long t1_ = __builtin_amdgcn_s_memrealtime(); if ((PROBE_MASK >> (k)) & 1) pr_acc += t1_ - pr_t0; pr_t0 = t1_; } } while (0)
#else
#define SEAM(k) do { if (IN(k) && IN((k) + 1)) { if ((k) == 0) cg::this_grid().sync(); else xcd_barrier(xbar); } } while (0)
#endif

    if (IN(0)) { PHASE_IDS;
        for (int i = gtid; i < 4 * T; i += NTH) SSQ[i] = 0.f;
        for (int i = gtid; i < SEQ * 16; i += NTH) { const int pos = i >> 4, fi = i & 15; const float inv = 1.0f / powf(10000.0f, (float)fi * (1.0f / 16.0f)); const float ang = (float)pos * inv;
            float s, c; sincosf(ang, &s, &c); ROPE[pos * 32 + fi] = c; ROPE[pos * 32 + 16 + fi] = s; }
        for (int i = gtid; i < 1024; i += NTH) { const float lam = args.in[14][i]; SP8[i] = 8.0f * log1pf(expf(-lam)); }
        {
          const float* w_in = args.in[2]; const float* w_qb = args.in[4]; const float* g_q = args.in[3]; const float* w_kvb = args.in[6]; const float* g_kv = args.in[5];
          const float* wr_ = args.in[10]; const float* wi_ = args.in[12]; const float* w_oa = args.in[7]; const float* w_ol = args.in[15]; const float* w_o = args.in[16];
          const float* wg_ = args.in[18]; const float* wu_ = args.in[19]; const float* g2 = args.in[17]; const float* w_d = args.in[20];
          constexpr int I0 = (DIN_PAD / 64) * (1024 / 8), I1 = (768 / 64) * (256 / 8), I2 = (1024 / 64) * (128 / 8), I3 = (2048 / 64) * (128 / 8), I4 = (1024 / 64) * (512 / 8), I5 = I4,
                        I6 = (1024 / 64) * (1024 / 8), I7 = (2 * DFF / 64) * (1024 / 8), I8 = (1024 / 64) * (DFF / 8), ITOT = I0 + I1 + I2 + I3 + I4 + I5 + I6 + I7 + I8;
          auto do_item = [&](int gi) { int r = gi;
              if (r < I0) { xpose_one(WIN, DIN_PAD, 1024, [=](int n, int k) -> float { int src;
                  if (n < 384) src = n; else if (n < 416) { const int j = n - 384; src = 384 + (j & 1) * 16 + (j >> 1); } else if (n < 512) src = -1;
                  else if (n < 1024) src = 416 + (n - 512); else if (n < 1536) src = 928 + (n - 1024); else src = 1440 + (n - 1536);
                  return src < 0 ? 0.f : w_in[(size_t)k * DIN_SRC + src]; }, r, lane); return; } r -= I0;
              if (r < I1) { xpose_one(WQB, 768, 256, [=](int n, int k) -> float { const int h = n / 96, dp = n % 96; int d = dp; if (dp >= 64) { const int j = dp - 64; d = 64 + (j & 1) * 16 + (j >> 1); }
                  return w_qb[(size_t)k * 768 + h * 96 + d] * g_q[k]; }, r, lane); return; } r -= I1;
              if (r < I2) { xpose_one(WKVB, 1024, 128, [=](int n, int k) -> float { const int nn = n & 511, h = nn >> 6, d = nn & 63; return w_kvb[(size_t)k * 1024 + h * 128 + (n >> 9) * 64 + d] * g_kv[k]; }, r, lane); return; } r -= I2;
              if (r < I3) { xpose_one(WG, 2048, 128, [=](int n, int k) -> float { const int g = n >> 8, bj = (n >> 7) & 1, j = n & 127, blk = g >> 1, dir = g & 1;
                  return (bj ? wi_ : wr_)[((size_t)(dir * 4 + blk) * 128 + k) * 128 + j]; }, r, lane); return; } r -= I3;
              if (r < I4) { xpose_one(WOA, 1024, 512, [=](int n, int k) -> float { return w_oa[(size_t)k * 1024 + n]; }, r, lane); return; } r -= I4;
              if (r < I5) { xpose_one(WOL, 1024, 512, [=](int n, int k) -> float { return w_ol[(size_t)k * 1024 + n]; }, r, lane); return; } r -= I5;
              if (r < I6) { xpose_one(WOUT, 1024, 1024, [=](int n, int k) -> float { return w_o[(size_t)k * 1024 + n]; }, r, lane); return; } r -= I6;
              if (r < I7) { xpose_one(WGU, 2 * DFF, 1024, [=](int n, int k) -> float { const int pn = n >> 8, bj = (n >> 7) & 1, j = n & 127; return (bj ? wu_ : wg_)[(size_t)k * DFF + pn * 128 + j] * g2[k]; }, r, lane); return; } r -= I7;
              xpose_one(WD, 1024, DFF, [=](int n, int k) -> float { return w_d[(size_t)k * 1024 + n]; }, r, lane); };
          const float* x = args.in[0]; const float* g1 = args.in[1];
          f32x4 gv[4];
#pragma unroll
          for (int j = 0; j < 4; ++j) gv[j] = *((const f32x4*)g1 + lane + 64 * j);
          int gi = gw;
          for (int m = gw; m < T; m += 2 * NGW) { const int m2 = m + NGW; const bool two = m2 < T; const int mb = two ? m2 : m;
              const f32x4* xr = (const f32x4*)(x + (size_t)m * DM) + lane; const f32x4* xr2 = (const f32x4*)(x + (size_t)mb * DM) + lane; f32x4 v[4], v2[4]; float s = 0.f, s2 = 0.f;
#pragma unroll
              for (int j = 0; j < 4; ++j) { v[j] = __builtin_nontemporal_load(xr + 64 * j); v2[j] = __builtin_nontemporal_load(xr2 + 64 * j); }
              if (gi < ITOT) { do_item(gi); gi += NGW; }
#pragma unroll
              for (int j = 0; j < 4; ++j) { s += (v[j].x * v[j].x + v[j].y * v[j].y) + (v[j].z * v[j].z + v[j].w * v[j].w); s2 += (v2[j].x * v2[j].x + v2[j].y * v2[j].y) + (v2[j].z * v2[j].z + v2[j].w * v2[j].w); }
              const float rstd = rsqrtf(wave_sum(s) * (1.0f / DM) + EPS), rstd2 = rsqrtf(wave_sum(s2) * (1.0f / DM) + EPS);
              u32x2* o8 = (u32x2*)(XN + (size_t)m * DM) + lane; u32x2* o82 = (u32x2*)(XN + (size_t)mb * DM) + lane;
#pragma unroll
              for (int j = 0; j < 4; ++j) { const f32x4 y = v[j] * rstd * gv[j]; u32x2 w2; w2.x = cvt_pk_bf16(y.x, y.y); w2.y = cvt_pk_bf16(y.z, y.w); o8[64 * j] = w2; }
              if (two) {
#pragma unroll
                  for (int j = 0; j < 4; ++j) { const f32x4 y = v2[j] * rstd2 * gv[j]; u32x2 w2; w2.x = cvt_pk_bf16(y.x, y.y); w2.y = cvt_pk_bf16(y.z, y.w); o82[64 * j] = w2; } } }
          for (; gi < ITOT; gi += NGW) do_item(gi);
        }
    }
    SEAM(0);
    if (IN(1)) {
        pg8::Gemm g{XN, XN, WIN, WIN, 1024, 1024, 1024, 0, 0}; pg8::StaticOrder S; S.init(T, DIN_PAD, G, bid);
        EpiProj E{QA, KVA, KR, LX, LY, GATES, SSQ, SSKV, ROPE};
        pg8::gemm_phase<EpiProj, pg8::StaticOrder, true>(lds, g, S, E);
    }
    SEAM(1);
    if (IN(2)) { PHASE_IDS;
        if (P2SUB & 1) { const float* cw = args.in[8]; const float* cb = args.in[9]; const int c8 = (gtid & 63) * 8;
          float w[4][8], bias[8];
#pragma unroll
          for (int e = 0; e < 8; ++e) { bias[e] = cb[c8 + e];
#pragma unroll
              for (int j = 0; j < 4; ++j) w[j][e] = cw[j * 512 + c8 + e]; }
          const int rstride = NTH >> 6;
          for (int row = gtid >> 6; row < T; row += 2 * rstride) { const int rowb = (row + rstride < T) ? row + rstride : row;
              u32x4 xa[4], xb[4];
#pragma unroll
              for (int j = 0; j < 4; ++j) { const int ta = (row & (SEQ - 1)) - 2 + j, tb = (rowb & (SEQ - 1)) - 2 + j;
                  xa[j] = (ta >= 0 && ta < SEQ) ? *(const u32x4*)(LX + (size_t)(row - 2 + j) * 512 + c8) : (u32x4){0u, 0u, 0u, 0u};
                  xb[j] = (tb >= 0 && tb < SEQ) ? *(const u32x4*)(LX + (size_t)(rowb - 2 + j) * 512 + c8) : (u32x4){0u, 0u, 0u, 0u}; }
              float a[8], bq[8];
#pragma unroll
              for (int e = 0; e < 8; ++e) { a[e] = bias[e]; bq[e] = bias[e]; }
#pragma unroll
              for (int j = 0; j < 4; ++j) { f32x4 x0, x1, y0, y1; unpack8(xa[j], x0, x1); unpack8(xb[j], y0, y1);
#pragma unroll
                  for (int e = 0; e < 4; ++e) { a[e] += w[j][e] * x0[e]; a[4 + e] += w[j][4 + e] * x1[e]; bq[e] += w[j][e] * y0[e]; bq[4 + e] += w[j][4 + e] * y1[e]; } }
              u32x4 o; o.x = cvt_pk_bf16(a[0], a[1]); o.y = cvt_pk_bf16(a[2], a[3]); o.z = cvt_pk_bf16(a[4], a[5]); o.w = cvt_pk_bf16(a[6], a[7]);
              *(u32x4*)(XC + (size_t)row * 512 + c8) = o;
              if (rowb != row) { u32x4 o2; o2.x = cvt_pk_bf16(bq[0], bq[1]); o2.y = cvt_pk_bf16(bq[2], bq[3]); o2.z = cvt_pk_bf16(bq[4], bq[5]); o2.w = cvt_pk_bf16(bq[6], bq[7]);
                  *(u32x4*)(XC + (size_t)rowb * 512 + c8) = o2; } } }
        if (P2SUB & 2) { pg8::Gemm g{QA, QA, WQB, WQB, 256, 256, 256, 0, 0}; pg8::StaticOrder S; S.init(T, 768, G, bid); EpiQ E{Qb, SSQ, ROPE};
          pg8::gemm_phase<EpiQ, pg8::StaticOrder, true>(lds, g, S, E); }
        if (P2SUB & 4) { pg8::Gemm g{KVA, KVA, WKVB, WKVB, 128, 128, 128, 0, 0}; pg8::StaticOrder S; S.init(T, 1024, G, bid); EpiKV E{KN, Vb, SSKV};
          pg8::gemm_phase<EpiKV, pg8::StaticOrder, true>(lds, g, S, E); }
    }
    SEAM(2);
    if (IN(3)) {
        pg8::Gemm g{XC, XC, WG, WG, 512, 128, 128, 1, 128}; pg8::StaticOrder S; S.init(T, 2048, G, bid);
        EpiGates E{XC, AU, args.in[11], args.in[13], SP8};
        pg8::gemm_phase<EpiGates, pg8::StaticOrder, true>(lds, g, S, E);
    }
    SEAM(3);
    if (IN(4)) {
        __syncthreads();
        const int vcu = (G % 8 == 0) ? (bid % 8) * (G / 8) + bid / 8 : bid;
        const int scan_pos = (bid >> 3) & 7;
        int ui = 0; bool scanned = false;
        for (int un = vcu; un < NBATCH * 8 * 8; un += G, ++ui) { const int bh = un >> 3, qb = un & 7, b = bh >> 3, h = bh & 7; const size_t rb = (size_t)b * SEQ;
            if (ui == scan_pos) { __syncthreads(); for (int it = bid; it < NBATCH * 8; it += G) scan_item(it >> 3, it & 7, AU, LY, REC, (float*)lds_raw); scanned = true; }
            att::attn_unit(Qb + (rb + qb * 256) * 768 + h * 96, KN + rb * 512 + h * 64, KR + rb * 32, Vb + rb * 512 + h * 64, ATT + (rb + qb * 256) * 512 + h * 64, (char*)lds_raw); }
        if (!scanned) { __syncthreads(); for (int it = bid; it < NBATCH * 8; it += G) scan_item(it >> 3, it & 7, AU, LY, REC, (float*)lds_raw); }
    }
    SEAM(4);
    if (IN(5)) {
        pg8::Gemm g{ATT, REC, WOA, WOL, 512, 512, 512, 0, 0}; pg8::DualOrder S; S.S.init(T, 1024, G, bid);
        EpiMerge E{GATES, MERGED};
        pg8::gemm_phase<EpiMerge, pg8::DualOrder, true>(lds, g, S, E);
    }
    SEAM(5);
    if (IN(6)) {
        pg8::Gemm g{MERGED, MERGED, WOUT, WOUT, 1024, 1024, 1024, 0, 0}; pg8::StaticOrder S; S.init(T, 1024, G, bid);
        EpiOut E{args.in[0], X1B, SS2};
        pg8::gemm_phase<EpiOut, pg8::StaticOrder, true>(lds, g, S, E);
    }
    SEAM(6);
    if (IN(7)) {
        pg8::Gemm g{X1B, X1B, WGU, WGU, 1024, 1024, 1024, 0, 0}; pg8::StaticOrder S; S.init(T, 2 * DFF, G, bid);
        EpiFfn E{HID, SS2};
        pg8::gemm_phase<EpiFfn, pg8::StaticOrder, true>(lds, g, S, E);
    }
    SEAM(7);
    if (IN(8)) {
        pg8::Gemm g{HID, HID, WD, WD, DFF, DFF, DFF, 0, 0}; pg8::StaticOrder S; S.init(T, 1024, G, bid);
        EpiDown E{X1B, SS3};
        pg8::gemm_phase<EpiDown, pg8::StaticOrder, true>(lds, g, S, E);
    }
    SEAM(8);
    if (IN(9)) { PHASE_IDS;
        const float* gf = args.in[21]; f32x4 gv[4];
#pragma unroll
        for (int j = 0; j < 4; ++j) gv[j] = *((const f32x4*)gf + lane + 64 * j);
        for (int m = gw; m < T; m += NGW) { f32x4* xr = (f32x4*)(args.out + (size_t)m * DM) + lane; const u32x2* br_ = (const u32x2*)(X1B + (size_t)m * DM) + lane; const float rstd = rsqrtf(SS3[m] * (1.0f / DM) + EPS);
            u32x2 w2[4];
#pragma unroll
            for (int j = 0; j < 4; ++j) w2[j] = __builtin_nontemporal_load(br_ + 64 * j);
#pragma unroll
            for (int j = 0; j < 4; ++j) { const f32x4 v = (f32x4){bf_lo(w2[j].x), bf_hi(w2[j].x), bf_lo(w2[j].y), bf_hi(w2[j].y)}; __builtin_nontemporal_store(v * rstd * gv[j], xr + 64 * j); } }
    }
#if PROBE_MASK
    SEAM(9);
    if (bid == 0 && tid == 0) { const unsigned long long t0_ = __builtin_amdgcn_s_memrealtime(); while (__builtin_amdgcn_s_memrealtime() - t0_ < pr_acc) __builtin_amdgcn_s_sleep(8); }
#endif
#undef IN
#undef SEAM
}

constexpr int LDS_BYTES = 147456;
constexpr int N_PHASES = 10;
extern "C" void kernel_launch(void* const* d_in, const int* in_sizes, int n_in, void* d_out, int out_size, void* d_ws, size_t ws_size, hipStream_t stream) {
    static int grid = 0;
    if (grid == 0) {
        if (n_in != 22 || out_size != T * DM || ws_size < WS_END) { fprintf(stderr, "kernel_launch: unexpected shapes n_in %d out %d ws %zu\n", n_in, out_size, ws_size); grid = -1; return; }
        int dev = 0, cus = 0, per_cu = 0;
        hipGetDevice(&dev); hipDeviceGetAttribute(&cus, hipDeviceAttributeMultiprocessorCount, dev);
        if (hipFuncSetAttribute((const void*)mega_fwd, hipFuncAttributeMaxDynamicSharedMemorySize, LDS_BYTES) != hipSuccess) { fprintf(stderr, "kernel_launch: hipFuncSetAttribute failed\n"); grid = -1; return; }
        if (hipOccupancyMaxActiveBlocksPerMultiprocessor(&per_cu, (const void*)mega_fwd, 512, LDS_BYTES) != hipSuccess || per_cu < 1) { fprintf(stderr, "kernel_launch: occupancy query gives %d\n", per_cu); per_cu = 1; }
        (void)hipGetLastError();
        grid = cus * (per_cu > 1 ? 1 : per_cu);
        if (grid > 256) grid = 256;
    }
    if (grid < 0) return;
    Args a{};
    for (int i = 0; i < 22; ++i) a.in[i] = (const float*)d_in[i];
    a.out = (float*)d_out; a.ws = (unsigned char*)d_ws;
#if MK_SINGLE
    if (hipMemsetAsync((char*)d_ws + WS_BAR, 0, 16384, stream) != hipSuccess) { fprintf(stderr, "kernel_launch: memset failed\n"); return; }
    a.ph_lo = 0; a.ph_hi = N_PHASES;
    void* kargs[] = {&a};
    hipError_t e = hipLaunchCooperativeKernel((const void*)mega_fwd, dim3(grid), dim3(512), kargs, LDS_BYTES, stream);
    if (e != hipSuccess) fprintf(stderr, "cooperative launch failed: %s (grid %d)\n", hipGetErrorString(e), grid);
#else
    for (int p = 0; p < N_PHASES; ++p) { a.ph_lo = p; a.ph_hi = p + 1; hipLaunchKernelGGL(mega_fwd, dim3(grid), dim3(512), LDS_BYTES, stream, a); }
#endif
}
```
